# Optimizing an MI355X kernel written in HIP

```python
import math
import jax, jax.numpy as jnp
from jax import lax
import numpy as np

D_MODEL = 1024
BATCH = 32
SEQ = 2048
DEPTH = 2

HEAD_DIM = 64
A_HEADS = 6
A_KV_HEADS = 2
B_HEADS = 6
B_KV_HEADS = 2
C_HEADS = 4
C_Q_RANK = 256
C_KV_RANK = 128
C_NOPE_DIM = 64
C_ROPE_DIM = 32
C_V_DIM = 64
C_QK_DIM = C_NOPE_DIM + C_ROPE_DIM
D_FF = 2816
GRID_W = 64
Q_BLOCK = 128
WINDOW = 128
NUM_BUCKETS = 32
MAX_DISTANCE = 128
ROPE_THETA = 10000.0
ADA_CHUNKS = 9
EPS = 1e-6
NEG_INF = -1e30

A_Q_W = A_HEADS * HEAD_DIM
A_KV_W = A_KV_HEADS * HEAD_DIM
B_Q_W = B_HEADS * HEAD_DIM
B_KV_W = B_KV_HEADS * HEAD_DIM
IN_SIZES = (A_Q_W, A_KV_W, A_KV_W, B_Q_W, B_KV_W, B_KV_W,
            C_Q_RANK, C_KV_RANK, C_ROPE_DIM, D_MODEL, D_MODEL, D_MODEL)
IN_COLS = (A_Q_W + 2 * A_KV_W + B_Q_W + 2 * B_KV_W
           + C_Q_RANK + C_KV_RANK + C_ROPE_DIM + 3 * D_MODEL)

kernel_name = 'hybrid_gated_mixer_encoder'


def rms_norm(x, g):
    xf = x.astype(jnp.float32)
    y = xf * lax.rsqrt(jnp.mean(xf * xf, axis=-1, keepdims=True) + EPS)
    return (y * g.astype(jnp.float32)).astype(x.dtype)


def modulate(h, shift, scale):
    return h * (1.0 + scale[:, None, :]) + shift[:, None, :]


def swiglu(h, w_gu, w_down):
    gate, up = jnp.split(h @ w_gu, 2, axis=-1)
    return (jax.nn.silu(gate) * up) @ w_down


def split_cols(y, sizes):
    out, off = [], 0
    for s in sizes:
        out.append(y[..., off:off + s])
        off += s
    return out


def rope_angles(pos, dim):
    inv = ROPE_THETA ** (-jnp.arange(0, dim, 2, dtype=jnp.float32) / dim)
    ang = pos.astype(jnp.float32)[:, None] * inv[None, :]
    return jnp.cos(ang), jnp.sin(ang)


def apply_rope(x, cos, sin):
    half = x.shape[-1] // 2
    xf = x.astype(jnp.float32)
    x1, x2 = xf[..., :half], xf[..., half:]
    cos, sin = cos[:, None, :], sin[:, None, :]
    return jnp.concatenate([x1 * cos - x2 * sin, x1 * sin + x2 * cos], axis=-1).astype(x.dtype)


def axial_rope(x, row_cs, col_cs):
    half = x.shape[-1] // 2
    return jnp.concatenate([apply_rope(x[..., :half], *row_cs),
                            apply_rope(x[..., half:], *col_cs)], axis=-1)


def t5_bucket(rel):
    nb = NUM_BUCKETS // 2
    max_exact = nb // 2
    ret = jnp.where(rel > 0, nb, 0)
    n = jnp.abs(rel)
    large = max_exact + (jnp.log(jnp.maximum(n, 1).astype(jnp.float32) / max_exact)
                         / math.log(MAX_DISTANCE / max_exact) * (nb - max_exact)).astype(jnp.int32)
    large = jnp.minimum(large, nb - 1)
    return ret + jnp.where(n < max_exact, n, large)


def window_bias_mask(rel_bias, seq):
    nblk = seq // Q_BLOCK
    r = jnp.arange(Q_BLOCK)[:, None]
    j = jnp.arange(3 * Q_BLOCK)[None, :]
    rel = j - Q_BLOCK - r
    bias = rel_bias[t5_bucket(rel)].astype(jnp.float32)
    bias = jnp.transpose(bias, (2, 0, 1)).reshape(B_KV_HEADS, B_HEADS // B_KV_HEADS, Q_BLOCK, 3 * Q_BLOCK)
    kpos = jnp.arange(nblk)[:, None, None] * Q_BLOCK - Q_BLOCK + j[None]
    mask = (jnp.abs(rel) <= WINDOW)[None] & (kpos >= 0) & (kpos < seq)
    return bias, mask


def dense_attention(q, k, v, scale):
    b, s, kh, g, dq = q.shape
    nblk = s // Q_BLOCK
    qb = jnp.moveaxis(q.reshape(b, nblk, Q_BLOCK, kh, g, dq), 1, 0)

    def one_block(qi):
        logits = jnp.einsum('bqkgd,bskd->bkgqs', qi, k).astype(jnp.float32) * scale
        p = jax.nn.softmax(logits, axis=-1).astype(v.dtype)
        return jnp.einsum('bkgqs,bskd->bqkgd', p, v)

    out = jnp.moveaxis(lax.map(one_block, qb), 0, 1)
    return out.reshape(b, s, kh * g * v.shape[-1])


def window_attention(q, k, v, bias, mask, sink, scale):
    b, s, kh, g, d = q.shape
    nblk = s // Q_BLOCK
    qb = q.reshape(b, nblk, Q_BLOCK, kh, g, d)

    def band(a):
        pad = jnp.pad(a, ((0, 0), (Q_BLOCK, Q_BLOCK), (0, 0), (0, 0)))
        pb = pad.reshape(b, nblk + 2, Q_BLOCK, kh, a.shape[-1])
        return jnp.concatenate([pb[:, :-2], pb[:, 1:-1], pb[:, 2:]], axis=2)

    kb, vb = band(k), band(v)
    logits = jnp.einsum('bnqkgd,bnskd->bnkgqs', qb, kb).astype(jnp.float32) * scale + bias[None, None]
    logits = jnp.where(mask[None, :, None, None], logits, NEG_INF)
    sink_col = jnp.broadcast_to(sink.astype(jnp.float32).reshape(1, 1, kh, g, 1, 1),
                                logits.shape[:-1] + (1,))
    p = jax.nn.softmax(jnp.concatenate([logits, sink_col], axis=-1), axis=-1)[..., :-1]
    out = jnp.einsum('bnkgqs,bnskd->bnqkgd', p.astype(v.dtype), vb)
    return out.reshape(b, s, kh * g * d)


def token_mix(h, w_in, a_q_norm, a_k_norm, b_sink, c_q_lat_norm, c_w_q_up, c_kv_lat_norm,
              c_w_kv_up, w_br_a, w_br_b, w_br_c, w_out, row_cs, col_cs, seq_cs, win_bias, win_mask):
    b, s, _ = h.shape
    (aq, ak, av, bq, bk, bv, cq_lat, ckv_lat, ck_rope,
     gate_a, gate_b, gate_c) = split_cols(h @ w_in, IN_SIZES)

    qa = axial_rope(rms_norm(aq.reshape(b, s, A_HEADS, HEAD_DIM), a_q_norm), row_cs, col_cs)
    ka = axial_rope(rms_norm(ak.reshape(b, s, A_KV_HEADS, HEAD_DIM), a_k_norm), row_cs, col_cs)
    va = av.reshape(b, s, A_KV_HEADS, HEAD_DIM)
    qa = qa.reshape(b, s, A_KV_HEADS, A_HEADS // A_KV_HEADS, HEAD_DIM)
    o_a = dense_attention(qa, ka, va, HEAD_DIM ** -0.5)

    qb = bq.reshape(b, s, B_KV_HEADS, B_HEADS // B_KV_HEADS, HEAD_DIM)
    kb = bk.reshape(b, s, B_KV_HEADS, HEAD_DIM)
    vb = bv.reshape(b, s, B_KV_HEADS, HEAD_DIM)
    o_b = window_attention(qb, kb, vb, win_bias, win_mask, b_sink, HEAD_DIM ** -0.5)

    qc = (rms_norm(cq_lat, c_q_lat_norm) @ c_w_q_up).reshape(b, s, C_HEADS, C_QK_DIM)
    qc_nope, qc_rope = qc[..., :C_NOPE_DIM], apply_rope(qc[..., C_NOPE_DIM:], *seq_cs)
    kv = (rms_norm(ckv_lat, c_kv_lat_norm) @ c_w_kv_up).reshape(b, s, C_HEADS, C_NOPE_DIM + C_V_DIM)
    kc_nope, vc = kv[..., :C_NOPE_DIM], kv[..., C_NOPE_DIM:]
    kc_rope = jnp.broadcast_to(apply_rope(ck_rope[:, :, None, :], *seq_cs), (b, s, C_HEADS, C_ROPE_DIM))
    qc_full = jnp.concatenate([qc_nope, qc_rope], axis=-1).reshape(b, s, C_HEADS, 1, C_QK_DIM)
    kc_full = jnp.concatenate([kc_nope, kc_rope], axis=-1)
    o_c = dense_attention(qc_full, kc_full, vc, C_QK_DIM ** -0.5)

    merged = (jax.nn.sigmoid(gate_a) * (o_a @ w_br_a)
              + jax.nn.sigmoid(gate_b) * (o_b @ w_br_b)
              + jax.nn.sigmoid(gate_c) * (o_c @ w_br_c))
    return merged @ w_out


def setup_inputs(seed: int = 0) -> dict:
    key = jax.random.key(seed)
    ks = jax.random.split(key, 32)
    L, D = DEPTH, D_MODEL

    def nrm(k, shape, scale):
        return jax.random.normal(k, shape, jnp.float32) * scale

    def gain(k, shape):
        return 1.0 + 0.05 * jax.random.normal(k, shape, jnp.float32)

    return {
        'x': nrm(ks[0], (BATCH, SEQ, D), 1.0),
        'c': nrm(ks[1], (BATCH, D), 1.0),
        'ada_w': nrm(ks[2], (L, D, ADA_CHUNKS * D), 0.5 * D ** -0.5),
        'ada_b': nrm(ks[3], (L, ADA_CHUNKS * D), 0.02),
        'norm_ffn1': gain(ks[4], (L, D)),
        'ffn1_w_gu': nrm(ks[5], (L, D, 2 * D_FF), D ** -0.5),
        'ffn1_w_down': nrm(ks[6], (L, D_FF, D), D_FF ** -0.5),
        'norm_mix': gain(ks[7], (L, D)),
        'w_in': nrm(ks[8], (L, D, IN_COLS), D ** -0.5),
        'a_q_norm': gain(ks[9], (L, HEAD_DIM)),
        'a_k_norm': gain(ks[10], (L, HEAD_DIM)),
        'b_sink': nrm(ks[11], (L, B_HEADS), 1.0),
        'rel_bias': nrm(ks[12], (NUM_BUCKETS, B_HEADS), 0.5),
        'c_q_lat_norm': gain(ks[13], (L, C_Q_RANK)),
        'c_w_q_up': nrm(ks[14], (L, C_Q_RANK, C_HEADS * C_QK_DIM), C_Q_RANK ** -0.5),
        'c_kv_lat_norm': gain(ks[15], (L, C_KV_RANK)),
        'c_w_kv_up': nrm(ks[16], (L, C_KV_RANK, C_HEADS * (C_NOPE_DIM + C_V_DIM)), C_KV_RANK ** -0.5),
        'w_br_a': nrm(ks[17], (L, A_Q_W, D), A_Q_W ** -0.5),
        'w_br_b': nrm(ks[18], (L, B_Q_W, D), B_Q_W ** -0.5),
        'w_br_c': nrm(ks[19], (L, C_HEADS * C_V_DIM, D), (C_HEADS * C_V_DIM) ** -0.5),
        'w_out': nrm(ks[20], (L, D, D), D ** -0.5),
        'norm_ffn2': gain(ks[21], (L, D)),
        'ffn2_w_gu': nrm(ks[22], (L, D, 2 * D_FF), D ** -0.5),
        'ffn2_w_down': nrm(ks[23], (L, D_FF, D), D_FF ** -0.5),
        'final_norm': gain(ks[24], (D,)),
    }


def reference(x, c, ada_w, ada_b, norm_ffn1, ffn1_w_gu, ffn1_w_down, norm_mix, w_in,
              a_q_norm, a_k_norm, b_sink, rel_bias, c_q_lat_norm, c_w_q_up, c_kv_lat_norm,
              c_w_kv_up, w_br_a, w_br_b, w_br_c, w_out, norm_ffn2, ffn2_w_gu, ffn2_w_down,
              final_norm):
    b, s, _ = x.shape
    rows = s // GRID_W
    t = jnp.arange(s)
    row_pos = jnp.repeat(jnp.arange(rows), GRID_W)
    col_pos = jnp.tile(jnp.arange(GRID_W), rows)
    row_cs = rope_angles(row_pos, HEAD_DIM // 2)
    col_cs = rope_angles(col_pos, HEAD_DIM // 2)
    seq_cs = rope_angles(t, C_ROPE_DIM)
    win_bias, win_mask = window_bias_mask(rel_bias, s)
    cond = jax.nn.silu(c)

    for l in range(DEPTH):
        mods = cond @ ada_w[l] + ada_b[l]
        sh1, sc1, g1, sh2, sc2, g2, sh3, sc3, g3 = jnp.split(mods, ADA_CHUNKS, axis=-1)

        h = modulate(rms_norm(x, norm_ffn1[l]), sh1, sc1)
        x = x + 0.5 * g1[:, None, :] * swiglu(h, ffn1_w_gu[l], ffn1_w_down[l])

        h = modulate(rms_norm(x, norm_mix[l]), sh2, sc2)
        x = x + g2[:, None, :] * token_mix(
            h, w_in[l], a_q_norm[l], a_k_norm[l], b_sink[l], c_q_lat_norm[l], c_w_q_up[l],
            c_kv_lat_norm[l], c_w_kv_up[l], w_br_a[l], w_br_b[l], w_br_c[l], w_out[l],
            row_cs, col_cs, seq_cs, win_bias, win_mask)

        h = modulate(rms_norm(x, norm_ffn2[l]), sh3, sc3)
        x = x + 0.5 * g3[:, None, :] * swiglu(h, ffn2_w_gu[l], ffn2_w_down[l])

    return rms_norm(x, final_norm)
```

```cpp
#include <hip/hip_runtime.h>
#include <hip/hip_cooperative_groups.h>
#include <hip/hip_bf16.h>
#include <cstdio>
#include <cstdint>
#include <cmath>
namespace cg = cooperative_groups;
#define GL(T, p) (*(const __attribute__((address_space(1))) T*)(p))
#define GS(T, p) (*(__attribute__((address_space(1))) T*)(p))
#define GLB(T, base, boff) (*(const __attribute__((address_space(1))) T*)((const __attribute__((address_space(1))) char*)(base) + (unsigned)(boff)))
#define GSB(T, base, boff) (*(__attribute__((address_space(1))) T*)((__attribute__((address_space(1))) char*)(base) + (unsigned)(boff)))
__device__ __forceinline__ int lautid() { int t = threadIdx.x; asm volatile("" : "+v"(t)); return t; }
namespace pg8 {
#define PG8_LAS __attribute__((address_space(3)))
typedef unsigned short bf16_t;
typedef short bf16x8 __attribute__((ext_vector_type(8)));
typedef float f32x4 __attribute__((ext_vector_type(4)));
typedef unsigned u32x4 __attribute__((ext_vector_type(4)));
constexpr int BM = 256, BK = 64, HALF = 128, HTB = HALF * BK * 2  , STAGE_BYTES = 8 * HTB, NXCD = 8, WGM = 8;

__host__ __device__ __forceinline__ int lds_byte(int r, int c) { const int st = (r >> 4) * 2 + (c >> 5), rr = r & 15, cc = c & 31, ob = rr * 64 + cc * 2; return st * 1024 + (ob ^ (((ob >> 9) & 1) << 5)); }
__host__ __device__ __forceinline__ void stage_rc(int b, int& R, int& C) { const int st = b / 1024, sb = b % 1024, swz = sb ^ (((sb >> 9) & 1) << 5); R = (st >> 1) * 16 + swz / 64; C = (st & 1) * 32 + (swz % 64) / 2; }
__host__ __device__ __forceinline__ int perm32(int rho) { const int n = rho >> 4, i = rho & 15; return 8 * (i >> 2) + 4 * n + (i & 3); }

struct Unit { int pm, pn, k0, nt, br; };
struct Gemm { const bf16_t* A; const bf16_t* Bt; int lda, ldb; };

struct Order {
    int nM, nN, nwg, G, c, nt, mode;
    __device__ __forceinline__ void init(int M, int N, int G_, int c_, int nt_, int mode_) { nM = M / BM; nN = N / BM; nwg = nM * nN; G = G_; c = c_; nt = nt_; mode = mode_; asm volatile("" : "+s"(nt)); }
    __device__ __forceinline__ bool next(int i, Unit& u) const {
        const int ii = mode ? i / 3 : i;
        const int L = ii * G + c; if (L >= nwg) return false;
        int wgid = L; { const int q = nwg / NXCD, r = nwg % NXCD, xcd = wgid % NXCD, off = wgid / NXCD; wgid = (xcd < r ? xcd * (q + 1) : r * (q + 1) + (xcd - r) * q) + off; }
        const int nig = WGM * nN, gid = wgid / nig, fm = gid * WGM, gsz = (nM - fm) < WGM ? (nM - fm) : WGM;
        u.pm = fm + ((wgid % nig) % gsz); u.pn = (wgid % nig) / gsz;
        if (mode) { const int br = i - ii * 3; u.br = br; u.k0 = br * 384; u.nt = (br == 2) ? 4 : 6; } else { u.br = 0; u.k0 = 0; u.nt = nt; }
        return true;
    }
    __device__ __forceinline__ void a_ready(const Unit&) const {}
    __device__ __forceinline__ void done(const Unit&) const {}
};
typedef float f32x2_cv __attribute__((ext_vector_type(2))); typedef __bf16 bf16x2_cv __attribute__((ext_vector_type(2)));
__device__ __forceinline__ unsigned cvt_pk_bf16(float lo, float hi) { f32x2_cv v = {lo, hi}; bf16x2_cv b = __builtin_convertvector(v, bf16x2_cv); return __builtin_bit_cast(unsigned, b); }
template <class Epi, class Sched, bool ALIGN_EPI = false, bool SP2 = false>
__device__ __forceinline__ void gemm_phase(PG8_LAS unsigned char* lds, const Gemm g, const Sched& S, const Epi& E) {
    const int tid = lautid(), wid = __builtin_amdgcn_readfirstlane(tid >> 6), lane = tid & 63, wr = wid >> 2, wc = wid & 3, fr = lane & 15, fq = lane >> 4;
    int nt;
    unsigned voffA[2], voffB[2];
#pragma unroll
    for (int i = 0; i < 2; ++i) { int R, C; stage_rc(tid * 16 + i * 8192, R, C); const int Rb = Epi::PERM ? ((R & ~31) + perm32(R & 31)) : R;
        voffA[i] = (unsigned)(R * g.lda + C) * 2u; voffB[i] = (unsigned)(Rb * g.ldb + C) * 2u; }
    const size_t kstep = (size_t)(BK * 2);
    const size_t hstepA = (size_t)HALF * g.lda * 2, hstepB = (size_t)HALF * g.ldb * 2;
    const size_t tstepA = 2 * hstepA, tstepB = 2 * hstepB;
    const unsigned ldsw = (unsigned)wid * 1024u;
    const int aoff = lds_byte(wr * 64 + fr, fq * 8), boff = lds_byte(wc * 32 + fr, fq * 8);
#define PG8_SA(b, h) (((b) * 2 + (h)) * HTB)
#define PG8_SB(b, h) ((4 + (b) * 2 + (h)) * HTB)
#define PG8_STAGE(bufoff, gbase, voff) do { _Pragma("unroll") for (int _i = 0; _i < 2; ++_i) \
        __builtin_amdgcn_global_load_lds((const unsigned*)((const char*)(gbase) + (voff)[_i]), (PG8_LAS unsigned*)(lds + (bufoff) + ldsw + _i * 8192), 16, 0, 0); } while (0)
#define PG8_LDA(dst, b, h) do { _Pragma("unroll") for (int m = 0; m < 4; ++m) _Pragma("unroll") for (int k = 0; k < 2; ++k) dst[m][k] = *(const PG8_LAS bf16x8*)(lds + PG8_SA(b, h) + aoff + m * 2048 + k * 1024); } while (0)
#define PG8_LDB(dst, b, h) do { _Pragma("unroll") for (int n = 0; n < 2; ++n) _Pragma("unroll") for (int k = 0; k < 2; ++k) dst[n][k] = *(const PG8_LAS bf16x8*)(lds + PG8_SB(b, h) + boff + n * 2048 + k * 1024); } while (0)
#define PG8_MMA(ai, bj, At, Bt) do { __builtin_amdgcn_s_setprio(1); _Pragma("unroll") for (int m = 0; m < 4; ++m) _Pragma("unroll") for (int n = 0; n < 2; ++n) _Pragma("unroll") for (int k = 0; k < 2; ++k) \
        acc[ai][bj][m][n] = __builtin_amdgcn_mfma_f32_16x16x32_bf16(Bt[n][k], At[m][k], acc[ai][bj][m][n], 0, 0, 0); __builtin_amdgcn_s_setprio(0); } while (0)
#define PG8_WAIT_V(n) asm volatile("s_waitcnt vmcnt(" #n ")" ::: "memory")
#define PG8_WAIT_L(n) asm volatile("s_waitcnt lgkmcnt(" #n ")" ::: "memory")
#define PG8_BAR __builtin_amdgcn_s_barrier()
#define PG8_SCHED __builtin_amdgcn_sched_barrier(0)
    Unit cur, nxt; int ui = 0;
    if (!S.next(0, cur)) return;
    f32x4 acc[2][2][4][2];
#pragma unroll
    for (int a = 0; a < 2; ++a)
#pragma unroll
        for (int b = 0; b < 2; ++b)
#pragma unroll
            for (int m = 0; m < 4; ++m)
#pragma unroll
                for (int n = 0; n < 2; ++n) acc[a][b][m][n] = (f32x4){0.f, 0.f, 0.f, 0.f};
    bf16x8 At[4][2], B0[2][2], B1[2][2];
    const char* cA = (const char*)g.A + (size_t)cur.pm * tstepA + (size_t)cur.k0 * 2; const char* cB = (const char*)g.Bt + (size_t)cur.pn * tstepB + (size_t)cur.k0 * 2; nt = cur.nt;
    S.a_ready(cur);
    if constexpr (SP2) {
        PG8_STAGE(PG8_SB(0, 0), cB, voffB); PG8_STAGE(PG8_SB(0, 1), cB + hstepB, voffB); PG8_STAGE(PG8_SA(0, 0), cA, voffA); PG8_STAGE(PG8_SA(0, 1), cA + hstepA, voffA);
        if (wr == 1) PG8_BAR;
        PG8_WAIT_V(2); PG8_BAR;
        PG8_STAGE(PG8_SB(1, 0), cB + kstep, voffB); PG8_STAGE(PG8_SA(1, 0), cA + kstep, voffA); PG8_STAGE(PG8_SB(1, 1), cB + hstepB + kstep, voffB);
        PG8_WAIT_V(6); PG8_BAR;
    } else {
        PG8_STAGE(PG8_SB(0, 0), cB, voffB); PG8_STAGE(PG8_SA(0, 0), cA, voffA); PG8_STAGE(PG8_SB(0, 1), cB + hstepB, voffB); PG8_STAGE(PG8_SA(0, 1), cA + hstepA, voffA);
        if (wr == 1) PG8_BAR;
        PG8_WAIT_V(4); PG8_BAR;
        PG8_STAGE(PG8_SB(1, 0), cB + kstep, voffB); PG8_STAGE(PG8_SA(1, 0), cA + kstep, voffA); PG8_STAGE(PG8_SB(1, 1), cB + hstepB + kstep, voffB);
        PG8_WAIT_V(6); PG8_BAR;
    }
    for (;;) {
        const bool has_next = S.next(ui + 1, nxt);
        const char* nA = has_next ? (const char*)g.A + (size_t)nxt.pm * tstepA + (size_t)nxt.k0 * 2 : cA; const char* nB = has_next ? (const char*)g.Bt + (size_t)nxt.pn * tstepB + (size_t)nxt.k0 * 2 : cB;
        for (int t = 0; t < nt; t += 2) {
            const bool last = (t == nt - 2);
            const char* a1 = cA + (size_t)(t + 1) * kstep;
            const char* a2 = last ? nA : cA + (size_t)(t + 2) * kstep; const char* b2 = last ? nB : cB + (size_t)(t + 2) * kstep;
            const char* a3 = a2 + kstep; const char* b3 = b2 + kstep;
            if (last && has_next) S.a_ready(nxt);
            if constexpr (SP2) {
            PG8_LDB(B0, 0, 0); PG8_LDB(B1, 0, 1); PG8_SCHED; PG8_LDA(At, 0, 0); PG8_STAGE(PG8_SA(1, 1), a1 + hstepA, voffA);
            PG8_WAIT_V(8); PG8_WAIT_L(0); PG8_BAR; PG8_MMA(0, 0, At, B0); PG8_MMA(0, 1, At, B1); PG8_BAR; PG8_SCHED;
            PG8_LDA(At, 0, 1); PG8_STAGE(PG8_SB(0, 0), b2, voffB); PG8_STAGE(PG8_SB(0, 1), b2 + hstepB, voffB); PG8_STAGE(PG8_SA(0, 0), a2, voffA);
            PG8_WAIT_V(8); PG8_WAIT_L(0); PG8_BAR; PG8_MMA(1, 0, At, B0); PG8_MMA(1, 1, At, B1); PG8_BAR; PG8_SCHED;
            PG8_LDB(B0, 1, 0); PG8_LDB(B1, 1, 1); PG8_SCHED; PG8_LDA(At, 1, 0); PG8_STAGE(PG8_SA(0, 1), a2 + hstepA, voffA);
            PG8_WAIT_V(8); PG8_WAIT_L(0); PG8_BAR; PG8_MMA(0, 0, At, B0); PG8_MMA(0, 1, At, B1); PG8_BAR; PG8_SCHED;
            PG8_LDA(At, 1, 1); PG8_STAGE(PG8_SB(1, 0), b3, voffB); PG8_STAGE(PG8_SB(1, 1), b3 + hstepB, voffB); PG8_STAGE(PG8_SA(1, 0), a3, voffA);
            PG8_WAIT_V(8); PG8_WAIT_L(0); PG8_BAR; PG8_MMA(1, 0, At, B0); PG8_MMA(1, 1, At, B1); PG8_BAR; PG8_SCHED;
            } else {
            PG8_LDB(B0, 0, 0); PG8_SCHED; PG8_LDA(At, 0, 0); PG8_STAGE(PG8_SA(1, 1), a1 + hstepA, voffA);
            PG8_WAIT_L(8); PG8_BAR; PG8_WAIT_L(0); PG8_MMA(0, 0, At, B0); PG8_BAR; PG8_SCHED;
            PG8_LDB(B1, 0, 1); PG8_STAGE(PG8_SB(0, 0), b2, voffB);
            PG8_BAR; PG8_WAIT_L(0); PG8_MMA(0, 1, At, B1); PG8_BAR;
            PG8_LDA(At, 0, 1); PG8_STAGE(PG8_SA(0, 0), a2, voffA);
            PG8_BAR; PG8_WAIT_L(0); PG8_MMA(1, 0, At, B0); PG8_BAR; PG8_SCHED;
            PG8_STAGE(PG8_SB(0, 1), b2 + hstepB, voffB);
            PG8_WAIT_V(6); PG8_BAR; PG8_MMA(1, 1, At, B1); PG8_BAR;
            PG8_LDB(B0, 1, 0); PG8_SCHED; PG8_LDA(At, 1, 0); PG8_STAGE(PG8_SA(0, 1), a2 + hstepA, voffA);
            PG8_WAIT_L(8); PG8_BAR; PG8_WAIT_L(0); PG8_MMA(0, 0, At, B0); PG8_BAR; PG8_SCHED;
            PG8_LDB(B1, 1, 1); PG8_STAGE(PG8_SB(1, 0), b3, voffB);
            PG8_BAR; PG8_WAIT_L(0); PG8_MMA(0, 1, At, B1); PG8_BAR;
            PG8_LDA(At, 1, 1); PG8_STAGE(PG8_SA(1, 0), a3, voffA);
            PG8_BAR; PG8_WAIT_L(0); PG8_MMA(1, 0, At, B0); PG8_BAR; PG8_SCHED;
            PG8_STAGE(PG8_SB(1, 1), b3 + hstepB, voffB);
            PG8_WAIT_V(6); PG8_BAR; PG8_MMA(1, 1, At, B1); PG8_BAR;
            }
        }
        if constexpr (ALIGN_EPI) { if (wr == 0) PG8_BAR; }
        if constexpr (!Epi::AFTER_DRAIN) { E(acc, cur, wr, wc, fr, fq); S.done(cur); }
        if (!has_next) break;
#pragma unroll
        for (int a = 0; a < 2; ++a)
#pragma unroll
            for (int b = 0; b < 2; ++b)
#pragma unroll
                for (int m = 0; m < 4; ++m)
#pragma unroll
                    for (int n = 0; n < 2; ++n) acc[a][b][m][n] = (f32x4){0.f, 0.f, 0.f, 0.f};
        cur = nxt; cA = nA; cB = nB; ++ui; nt = cur.nt;
        if constexpr (ALIGN_EPI) { if (wr == 1) PG8_BAR; }
    }
    PG8_WAIT_V(0);
    if constexpr (!ALIGN_EPI) { if (wr == 0) PG8_BAR; }
    PG8_BAR;
    if constexpr (Epi::AFTER_DRAIN) { E.fused(acc, cur, wr, wc, fr, fq, lds, wid, lane); S.done(cur); }
#undef PG8_SA
#undef PG8_SB
#undef PG8_STAGE
#undef PG8_LDA
#undef PG8_LDB
#undef PG8_MMA
#undef PG8_WAIT_V
#undef PG8_WAIT_L
#undef PG8_BAR
#undef PG8_SCHED
}
}
constexpr int MTOK = 65536, DM = 1024, SEQ = 2048, NB = 32, FF = 2816, NGU = 5632, NIN = 4864, NYS = 1792, NMOD = 9216;
constexpr float EPS = 1e-6f, LOG2E = 1.4426950408889634f;
constexpr float C2A = 0.125f * LOG2E;
constexpr float C2C = 0.10206207261596575f * LOG2E;

namespace pg8 {
__device__ __forceinline__ float fsigmoid(float x) { return __builtin_amdgcn_rcpf(1.0f + __builtin_amdgcn_exp2f(-x * LOG2E)); }
__device__ __forceinline__ void load_rstd(const float* rstdv, int row0, float (&rs)[2][4]) {
#pragma unroll
    for (int ai = 0; ai < 2; ++ai)
#pragma unroll
        for (int m = 0; m < 4; ++m) rs[ai][m] = GL(float, rstdv + row0 + ai * HALF + m * 16);
}
struct EpiGU {
    static constexpr bool PERM = true, AFTER_DRAIN = false;
    bf16_t* H; const float* rowss; const float* shW;
    __device__ __forceinline__ void operator()(const f32x4 (&acc)[2][2][4][2], const Unit& u, int wr, int wc, int fr, int fq) const {
        const int row0 = u.pm * BM + wr * 64 + fr, b = u.pm >> 3;
        const int cg0 = u.pn * BM + wc * 32 + 8 * fq, hc = u.pn * HALF + wc * 32 + 8 * fq;
        f32x4 sg[2], su[2];
#pragma unroll
        for (int n = 0; n < 2; ++n) { sg[n] = GL(f32x4, shW + (size_t)b * NGU + cg0 + 4 * n); su[n] = GL(f32x4, shW + (size_t)b * NGU + cg0 + HALF + 4 * n); }
        float rs[2][4]; load_rstd(rowss, row0, rs);
#pragma unroll
        for (int ai = 0; ai < 2; ++ai)
#pragma unroll
            for (int m = 0; m < 4; ++m) {
                const float r = rs[ai][m]; float h[8];
#pragma unroll
                for (int n = 0; n < 2; ++n) { const f32x4 g = acc[ai][0][m][n] * r + sg[n], up = acc[ai][1][m][n] * r + su[n];
#pragma unroll
                    for (int j = 0; j < 4; ++j) h[4 * n + j] = g[j] * fsigmoid(g[j]) * up[j]; }
                u32x4 w; w.x = cvt_pk_bf16(h[0], h[1]); w.y = cvt_pk_bf16(h[2], h[3]); w.z = cvt_pk_bf16(h[4], h[5]); w.w = cvt_pk_bf16(h[6], h[7]);
                GS(u32x4, H + (size_t)(row0 + ai * HALF + m * 16) * FF + hc) = w;
            }
    }
};
struct EpiRes {
    static constexpr bool PERM = false, AFTER_DRAIN = false;
    const float* base; float* out; const float* gate; bf16_t* AP; const float* gain; const float* sc; float* rowss; float gscale; int pad;
    __device__ __forceinline__ void operator()(const f32x4 (&acc)[2][2][4][2], const Unit& u, int wr, int wc, int fr, int fq) const {
        typedef unsigned u32x2 __attribute__((ext_vector_type(2)));
        const unsigned row0 = u.pm * BM + wr * 64 + fr, b = u.pm >> 3, col0 = u.pn * BM + wc * 32 + 4 * fq;
        f32x4 gv[2][2], mu[2][2];
#pragma unroll
        for (int bj = 0; bj < 2; ++bj)
#pragma unroll
            for (int n = 0; n < 2; ++n) { const unsigned cb = col0 + bj * HALF + n * 16;
                gv[bj][n] = GLB(f32x4, gate, (b * NMOD + cb) * 4u) * gscale;
                if (AP) mu[bj][n] = GLB(f32x4, gain, cb * 4u) * (GLB(f32x4, sc, (b * NMOD + cb) * 4u) + 1.0f); else mu[bj][n] = (f32x4){0.f, 0.f, 0.f, 0.f}; }
#pragma unroll
        for (int ai = 0; ai < 2; ++ai) {
            f32x4 xb[4][2][2];
#pragma unroll
            for (int m = 0; m < 4; ++m)
#pragma unroll
                for (int bj = 0; bj < 2; ++bj)
#pragma unroll
                    for (int n = 0; n < 2; ++n) xb[m][bj][n] = GLB(f32x4, base, ((row0 + ai * HALF + m * 16) * DM + col0 + bj * HALF + n * 16) * 4u);
#pragma unroll
            for (int m = 0; m < 4; ++m) {
                const unsigned row = row0 + ai * HALF + m * 16; float ss = 0.f;
#pragma unroll
                for (int bj = 0; bj < 2; ++bj)
#pragma unroll
                    for (int n = 0; n < 2; ++n) { const unsigned off = row * DM + col0 + bj * HALF + n * 16;
                        const f32x4 x = xb[m][bj][n] + gv[bj][n] * acc[ai][bj][m][n];
                        GSB(f32x4, out, off * 4u) = x; ss += (x[0] * x[0] + x[1] * x[1]) + (x[2] * x[2] + x[3] * x[3]);
                        if (AP) { const f32x4 y = x * mu[bj][n]; u32x2 w; w.x = cvt_pk_bf16(y[0], y[1]); w.y = cvt_pk_bf16(y[2], y[3]); GSB(u32x2, AP, off * 2u) = w; } }
                ss += __shfl_xor(ss, 16); ss += __shfl_xor(ss, 32);
                if (fq == 0) GSB(float, rowss, (row * 16 + u.pn * 4 + wc) * 4u) = ss;
            }
        }
    }
};
struct EpiIn {
    static constexpr bool PERM = true, AFTER_DRAIN = false;
    bf16_t* YS; bf16_t* YG; const float* rowss; const float* shW;
    __device__ __forceinline__ void operator()(const f32x4 (&acc)[2][2][4][2], const Unit& u, int wr, int wc, int fr, int fq) const {
        const int row0 = u.pm * BM + wr * 64 + fr, b = u.pm >> 3;
        float rs[2][4]; load_rstd(rowss, row0, rs);
        if (u.pn >= 7) {
#pragma unroll
            for (int bj = 0; bj < 2; ++bj) {
                const int cb = u.pn * BM + bj * HALF, col = cb + wc * 32 + 8 * fq, gc = cb - NYS;
                f32x4 sh[2];
#pragma unroll
                for (int n = 0; n < 2; ++n) sh[n] = GL(f32x4, shW + (size_t)b * NIN + col + 4 * n);
                bf16_t* dst = YG + (size_t)(gc >> 10) * ((size_t)MTOK * DM) + (gc & 1023) + wc * 32 + 8 * fq;
#pragma unroll
                for (int ai = 0; ai < 2; ++ai)
#pragma unroll
                    for (int m = 0; m < 4; ++m) {
                        const float r = rs[ai][m]; float h[8];
#pragma unroll
                        for (int n = 0; n < 2; ++n) { const f32x4 v = acc[ai][bj][m][n] * r + sh[n];
#pragma unroll
                            for (int j = 0; j < 4; ++j) h[4 * n + j] = fsigmoid(v[j]); }
                        u32x4 w; w.x = cvt_pk_bf16(h[0], h[1]); w.y = cvt_pk_bf16(h[2], h[3]); w.z = cvt_pk_bf16(h[4], h[5]); w.w = cvt_pk_bf16(h[6], h[7]);
                        GS(u32x4, dst + (size_t)(row0 + ai * HALF + m * 16) * DM) = w;
                    }
            }
        } else {
#pragma unroll
            for (int bj = 0; bj < 2; ++bj) {
                const int cb = u.pn * BM + bj * HALF, col = cb + wc * 32 + 8 * fq;
                f32x4 sh[2];
#pragma unroll
                for (int n = 0; n < 2; ++n) sh[n] = GL(f32x4, shW + (size_t)b * NIN + col + 4 * n);
                const float scale = (cb >= 640 && cb < 1024) ? C2A : 1.0f;
                bf16_t* dst = YS + col;
#pragma unroll
                for (int ai = 0; ai < 2; ++ai)
#pragma unroll
                    for (int m = 0; m < 4; ++m) {
                        const float r = rs[ai][m];
                        const f32x4 v0 = (acc[ai][bj][m][0] * r + sh[0]) * scale, v1 = (acc[ai][bj][m][1] * r + sh[1]) * scale;
                        u32x4 w; w.x = cvt_pk_bf16(v0[0], v0[1]); w.y = cvt_pk_bf16(v0[2], v0[3]); w.z = cvt_pk_bf16(v1[0], v1[1]); w.w = cvt_pk_bf16(v1[2], v1[3]);
                        GS(u32x4, dst + (size_t)(row0 + ai * HALF + m * 16) * NYS) = w;
                    }
            }
        }
    }
};
struct EpiQup {
    static constexpr bool PERM = false, AFTER_DRAIN = false;
    bf16_t* QC; const float* cs; const float* sn;
    __device__ __forceinline__ void operator()(const f32x4 (&acc)[2][2][4][2], const Unit& u, int wr, int wc, int fr, int fq) const {
        typedef unsigned u32x2 __attribute__((ext_vector_type(2)));
        const int row0 = u.pm * BM + wr * 64 + fr;
#pragma unroll
        for (int bj = 0; bj < 2; ++bj) {
            const int cb = u.pn * BM + bj * HALF + wc * 32;
            if (cb >= 384) continue;
            const bool rope = (cb % 96) == 64;
#pragma unroll
            for (int ai = 0; ai < 2; ++ai)
#pragma unroll
                for (int m = 0; m < 4; ++m) {
                    const int row = row0 + ai * HALF + m * 16, t = row & (SEQ - 1);
                    f32x4 x0 = acc[ai][bj][m][0], x1 = acc[ai][bj][m][1];
                    if (rope) { const f32x4 c = GL(f32x4, cs + t * 16 + 4 * fq), s = GL(f32x4, sn + t * 16 + 4 * fq);
                        const f32x4 y0 = x0 * c - x1 * s, y1 = x0 * s + x1 * c; x0 = y0; x1 = y1; }
                    x0 = x0 * C2C; x1 = x1 * C2C;
                    u32x2 w0, w1; w0.x = cvt_pk_bf16(x0[0], x0[1]); w0.y = cvt_pk_bf16(x0[2], x0[3]); w1.x = cvt_pk_bf16(x1[0], x1[1]); w1.y = cvt_pk_bf16(x1[2], x1[3]);
                    bf16_t* d = QC + (size_t)row * 384 + cb + 4 * fq;
                    *(u32x2*)d = w0; GS(u32x2, d + 16) = w1;
                }
        }
    }
};
struct EpiPlain {
    static constexpr bool PERM = true, AFTER_DRAIN = false;
    bf16_t* O; int ldc;
    __device__ __forceinline__ void operator()(const f32x4 (&acc)[2][2][4][2], const Unit& u, int wr, int wc, int fr, int fq) const {
        const int row0 = u.pm * BM + wr * 64 + fr, col0 = u.pn * BM + wc * 32 + 8 * fq;
#pragma unroll
        for (int ai = 0; ai < 2; ++ai)
#pragma unroll
            for (int m = 0; m < 4; ++m)
#pragma unroll
                for (int bj = 0; bj < 2; ++bj) { const f32x4 v0 = acc[ai][bj][m][0], v1 = acc[ai][bj][m][1];
                    u32x4 w; w.x = cvt_pk_bf16(v0[0], v0[1]); w.y = cvt_pk_bf16(v0[2], v0[3]); w.z = cvt_pk_bf16(v1[0], v1[1]); w.w = cvt_pk_bf16(v1[2], v1[3]);
                    GS(u32x4, O + (size_t)(row0 + ai * HALF + m * 16) * ldc + col0 + bj * HALF) = w; asm volatile("" ::: "memory"); }
    }
};
struct EpiBr {
    static constexpr bool PERM = true, AFTER_DRAIN = false;
    bf16_t* YG; float* MG;
    __device__ __forceinline__ void operator()(const f32x4 (&acc)[2][2][4][2], const Unit& u, int wr, int wc, int fr, int fq) const {
        const unsigned row0 = u.pm * BM + wr * 64 + fr, col0 = u.pn * BM + wc * 32 + 8 * fq;
        const bf16_t* G = YG + (size_t)u.br * ((size_t)MTOK * DM);
#pragma unroll
        for (int ai = 0; ai < 2; ++ai) {
            u32x4 gw[4][2], mw[4][2];
#pragma unroll
            for (int m = 0; m < 4; ++m)
#pragma unroll
                for (int bj = 0; bj < 2; ++bj) { const unsigned off = ((row0 + ai * HALF + m * 16) * DM + col0 + bj * HALF) * 2u;
                    gw[m][bj] = GLB(u32x4, G, off); mw[m][bj] = (u.br > 0) ? GLB(u32x4, YG, off) : (u32x4){0u, 0u, 0u, 0u}; }
#pragma unroll
            for (int m = 0; m < 4; ++m)
#pragma unroll
                for (int bj = 0; bj < 2; ++bj) { const unsigned off = ((row0 + ai * HALF + m * 16) * DM + col0 + bj * HALF) * 2u;
                    const u32x4 g = gw[m][bj], r = mw[m][bj]; f32x4 g0, g1, r0, r1;
                    g0[0] = __uint_as_float(g.x << 16); g0[1] = __uint_as_float(g.x & 0xffff0000u); g0[2] = __uint_as_float(g.y << 16); g0[3] = __uint_as_float(g.y & 0xffff0000u);
                    g1[0] = __uint_as_float(g.z << 16); g1[1] = __uint_as_float(g.z & 0xffff0000u); g1[2] = __uint_as_float(g.w << 16); g1[3] = __uint_as_float(g.w & 0xffff0000u);
                    r0[0] = __uint_as_float(r.x << 16); r0[1] = __uint_as_float(r.x & 0xffff0000u); r0[2] = __uint_as_float(r.y << 16); r0[3] = __uint_as_float(r.y & 0xffff0000u);
                    r1[0] = __uint_as_float(r.z << 16); r1[1] = __uint_as_float(r.z & 0xffff0000u); r1[2] = __uint_as_float(r.w << 16); r1[3] = __uint_as_float(r.w & 0xffff0000u);
                    const f32x4 v0 = acc[ai][bj][m][0] * g0 + r0, v1 = acc[ai][bj][m][1] * g1 + r1;
                    u32x4 w; w.x = cvt_pk_bf16(v0[0], v0[1]); w.y = cvt_pk_bf16(v0[2], v0[3]); w.z = cvt_pk_bf16(v1[0], v1[1]); w.w = cvt_pk_bf16(v1[2], v1[3]); GSB(u32x4, YG, off) = w; }
        }
    }
};
}
namespace att {
using bf16 = unsigned short;
using bf16x8 = __attribute__((ext_vector_type(8))) short;
using s16x4 = __attribute__((ext_vector_type(4))) short;
using f32x16 = __attribute__((ext_vector_type(16))) float;
using u32x4 = __attribute__((ext_vector_type(4))) unsigned;
constexpr int LDS_K = 0, KSLOT_MAX = 12288, LDS_V = 2 * KSLOT_MAX, LDS_WS = LDS_V + 2 * 8192, LDS_BIAS = LDS_WS + 2048, LDS_OST = LDS_BIAS + 2048, LDS_BYTES = LDS_OST + 8 * 4096;
__device__ __forceinline__ int crow(int r, int hi) { return (r & 3) + 8 * (r >> 2) + 4 * hi; }
__device__ __forceinline__ void glds16(const void* gsrc, unsigned lds_dst) { unsigned keep;
    asm volatile("s_mov_b32 %0, m0\n\ts_mov_b32 m0, %2\n\ts_nop 0\n\tglobal_load_lds_dwordx4 %1, off\n\ts_mov_b32 m0, %0" : "=&s"(keep) : "v"(gsrc), "s"(lds_dst) : "memory"); }
typedef float f32x2_t __attribute__((ext_vector_type(2))); typedef __bf16 bf16x2_t __attribute__((ext_vector_type(2)));
__device__ __forceinline__ unsigned cvtpk_s(float lo, float hi) { f32x2_t v = {lo, hi}; bf16x2_t b = __builtin_convertvector(v, bf16x2_t); return __builtin_bit_cast(unsigned, b); }
typedef __attribute__((address_space(3))) char* ATT_LAS_T;
__device__ __forceinline__ float max3f(float a, float b, float c) { float r; asm("v_max3_f32 %0, %1, %2, %3" : "=v"(r) : "v"(a), "v"(b), "v"(c)); return r; }
__device__ __forceinline__ float max2f(float a, float b) { float r; asm("v_max_f32_e32 %0, %1, %2" : "=v"(r) : "v"(a), "v"(b)); return r; }
struct Desc { const bf16* Q; int ldq; const bf16* K0; int ldk0; const bf16* K1; int ldk1; const bf16* V; int ldv; bf16* O; int ldo; };

__device__ __forceinline__ void pv(f32x16* o, int vb, bf16x8 pa0, bf16x8 pa1, bf16x8 pa2, bf16x8 pa3) {
#pragma unroll
    for (int d0 = 0; d0 < 2; ++d0) { s16x4 lo[4], hi[4];
#pragma unroll
        for (int ks = 0; ks < 4; ++ks) {
            asm volatile("ds_read_b64_tr_b16 %0,%1 offset:%c2" : "=&v"(lo[ks]) : "v"(vb), "i"(d0 * 4096 + ks * 1024) : "memory");
            asm volatile("ds_read_b64_tr_b16 %0,%1 offset:%c2" : "=&v"(hi[ks]) : "v"(vb), "i"(d0 * 4096 + ks * 1024 + 512) : "memory"); }
        asm volatile("s_waitcnt lgkmcnt(0)" ::: "memory"); __builtin_amdgcn_sched_barrier(0);
#define ATT_PK(k) (bf16x8){lo[k][0], lo[k][1], lo[k][2], lo[k][3], hi[k][0], hi[k][1], hi[k][2], hi[k][3]}
        o[d0] = __builtin_amdgcn_mfma_f32_32x32x16_bf16(pa0, ATT_PK(0), o[d0], 0, 0, 0);
        o[d0] = __builtin_amdgcn_mfma_f32_32x32x16_bf16(pa1, ATT_PK(1), o[d0], 0, 0, 0);
        o[d0] = __builtin_amdgcn_mfma_f32_32x32x16_bf16(pa2, ATT_PK(2), o[d0], 0, 0, 0);
        o[d0] = __builtin_amdgcn_mfma_f32_32x32x16_bf16(pa3, ATT_PK(3), o[d0], 0, 0, 0);
#undef ATT_PK
    }
}
#define ATT_LAS __attribute__((address_space(3)))
template <int DQK, int MODE> __device__ __forceinline__ void unit(const Desc& d, int q0, ATT_LAS char* shm, const float* biasg, float sinkl2) {
    constexpr int NCH = DQK / 8, KSLOT = DQK * 128, ND0 = DQK / 16; constexpr float THR = 8.0f, NEGBIG = -1e30f;
    const int tid = lautid(), lane = tid & 63, r32 = lane & 31, hi = lane >> 5; const int wid = __builtin_amdgcn_readfirstlane(tid >> 6);
    const unsigned lds0 = (unsigned)(uintptr_t)shm;
    ATT_LAS float* wsf = (ATT_LAS float*)(shm + LDS_WS) + wid * 64;
    ATT_LAS float* bias_l = (ATT_LAS float*)(shm + LDS_BIAS);
    const int qw = q0 + wid * 32;
    int t0 = 0, t1 = 32, wt0 = 0, wt1 = 32;
    if (MODE == 1) { t0 = q0 >= 128 ? (q0 - 128) >> 6 : 0; t1 = ((q0 + 383) >> 6) + 1; if (t1 > 32) t1 = 32;
                     wt0 = qw >= 128 ? (qw - 128) >> 6 : 0; wt1 = ((qw + 159) >> 6) + 1; if (wt1 > 32) wt1 = 32; }
#define ATT_DMA(t, bsel) do { \
        _Pragma("unroll") for (int c_ = 0; c_ < 2; ++c_) { const int ch_ = wid + 8 * c_; if (ch_ < NCH) { \
            const bf16* s_ = (ch_ < 8) ? d.K0 + (size_t)((t) * 64 + lane) * d.ldk0 + ch_ * 8 : d.K1 + (size_t)((t) * 64 + lane) * d.ldk1 + (ch_ - 8) * 8; \
            glds16(s_, (unsigned)__builtin_amdgcn_readfirstlane(lds0 + LDS_K + (bsel) * KSLOT + ch_ * 1024)); } } \
        { const bf16* v_ = d.V + (size_t)((t) * 64 + 16 * (wid & 3) + (lane >> 2)) * d.ldv + (wid >> 2) * 32 + (lane & 3) * 8; \
          glds16(v_, (unsigned)__builtin_amdgcn_readfirstlane(lds0 + LDS_V + (bsel) * 8192 + wid * 1024)); } } while (0)
    if (MODE == 1) { const int idx = tid - 128; bias_l[tid] = (idx >= 0 && idx <= 256) ? biasg[idx] : NEGBIG; }
    ATT_DMA(t0, 0);
    bf16x8 qr[ND0];
    { const bf16* Qw = d.Q + (size_t)(qw + r32) * d.ldq + hi * 8;
#pragma unroll
      for (int d0 = 0; d0 < ND0; ++d0) qr[d0] = GL(bf16x8, Qw + d0 * 16); }
    float mhat = 0.f, l_reg = 0.f; f32x16 o[2]; o[0] = f32x16{}; o[1] = f32x16{}; f32x16 negm = f32x16{};
    constexpr bool MSUM = true;
    f32x16 lacc = f32x16{}; const bf16x8 ones8 = (bf16x8){0x3f80, 0x3f80, 0x3f80, 0x3f80, 0x3f80, 0x3f80, 0x3f80, 0x3f80};
    const int vb0 = (int)(lds0 + LDS_V) + ((lane >> 4) & 1) * 32 + (lane & 3) * 8 + (4 * hi + ((lane & 15) >> 2)) * 64;
    int buf = 0;
    for (int t = t0; t < t1; ++t) {
        asm volatile("s_waitcnt vmcnt(0) lgkmcnt(0)\n\ts_barrier" ::: "memory");
        if (t + 1 < t1) ATT_DMA(t + 1, buf ^ 1);
        const bool active = (MODE == 0) || (t >= wt0 && t < wt1);
        if (active) {
            f32x16 p0, p1;
            { const ATT_LAS char* kb = shm + LDS_K + buf * KSLOT + hi * 1024 + r32 * 16;
#pragma unroll
              for (int d0 = 0; d0 < ND0; ++d0) {
                  const bf16x8 b0 = *(const ATT_LAS bf16x8*)(kb + d0 * 2048);
                  const bf16x8 b1 = *(const ATT_LAS bf16x8*)(kb + d0 * 2048 + 512);
                  if (d0 == 0) { p0 = __builtin_amdgcn_mfma_f32_32x32x16_bf16(b0, qr[0], negm, 0, 0, 0); p1 = __builtin_amdgcn_mfma_f32_32x32x16_bf16(b1, qr[0], negm, 0, 0, 0); }
                  else { p0 = __builtin_amdgcn_mfma_f32_32x32x16_bf16(b0, qr[d0], p0, 0, 0, 0); p1 = __builtin_amdgcn_mfma_f32_32x32x16_bf16(b1, qr[d0], p1, 0, 0, 0); } } }
            if (MODE == 1) {
                const ATT_LAS float* bp = bias_l + (64 * t - (qw + r32) + 256 + 4 * hi);
#pragma unroll
                for (int r = 0; r < 16; ++r) { p0[r] += bp[(r & 3) + 8 * (r >> 2)]; p1[r] += bp[(r & 3) + 8 * (r >> 2) + 32]; }
            }
            asm volatile("s_nop 15\n\ts_nop 7" : "+v"(p0), "+v"(p1));
            float rm, rmb;
            rm = max3f(p0[0], p0[1], p1[0]); rmb = max3f(p0[2], p0[3], p1[1]); rm = max3f(rm, p1[2], p1[3]);
#pragma unroll
            for (int r = 4; r < 16; r += 4) { rm = max3f(rm, p0[r], p0[r + 1]); rmb = max3f(rmb, p0[r + 2], p0[r + 3]); rm = max3f(rm, p1[r], p1[r + 1]); rmb = max3f(rmb, p1[r + 2], p1[r + 3]); }
            rm = max2f(rm, rmb);
            { auto rr = __builtin_amdgcn_permlane32_swap(__float_as_uint(rm), __float_as_uint(rm), false, false); rm = max2f(__uint_as_float(rr[0]), __uint_as_float(rr[1])); }
            const bool first = (t == wt0);
            if (first) {
                mhat = rm;
#pragma unroll
                for (int r = 0; r < 16; ++r) { p0[r] -= rm; p1[r] -= rm; }
#pragma unroll
                for (int r = 0; r < 16; ++r) negm[r] = -mhat;
            } else if (__any(rm > THR)) {
                const float dl = fmaxf(rm, 0.f); mhat += dl;
#pragma unroll
                for (int r = 0; r < 16; ++r) { p0[r] -= dl; p1[r] -= dl; }
#pragma unroll
                for (int r = 0; r < 16; ++r) negm[r] = -mhat;
                const float f = __builtin_amdgcn_exp2f(-dl); l_reg *= f; if (hi == 0) wsf[r32] = f;
                asm volatile("s_waitcnt lgkmcnt(0)" ::: "memory");
#pragma unroll
                for (int d_ = 0; d_ < 2; ++d_)
#pragma unroll
                    for (int r = 0; r < 16; ++r) o[d_][r] *= wsf[crow(r, hi)];
                if (MSUM) {
#pragma unroll
                    for (int r = 0; r < 16; ++r) lacc[r] *= wsf[crow(r, hi)];
                }
                asm volatile("s_waitcnt lgkmcnt(0)" ::: "memory");
            }
            if (MSUM) {
#pragma unroll
                for (int r = 0; r < 16; ++r) { p0[r] = __builtin_amdgcn_exp2f(p0[r]); p1[r] = __builtin_amdgcn_exp2f(p1[r]); }
            } else {
                float sacc = 0.f;
#pragma unroll
                for (int r = 0; r < 16; ++r) { p0[r] = __builtin_amdgcn_exp2f(p0[r]); p1[r] = __builtin_amdgcn_exp2f(p1[r]); sacc += p0[r] + p1[r]; }
                l_reg += sacc;
            }
            u32x4 pw0, pw1, pw2, pw3;
            pw0 = (u32x4){cvtpk_s(p0[0], p0[1]), cvtpk_s(p0[2], p0[3]), cvtpk_s(p0[4], p0[5]), cvtpk_s(p0[6], p0[7])};
            pw1 = (u32x4){cvtpk_s(p0[8], p0[9]), cvtpk_s(p0[10], p0[11]), cvtpk_s(p0[12], p0[13]), cvtpk_s(p0[14], p0[15])};
            pw2 = (u32x4){cvtpk_s(p1[0], p1[1]), cvtpk_s(p1[2], p1[3]), cvtpk_s(p1[4], p1[5]), cvtpk_s(p1[6], p1[7])};
            pw3 = (u32x4){cvtpk_s(p1[8], p1[9]), cvtpk_s(p1[10], p1[11]), cvtpk_s(p1[12], p1[13]), cvtpk_s(p1[14], p1[15])};
            pv(o, vb0 + buf * 8192, __builtin_bit_cast(bf16x8, pw0), __builtin_bit_cast(bf16x8, pw1), __builtin_bit_cast(bf16x8, pw2), __builtin_bit_cast(bf16x8, pw3));
            if (MSUM) {
                lacc = __builtin_amdgcn_mfma_f32_32x32x16_bf16(__builtin_bit_cast(bf16x8, pw0), ones8, lacc, 0, 0, 0);
                lacc = __builtin_amdgcn_mfma_f32_32x32x16_bf16(__builtin_bit_cast(bf16x8, pw1), ones8, lacc, 0, 0, 0);
                lacc = __builtin_amdgcn_mfma_f32_32x32x16_bf16(__builtin_bit_cast(bf16x8, pw2), ones8, lacc, 0, 0, 0);
                lacc = __builtin_amdgcn_mfma_f32_32x32x16_bf16(__builtin_bit_cast(bf16x8, pw3), ones8, lacc, 0, 0, 0);
            }
        }
        buf ^= 1;
    }
    float rli[16];
    if (MSUM) {
        if (MODE == 1) { if (hi == 0) wsf[32 + r32] = __builtin_amdgcn_exp2f(sinkl2 - mhat); asm volatile("s_waitcnt lgkmcnt(0)" ::: "memory"); }
#pragma unroll
        for (int r = 0; r < 16; ++r) rli[r] = __builtin_amdgcn_rcpf(lacc[r] + (MODE == 1 ? wsf[32 + crow(r, hi)] : 0.f));
    } else {
        { auto rr = __builtin_amdgcn_permlane32_swap(__float_as_uint(l_reg), __float_as_uint(l_reg), false, false); l_reg = __uint_as_float(rr[0]) + __uint_as_float(rr[1]); }
        if (MODE == 1) l_reg += __builtin_amdgcn_exp2f(sinkl2 - mhat);
        if (hi == 0) wsf[32 + r32] = l_reg; asm volatile("s_waitcnt lgkmcnt(0)" ::: "memory");
#pragma unroll
        for (int r = 0; r < 16; ++r) rli[r] = __builtin_amdgcn_rcpf(wsf[32 + crow(r, hi)]);
    }
    bf16* Ow = d.O + (size_t)qw * d.ldo;
    { ATT_LAS bf16* stg = (ATT_LAS bf16*)(shm + LDS_OST) + wid * 2048;
#pragma unroll
      for (int r = 0; r < 16; ++r) { const int orow = crow(r, hi);
#pragma unroll
          for (int d0 = 0; d0 < 2; ++d0) { const unsigned w = cvtpk_s(o[d0][r] * rli[r], 0.f); stg[orow * 64 + d0 * 32 + r32] = (bf16)(w & 0xffffu); } }
      asm volatile("s_waitcnt lgkmcnt(0)" ::: "memory");
#pragma unroll
      for (int i = 0; i < 4; ++i) { const int row = i * 8 + (lane >> 3), ch = lane & 7; const u32x4 v = *(const ATT_LAS u32x4*)(stg + row * 64 + ch * 8); GS(u32x4, Ow + (size_t)row * d.ldo + ch * 8) = v; } }
    asm volatile("s_waitcnt lgkmcnt(0)\n\ts_barrier" ::: "memory");
#undef ATT_DMA
}
}
#define GAS __attribute__((address_space(1)))
#define LAS __attribute__((address_space(3)))
typedef unsigned short bf16;
typedef unsigned v4u __attribute__((ext_vector_type(4)));
typedef float f32x4 __attribute__((ext_vector_type(4)));
typedef float f32x16 __attribute__((ext_vector_type(16)));
constexpr int NWAVES = 8;
constexpr int LDS_BYTES = 147456;
constexpr size_t MiB = 1u << 20;
constexpr size_t WS_MODS = 0;
constexpr size_t WS_SHW = 3 * MiB;
constexpr size_t SHW_L = (size_t)32 * (NGU + NIN + NGU) * 4;
constexpr size_t WS_ROWSS = 8 * MiB;
constexpr size_t WS_RSTD = 13 * MiB;
constexpr size_t WS_CS = 12 * MiB, WS_SN = WS_CS + 131072;
constexpr size_t WS_BIAS = WS_SN + 131072;
constexpr size_t WS_CTL = 15 * MiB, CTL_BYTES = 16384;
constexpr size_t WS_W = 16 * MiB, W_LAYER = 48 * MiB;
constexpr size_t W_GU1 = 0, W_DN1 = 11 * MiB, W_GU2 = W_DN1 + 5632 * 1024, W_DN2 = W_GU2 + 11 * MiB, W_IN = 33 * MiB, W_QUP = W_IN + (size_t)NIN * 1024 * 2, W_KVUP = W_QUP + 262144, W_BR = 43 * MiB, W_OUT = 45 * MiB;
constexpr size_t WS_AP = 112 * MiB;
constexpr size_t WS_YS = 240 * MiB;
constexpr size_t WS_QC = 464 * MiB;
constexpr size_t WS_KVC = 512 * MiB;
constexpr size_t WS_YG = 576 * MiB;
constexpr size_t WS_H = 240 * MiB;
constexpr size_t WS_MG = 240 * MiB;
constexpr size_t WS_END = 960 * MiB;
static_assert(W_DN2 + 5632 * 1024 <= W_IN && W_KVUP + 131072 <= W_BR && W_OUT + 2 * MiB <= W_LAYER && WS_W + 2 * W_LAYER <= WS_AP, "weight map");
static_assert(WS_H + (size_t)MTOK * FF * 2 <= WS_YG + 3 * (size_t)MTOK * DM * 2 && WS_MG + (size_t)MTOK * DM * 4 <= WS_KVC && WS_SHW + 2 * SHW_L <= WS_ROWSS, "ws map");

struct Args { const float* in[25]; float* out; unsigned char* ws; };
__device__ __forceinline__ int lauint(int k) { asm volatile("" : "+s"(k)); return k; }
__device__ __forceinline__ unsigned char* lau(unsigned char* p) { asm volatile("" : "+s"(p)); return p; }

__device__ __forceinline__ unsigned f2bf(float f) { unsigned u = __builtin_bit_cast(unsigned, f); return (u + 0x7fffu + ((u >> 16) & 1u)) >> 16; }
__device__ __forceinline__ unsigned pk2(float lo, float hi) { return f2bf(lo) | (f2bf(hi) << 16); }
__device__ __forceinline__ float bflo(unsigned w) { return __uint_as_float(w << 16); }
__device__ __forceinline__ float bfhi(unsigned w) { return __uint_as_float(w & 0xffff0000u); }
__device__ __forceinline__ float wave_sum(float v) {
#pragma unroll
    for (int o = 1; o < 64; o <<= 1) v += __shfl_xor(v, o);
    return v;
}
__device__ __forceinline__ void tr_item(const float* W, int N, int k0, int n0, bf16* WT, int ldk, int drow0, int dk0, const float* kscale, LAS float* scr, int lane) {
#pragma unroll
    for (int i = 0; i < 32; ++i) { const int kk = 2 * i + (lane >> 5); float v = W[(size_t)(k0 + kk) * N + n0 + (lane & 31)]; if (kscale) v *= kscale[k0 + kk]; scr[kk * 33 + (lane & 31)] = v; }
    asm volatile("s_waitcnt lgkmcnt(0)" ::: "memory");
    const int c = lane & 7;
#pragma unroll
    for (int j = 0; j < 4; ++j) { const int n = (lane >> 3) + 8 * j; const LAS float* s = scr + (8 * c) * 33 + n;
        v4u o; o.x = pk2(s[0 * 33], s[1 * 33]); o.y = pk2(s[2 * 33], s[3 * 33]); o.z = pk2(s[4 * 33], s[5 * 33]); o.w = pk2(s[6 * 33], s[7 * 33]);
        GS(v4u, WT + (size_t)(drow0 + n) * ldk + dk0 + k0 + 8 * c) = o; }
    asm volatile("s_waitcnt lgkmcnt(0)" ::: "memory");
}
__device__ __forceinline__ void tr_matrix(const float* W, int K, int N, bf16* WT, int ldk, int dk0, int remap, const float* kscale, LAS float* scr, int lane, int gw, int NGW) {
    const int nblk = N / 32, items = (K / 64) * nblk;
    for (int it = gw; it < items; it += NGW) {
        const int kb = it / nblk, nb = it - kb * nblk, n0 = nb * 32;
        int dr = n0;
        if (remap == 1) dr = (n0 < FF) ? (n0 / 128) * 256 + (n0 % 128) : ((n0 - FF) / 128) * 256 + 128 + ((n0 - FF) % 128);
        else if (remap == 2) dr = (n0 < 1696) ? n0 : n0 + 96;
        tr_item(W, N, kb * 64, n0, WT, ldk, dr, dk0, kscale, scr, lane);
    }
}
__device__ __forceinline__ void sg_item(const float* in, int in_stride, bool do_silu, const float* W, int N, int n0, float* out, int out_stride, int dcol0, const float* bias, int lane) {
    const int i = lane & 31, hi = lane >> 5;
    f32x16 acc = f32x16{};
    const float* ip = in + (size_t)i * in_stride + 4 * hi;
    const float* wp = W + (size_t)(4 * hi) * N + n0 + i;
#pragma unroll 4
    for (int k0 = 0; k0 < 1024; k0 += 8) {
        f32x4 a = GL(f32x4, ip + k0);
        if (do_silu) { a[0] = a[0] / (1.0f + __expf(-a[0])); a[1] = a[1] / (1.0f + __expf(-a[1])); a[2] = a[2] / (1.0f + __expf(-a[2])); a[3] = a[3] / (1.0f + __expf(-a[3])); }
        const float b0 = wp[(size_t)(k0 + 0) * N], b1 = wp[(size_t)(k0 + 1) * N], b2 = wp[(size_t)(k0 + 2) * N], b3 = wp[(size_t)(k0 + 3) * N];
        acc = __builtin_amdgcn_mfma_f32_32x32x2f32(a[0], b0, acc, 0, 0, 0);
        acc = __builtin_amdgcn_mfma_f32_32x32x2f32(a[1], b1, acc, 0, 0, 0);
        acc = __builtin_amdgcn_mfma_f32_32x32x2f32(a[2], b2, acc, 0, 0, 0);
        acc = __builtin_amdgcn_mfma_f32_32x32x2f32(a[3], b3, acc, 0, 0, 0);
    }
    const float bv = bias ? bias[n0 + i] : 0.f;
#pragma unroll
    for (int r = 0; r < 16; ++r) { const int b = (r & 3) + 8 * (r >> 2) + 4 * hi; out[(size_t)b * out_stride + dcol0 + i] = acc[r] + bv; }
}
__device__ __forceinline__ void sincos_d(float af, float& sv, float& cv) {
    const double a = (double)af; const double kq = rint(a * 0.63661977236758134308); const double r = (a - kq * 1.57079632679489655800) - kq * 6.123233995736766e-17;
    const double r2 = r * r;
    const double s = r * (1.0 - r2 * (1.0 / 6.0 - r2 * (1.0 / 120.0 - r2 * (1.0 / 5040.0 - r2 * (1.0 / 362880.0 - r2 * (1.0 / 39916800.0 - r2 * (1.0 / 6227020800.0 - r2 * (1.0 / 1307674368000.0))))))));
    const double c = 1.0 - r2 * (0.5 - r2 * (1.0 / 24.0 - r2 * (1.0 / 720.0 - r2 * (1.0 / 40320.0 - r2 * (1.0 / 3628800.0 - r2 * (1.0 / 479001600.0 - r2 * (1.0 / 87178291200.0 - r2 * (1.0 / 20922789888000.0))))))));
    const int q = ((int)kq) & 3;
    const double ss = (q == 0) ? s : (q == 1) ? c : (q == 2) ? -s : -c;
    const double cc = (q == 0) ? c : (q == 1) ? -s : (q == 2) ? -c : s;
    sv = (float)ss; cv = (float)cc;
}
#define XB_TMO      128
#define XB_XCNT(j)  (256  + 64 * (j))
#define XB_XSUB(j)  (1280 + 64 * (j))
#define XB_XGEN(j)  (2304 + 64 * (j))
#define XB_TOP      3328
#define XB_TOPGEN   3392
#define XCD_BAR_WORDS 3456
#define XB_SPIN_CAP (1u << 18)

__device__ __forceinline__ unsigned xb_ld(unsigned* p)              { return __hip_atomic_load(p, __ATOMIC_RELAXED, __HIP_MEMORY_SCOPE_AGENT); }
__device__ __forceinline__ unsigned xb_add(unsigned* p, unsigned v) { return __hip_atomic_fetch_add(p, v, __ATOMIC_RELAXED, __HIP_MEMORY_SCOPE_AGENT); }
__device__ __forceinline__ unsigned xb_xcc_id() { return (unsigned)__builtin_amdgcn_s_getreg((3 << 11) | 20) & 0xFu; }
#define XB_SPIN(cond, bar) do { unsigned _sp = 0; while (cond) { __builtin_amdgcn_s_sleep(1); \
    if ((++_sp & 255u) == 0u) { if (xb_ld(&(bar)[XB_TMO])) break; if (_sp > XB_SPIN_CAP) { atomicAdd(&(bar)[XB_TMO], 1u); break; } } } } while (0)

struct XcdBarrier {
    unsigned* bar; unsigned x;
    volatile LAS unsigned* st;
};

__device__ __forceinline__ XcdBarrier xcd_barrier_post(unsigned* bar, volatile LAS unsigned* st) {
    XcdBarrier b; b.bar = bar; b.x = (unsigned)__builtin_amdgcn_readfirstlane((int)xb_xcc_id()); b.st = st;
    if (threadIdx.x == 0) (void)xb_add(&bar[XB_XCNT(b.x)], 1u);
    return b;
}
__device__ __forceinline__ void xcd_barrier_complete(unsigned* bar, unsigned x, unsigned& nloc, unsigned& nx) {
    const unsigned G = gridDim.x * gridDim.y * gridDim.z;
    unsigned sum, cnt, mine, sp = 0u;
    for (;;) {
        sum = 0u; cnt = 0u; mine = 0u;
#pragma unroll
        for (unsigned j = 0; j < 16; ++j) { const unsigned c = xb_ld(&bar[XB_XCNT(j)]); sum += c; cnt += (c > 0u) ? 1u : 0u; mine = (j == x) ? c : mine; }
        if (sum == G) break;
        __builtin_amdgcn_s_sleep(1);
        if ((++sp & 255u) == 0u) { if (xb_ld(&bar[XB_TMO])) break; if (sp > XB_SPIN_CAP) { atomicAdd(&bar[XB_TMO], 1u); break; } }
    }
    nloc = mine > 0u ? mine : 1u; nx = cnt > 0u ? cnt : 1u;
}

__device__ __forceinline__ void xcd_barrier(const XcdBarrier& b) {
    asm volatile("s_waitcnt vmcnt(0)" ::: "memory");
    __syncthreads();
    if (threadIdx.x == 0) {
        unsigned* bar = b.bar;
        __builtin_amdgcn_s_waitcnt(0);
        unsigned nloc = b.st[0], nx = b.st[1];
        if (nloc == 0u) { xcd_barrier_complete(bar, b.x, nloc, nx); b.st[0] = nloc; b.st[1] = nx; }
        const unsigned old = xb_add(&bar[XB_XSUB(b.x)], 1u);
        const unsigned gen = old / nloc;
        if (old + 1u == (gen + 1u) * nloc) {
            __builtin_amdgcn_fence(__ATOMIC_RELEASE, "agent");
            asm volatile("s_waitcnt vmcnt(0)" ::: "memory");
            const unsigned og = xb_add(&bar[XB_TOP], 1u);
            const unsigned tg = og / nx;
            if (og + 1u == (tg + 1u) * nx) xb_add(&bar[XB_TOPGEN], 1u);
            else XB_SPIN(xb_ld(&bar[XB_TOPGEN]) == tg, bar);
            __builtin_amdgcn_fence(__ATOMIC_ACQUIRE, "agent");
            xb_add(&bar[XB_XGEN(b.x)], 1u);
            asm volatile("s_waitcnt vmcnt(0)" ::: "memory");
        } else {
            XB_SPIN(xb_ld(&bar[XB_XGEN(b.x)]) == gen, bar);
            __builtin_amdgcn_fence(__ATOMIC_ACQUIRE, "agent");
            asm volatile("s_waitcnt vmcnt(0)" ::: "memory");
        }
    }
    __syncthreads();
}

#ifndef PHMASK
#define PHMASK 0x1FFF
#endif
#define PH_ON(k) (((PHMASK) >> (k)) & 1)
#define INP(k) (args.in[lauint(k)])
__global__ void __launch_bounds__(NWAVES * 64, 2) mega_fwd(Args args) {
    extern __shared__ __attribute__((aligned(16))) unsigned char lds[];
    cg::grid_group grid = cg::this_grid();
    const int G = gridDim.x, bx = blockIdx.x;
    const int vcu = (G % 8 == 0) ? (bx % 8) * (G / 8) + bx / 8 : bx;
    const int NGW = G * NWAVES;
    volatile LAS unsigned* MISC = (volatile LAS unsigned*)((LAS unsigned char*)lds + 131072 + 320);
    if (threadIdx.x < 32) MISC[threadIdx.x] = 0u;
    __syncthreads();
    XcdBarrier xbar = xcd_barrier_post((unsigned*)(args.ws + WS_CTL), MISC + 8);
#define GRID_BAR() do { XcdBarrier bb_ = xbar; bb_.bar = (unsigned*)lau((unsigned char*)bb_.bar); bb_.x = (unsigned)lauint((int)bb_.x); xcd_barrier(bb_); } while (0)
#define PTRS const int tid = lautid(), lane = tid & 63, wave = __builtin_amdgcn_readfirstlane(tid >> 6), gw = vcu * NWAVES + wave; (void)lane; (void)gw; unsigned char* ws = lau(args.ws); float* X = (float*)lau((unsigned char*)args.out); (void)X; \
    float* mods = (float*)(ws + WS_MODS); float* rowss = (float*)(ws + WS_ROWSS); float* rstdv = (float*)(ws + WS_RSTD); (void)rstdv; float* cs = (float*)(ws + WS_CS); float* sn = (float*)(ws + WS_SN); float* biasT = (float*)(ws + WS_BIAS); \
    bf16* AP = (bf16*)(ws + WS_AP); bf16* YS = (bf16*)(ws + WS_YS); bf16* QC = (bf16*)(ws + WS_QC); bf16* KVC = (bf16*)(ws + WS_KVC); bf16* YG = (bf16*)(ws + WS_YG); bf16* HB = (bf16*)(ws + WS_H); float* MG = (float*)(ws + WS_MG); \
    (void)mods; (void)rowss; (void)cs; (void)sn; (void)biasT; (void)AP; (void)YS; (void)QC; (void)KVC; (void)YG; (void)HB; (void)MG; \
    unsigned char* wl = ws + WS_W + (size_t)l * W_LAYER; const float* ml = mods + (size_t)l * NB * NMOD; const float* shw = (const float*)(ws + WS_SHW + (size_t)l * SHW_L); (void)wl; (void)ml; (void)shw;
    LAS unsigned char* ldsl = (LAS unsigned char*)lds;

    if (PH_ON(0)) {
        const int l = 0; PTRS
        for (int it = gw; it < 2 * (NMOD / 32); it += NGW) { const int l = it / (NMOD / 32), n0 = (it % (NMOD / 32)) * 32;
            sg_item(INP(1), DM, true, INP(2) + (size_t)l * DM * NMOD, NMOD, n0, mods + (size_t)l * NB * NMOD, NMOD, n0, INP(3) + (size_t)l * NMOD, lane); }
        for (int e = bx * 512 + tid; e < 2048 * 16; e += G * 512) { const int p = e >> 4, i = e & 15; const float inv = powf(10000.0f, -(float)(2 * i) / 32.0f); const float ang = (float)p * inv; float s, c; sincos_d(ang, s, c); cs[e] = c; sn[e] = s; }
        for (int e = bx * 512 + tid; e < 6 * 257; e += G * 512) { const int h = e / 257, idx = e % 257, rel = idx - 128, n = rel < 0 ? -rel : rel;
            int bk = rel > 0 ? 16 : 0; if (n < 8) bk += n; else { int lg = 31 - __clz(n * n); int large = 2 + lg; if (large > 15) large = 15; bk += large; }
            biasT[h * 260 + idx] = INP(12)[bk * 6 + h] * LOG2E; }
        LAS float* scr = (LAS float*)(ldsl + wave * 16384);
#pragma unroll 1
        for (int l2 = 0; l2 < 2; ++l2) { const int l = l2;
            unsigned char* wl = ws + WS_W + (size_t)l * W_LAYER;
            tr_matrix(INP(5) + (size_t)l * DM * NGU, DM, NGU, (bf16*)(wl + W_GU1), DM, 0, 1, nullptr, scr, lane, gw, NGW);
            tr_matrix(INP(6) + (size_t)l * FF * DM, FF, DM, (bf16*)(wl + W_DN1), FF, 0, 0, nullptr, scr, lane, gw, NGW);
            tr_matrix(INP(22) + (size_t)l * DM * NGU, DM, NGU, (bf16*)(wl + W_GU2), DM, 0, 1, nullptr, scr, lane, gw, NGW);
            tr_matrix(INP(23) + (size_t)l * FF * DM, FF, DM, (bf16*)(wl + W_DN2), FF, 0, 0, nullptr, scr, lane, gw, NGW);
            tr_matrix(INP(8) + (size_t)l * DM * 4768, DM, 4768, (bf16*)(wl + W_IN), DM, 0, 2, nullptr, scr, lane, gw, NGW);
            tr_matrix(INP(14) + (size_t)l * 256 * 384, 256, 384, (bf16*)(wl + W_QUP), 256, 0, 0, INP(13) + l * 256, scr, lane, gw, NGW);
            tr_matrix(INP(16) + (size_t)l * 128 * 512, 128, 512, (bf16*)(wl + W_KVUP), 128, 0, 0, INP(15) + l * 128, scr, lane, gw, NGW);
            tr_matrix(INP(17) + (size_t)l * 384 * DM, 384, DM, (bf16*)(wl + W_BR), DM, 0, 0, nullptr, scr, lane, gw, NGW);
            tr_matrix(INP(18) + (size_t)l * 384 * DM, 384, DM, (bf16*)(wl + W_BR), DM, 384, 0, nullptr, scr, lane, gw, NGW);
            tr_matrix(INP(19) + (size_t)l * 256 * DM, 256, DM, (bf16*)(wl + W_BR), DM, 768, 0, nullptr, scr, lane, gw, NGW);
            tr_matrix(INP(20) + (size_t)l * DM * DM, DM, DM, (bf16*)(wl + W_OUT), DM, 0, 0, nullptr, scr, lane, gw, NGW);
            for (int e = bx * 512 + tid; e < 96 * 1024 / 8; e += G * 512) ((v4u*)(wl + W_IN + (size_t)1696 * 1024 * 2))[e] = (v4u){0u, 0u, 0u, 0u};
            for (int e = bx * 512 + tid; e < 128 * 256 / 8; e += G * 512) ((v4u*)(wl + W_QUP + (size_t)384 * 256 * 2))[e] = (v4u){0u, 0u, 0u, 0u};
        }
    }
    grid.sync();
    if (PH_ON(1)) {
        const int l = 0; PTRS
#pragma unroll 1
        for (int l2 = 0; l2 < 2; ++l2) { const int l = l2;
            float* shw = (float*)(ws + WS_SHW + (size_t)l * SHW_L); const float* ml = mods + (size_t)l * NB * NMOD;
            for (int it = gw; it < (NGU + 4768 + NGU) / 32; it += NGW) {
                int n0 = it * 32;
                if (n0 < NGU) { const int dr = (n0 < FF) ? (n0 / 128) * 256 + (n0 % 128) : ((n0 - FF) / 128) * 256 + 128 + ((n0 - FF) % 128);
                    sg_item(ml + 0 * DM, NMOD, false, INP(5) + (size_t)l * DM * NGU, NGU, n0, shw, NGU, dr, nullptr, lane); continue; }
                n0 -= NGU;
                if (n0 < 4768) { const int dr = (n0 < 1696) ? n0 : n0 + 96;
                    sg_item(ml + 3 * DM, NMOD, false, INP(8) + (size_t)l * DM * 4768, 4768, n0, shw + 32 * NGU, NIN, dr, nullptr, lane); continue; }
                n0 -= 4768;
                { const int dr = (n0 < FF) ? (n0 / 128) * 256 + (n0 % 128) : ((n0 - FF) / 128) * 256 + 128 + ((n0 - FF) % 128);
                    sg_item(ml + 6 * DM, NMOD, false, INP(22) + (size_t)l * DM * NGU, NGU, n0, shw + 32 * NGU + 32 * NIN, NGU, dr, nullptr, lane); }
            }
        }
        const float* gain = INP(4);
#pragma unroll 2
        for (int m = gw; m < MTOK; m += NGW) {
            const int b = m >> 11; const f32x4* xr = (const f32x4*)(INP(0) + (size_t)m * DM) + lane; const float* scp = mods + (size_t)b * NMOD + 1 * DM;
            f32x4 v[4]; float s = 0.f;
#pragma unroll
            for (int j = 0; j < 4; ++j) { v[j] = xr[64 * j]; s += (v[j][0] * v[j][0] + v[j][1] * v[j][1]) + (v[j][2] * v[j][2] + v[j][3] * v[j][3]); }
            s = wave_sum(s);
            if (lane < 16) rowss[(size_t)m * 16 + lane] = lane == 0 ? s : 0.f;
            unsigned long long* o8 = (unsigned long long*)(AP + (size_t)m * DM) + lane;
#pragma unroll
            for (int j = 0; j < 4; ++j) { const int col = 4 * lane + 256 * j; const f32x4 g = GL(f32x4, gain + col), sc = GL(f32x4, scp + col); const f32x4 y = v[j] * g * (sc + 1.0f);
                o8[64 * j] = (unsigned long long)pk2(y[0], y[1]) | ((unsigned long long)pk2(y[2], y[3]) << 32); }
        }
    }
    GRID_BAR();

#pragma unroll 1
    for (int ph = 0; ph < 26; ++ph) {
        const int l = ph >= 13 ? 1 : 0, k = ph - 13 * l, f = k >= 10 ? 1 : 0;
        if ((k == 0 || k == 3 || k == 10) && PH_ON(12)) { PTRS  for (int row = bx * 512 + tid; row < MTOK; row += G * 512) { const f32x4 a = GL(f32x4, rowss + (size_t)row * 16), b = GL(f32x4, rowss + (size_t)row * 16 + 4), c = GL(f32x4, rowss + (size_t)row * 16 + 8), d = GL(f32x4, rowss + (size_t)row * 16 + 12); const float sq = ((a[0] + a[1]) + (a[2] + a[3])) + ((b[0] + b[1]) + (b[2] + b[3])) + ((c[0] + c[1]) + (c[2] + c[3])) + ((d[0] + d[1]) + (d[2] + d[3])); rstdv[row] = 1.0f / sqrtf(sq * (1.0f / 1024.0f) + EPS); } }
        {
            {
                if (k == 4 && PH_ON(2)) { PTRS   pg8::Gemm g{AP, (const bf16*)(wl + W_IN), DM, DM}; pg8::Order S; S.init(MTOK, NIN, G, bx, DM / 64, 0);
                  pg8::EpiIn E{YS, YG, rstdv, shw + 32 * NGU};
                  pg8::gemm_phase<pg8::EpiIn, pg8::Order, true, true>(ldsl, g, S, E); }
                if (k == 5 && PH_ON(3)) { PTRS
                    const float* gq = INP(9) + l * 64; const float* gk = INP(10) + l * 64;
#pragma unroll 2
                    for (int m = gw; m < MTOK; m += NGW) {
                        const int t = m & (SEQ - 1), rp = t >> 6, cp = t & 63;
                        bf16* yr = YS + (size_t)m * NYS;
                        const v4u w1 = GL(v4u, yr + lane * 8), w2 = GL(v4u, yr + 1280 + lane * 8);
                        { float v[8] = {bflo(w1.x), bfhi(w1.x), bflo(w1.y), bfhi(w1.y), bflo(w1.z), bfhi(w1.z), bflo(w1.w), bfhi(w1.w)};
                          const int hh = lane >> 3, j = lane & 7;
                          float ss = 0.f;
#pragma unroll
                          for (int e = 0; e < 8; ++e) ss += v[e] * v[e];
                          ss += __shfl_xor(ss, 1); ss += __shfl_xor(ss, 2); ss += __shfl_xor(ss, 4);
                          const float rstd = 1.0f / sqrtf(ss * (1.0f / 64.0f) + EPS);
                          const float* gp = (hh < 6 ? gq : gk) + j * 8;
                          const int pos = (j < 4) ? rp : cp; const float* cp_ = cs + pos * 16 + (j & 1) * 8; const float* sp_ = sn + pos * 16 + (j & 1) * 8;
                          const float osc = hh < 6 ? C2A : 1.0f; float o[8];
#pragma unroll
                          for (int e = 0; e < 8; ++e) { const float a = v[e] * rstd * gp[e]; const float pa = __shfl_xor(a, 2); const float c = cp_[e], s = sp_[e];
                              o[e] = ((j & 2) == 0 ? a * c - pa * s : pa * s + a * c) * osc; }
                          v4u ow; ow.x = pk2(o[0], o[1]); ow.y = pk2(o[2], o[3]); ow.z = pk2(o[4], o[5]); ow.w = pk2(o[6], o[7]);
                          GS(v4u, yr + lane * 8) = ow; }
                        { float v[8] = {bflo(w2.x), bfhi(w2.x), bflo(w2.y), bfhi(w2.y), bflo(w2.z), bfhi(w2.z), bflo(w2.w), bfhi(w2.w)};
                          float ss = 0.f;
#pragma unroll
                          for (int e = 0; e < 8; ++e) ss += v[e] * v[e];
                          ss += __shfl_xor(ss, 1); ss += __shfl_xor(ss, 2); ss += __shfl_xor(ss, 4); ss += __shfl_xor(ss, 8);
                          const float s32 = ss + __shfl_xor(ss, 16);
                          const float rstd = lane < 32 ? 1.0f / sqrtf(s32 * (1.0f / 256.0f) + EPS) : 1.0f / sqrtf(ss * (1.0f / 128.0f) + EPS);
                          const int j = lane & 3; const float* cp_ = cs + t * 16 + (j & 1) * 8; const float* sp_ = sn + t * 16 + (j & 1) * 8;
                          float o[8];
#pragma unroll
                          for (int e = 0; e < 8; ++e) { const float pa = __shfl_xor(v[e], 2); const float c = cp_[e], s = sp_[e];
                              o[e] = lane < 48 ? v[e] * rstd : ((j & 2) == 0 ? v[e] * c - pa * s : pa * s + v[e] * c); }
                          v4u ow; ow.x = pk2(o[0], o[1]); ow.y = pk2(o[2], o[3]); ow.z = pk2(o[4], o[5]); ow.w = pk2(o[6], o[7]);
                          if (lane < 52) GS(v4u, yr + 1280 + lane * 8) = ow; }
                    }
                }
                if (k == 6 && PH_ON(4)) { PTRS  pg8::Gemm g{YS + 1280, (const bf16*)(wl + W_QUP), NYS, 256}; pg8::Order S; S.init(MTOK, 512, G, bx, 4, 0);
                  pg8::EpiQup E{QC, cs, sn};
                  pg8::gemm_phase<pg8::EpiQup, pg8::Order, true, true>(ldsl, g, S, E); }
                if (k == 6 && PH_ON(5)) { PTRS  pg8::Gemm g{YS + 1536, (const bf16*)(wl + W_KVUP), NYS, 128}; pg8::Order S; S.init(MTOK, 512, G, bx, 2, 0);
                  pg8::EpiPlain E{KVC, 512};
                  pg8::gemm_phase<pg8::EpiPlain, pg8::Order, true, true>(ldsl, g, S, E); }
#ifndef ATT_REP
#define ATT_REP 1
#endif
                for (int rep = 0; rep < ATT_REP; ++rep) if (k == 7 && PH_ON(6)) { PTRS
                    const int b = vcu >> 3, jj = vcu & 7; const size_t r0 = (size_t)b * SEQ;
#pragma unroll 1
                    for (int i = 0; i < 6; ++i) { const int e = (jj & 3) * 6 + i, h = (jj >> 2) * 3 + (e >> 3), qb = e & 7, kvh = jj >> 2;
                        att::Desc d{YS + r0 * NYS + h * 64, NYS, YS + r0 * NYS + 384 + kvh * 64, NYS, nullptr, 0, YS + r0 * NYS + 512 + kvh * 64, NYS, AP + r0 * DM + h * 64, DM};
                        att::unit<64, 0>(d, qb * 256, (att::ATT_LAS_T)lds, nullptr, 0.f); }
#pragma unroll 1
                    for (int i = 0; i < 4; ++i) { const int e = jj * 4 + i, h = e >> 3, qb = e & 7;
                        att::Desc d{QC + r0 * 384 + h * 96, 384, KVC + r0 * 512 + h * 128, 512, YS + r0 * NYS + 1664, NYS, KVC + r0 * 512 + h * 128 + 64, 512, AP + r0 * DM + 768 + h * 64, DM};
                        att::unit<96, 0>(d, qb * 256, (att::ATT_LAS_T)lds, nullptr, 0.f); }
#pragma unroll 1
                    for (int i = 0; i < 6; ++i) { const int e = (jj & 3) * 6 + i, h = (jj >> 2) * 3 + (e >> 3), qb = e & 7, kvh = jj >> 2;
                        att::Desc d{YS + r0 * NYS + 640 + h * 64, NYS, YS + r0 * NYS + 1024 + kvh * 64, NYS, nullptr, 0, YS + r0 * NYS + 1152 + kvh * 64, NYS, AP + r0 * DM + 384 + h * 64, DM};
                        att::unit<64, 1>(d, qb * 256, (att::ATT_LAS_T)lds, biasT + h * 260, INP(11)[l * 6 + h] * LOG2E); }
                }
                if (k == 8 && PH_ON(7)) { PTRS  pg8::Gemm g{AP, (const bf16*)(wl + W_BR), DM, DM}; pg8::Order S; S.init(MTOK, DM, G, bx, 0, 1);
                  pg8::EpiBr E{YG, MG};
                  pg8::gemm_phase<pg8::EpiBr, pg8::Order, true, true>(ldsl, g, S, E); }
                if (k == 9 && PH_ON(8)) { PTRS  pg8::Gemm g{YG, (const bf16*)(wl + W_OUT), DM, DM}; pg8::Order S; S.init(MTOK, DM, G, bx, DM / 64, 0);
                  pg8::EpiRes E{X, X, ml + 5 * DM, AP, INP(21) + l * DM, ml + 7 * DM, rowss, 1.0f, 0};
                  pg8::gemm_phase<pg8::EpiRes, pg8::Order, true, true>(ldsl, g, S, E); }
            }
            if ((k == 1 || k == 11) && PH_ON(9)) { PTRS   pg8::Gemm g{AP, (const bf16*)(wl + (f ? W_GU2 : W_GU1)), DM, DM}; pg8::Order S; S.init(MTOK, NGU, G, bx, DM / 64, 0);
              pg8::EpiGU E{HB, rstdv, shw + (f ? 32 * NGU + 32 * NIN : 0)};
              pg8::gemm_phase<pg8::EpiGU, pg8::Order, true, true>(ldsl, g, S, E); }
            if ((k == 2 || k == 12) && PH_ON(10)) { PTRS  pg8::Gemm g{HB, (const bf16*)(wl + (f ? W_DN2 : W_DN1)), FF, FF}; pg8::Order S; S.init(MTOK, DM, G, bx, FF / 64, 0);
              const float* base = (l == 0 && f == 0) ? INP(0) : X;
              const bool has_next = !(l == 1 && f == 1);
              const float* ngain = f == 0 ? INP(7) + l * DM : INP(4) + (l + 1) * DM;
              const float* nsc = f == 0 ? ml + 4 * DM : ml + (size_t)NB * NMOD + 1 * DM;
              pg8::EpiRes E{base, X, ml + (f ? 8 : 2) * DM, has_next ? AP : nullptr, ngain, nsc, rowss, 0.5f, 0};
              pg8::gemm_phase<pg8::EpiRes, pg8::Order, true, true>(ldsl, g, S, E); }
        }
        GRID_BAR();
    }
    if (PH_ON(11)) {
        const int l = 0; PTRS
        const float* gain = INP(24);
        for (int m = gw; m < MTOK; m += 2 * NGW) {
            f32x4* xr0 = (f32x4*)(X + (size_t)m * DM) + lane; f32x4* xr1 = (f32x4*)(X + (size_t)(m + NGW) * DM) + lane; f32x4 v[2][4]; float s0 = 0.f, s1 = 0.f;
#pragma unroll
            for (int j = 0; j < 4; ++j) { v[0][j] = GL(f32x4, xr0 + 64 * j); v[1][j] = GL(f32x4, xr1 + 64 * j); }
#pragma unroll
            for (int j = 0; j < 4; ++j) { s0 += (v[0][j][0] * v[0][j][0] + v[0][j][1] * v[0][j][1]) + (v[0][j][2] * v[0][j][2] + v[0][j][3] * v[0][j][3]); s1 += (v[1][j][0] * v[1][j][0] + v[1][j][1] * v[1][j][1]) + (v[1][j][2] * v[1][j][2] + v[1][j][3] * v[1][j][3]); }
            const float r0 = 1.0f / sqrtf(wave_sum(s0) * (1.0f / 1024.0f) + EPS), r1 = 1.0f / sqrtf(wave_sum(s1) * (1.0f / 1024.0f) + EPS);
#pragma unroll
            for (int j = 0; j < 4; ++j) { const f32x4 g = GL(f32x4, gain + 4 * lane + 256 * j); GS(f32x4, xr0 + 64 * j) = v[0][j] * r0 * g; GS(f32x4, xr1 + 64 * j) = v[1][j] * r1 * g; }
        }
    }
}

extern "C" void kernel_launch(void* const* d_in, const int* in_sizes, int n_in, void* d_out, int out_size, void* d_ws, size_t ws_size, hipStream_t stream) {
    static int grid = 0;
    if (grid == 0) {
        if (n_in != 25 || out_size != MTOK * DM || ws_size < WS_END) { fprintf(stderr, "kernel_launch: unexpected shapes (n_in %d, out %d, ws %zu)\n", n_in, out_size, ws_size); grid = -1; return; }
        int dev = 0, cus = 0, per_cu = 0;
        hipGetDevice(&dev); hipDeviceGetAttribute(&cus, hipDeviceAttributeMultiprocessorCount, dev);
        if (hipFuncSetAttribute((const void*)mega_fwd, hipFuncAttributeMaxDynamicSharedMemorySize, LDS_BYTES) != hipSuccess) { fprintf(stderr, "kernel_launch: hipFuncSetAttribute failed\n"); grid = -1; return; }
        if (hipOccupancyMaxActiveBlocksPerMultiprocessor(&per_cu, (const void*)mega_fwd, NWAVES * 64, LDS_BYTES) != hipSuccess || per_cu < 1) { fprintf(stderr, "kernel_launch: occupancy query failed (%d)\n", per_cu); per_cu = 1; }
        (void)hipGetLastError();
        grid = cus * (per_cu > 1 ? 1 : per_cu);
        fprintf(stderr, "kernel_launch: grid %d (cus %d, per_cu %d)\n", grid, cus, per_cu);
    }
    if (grid < 0) return;
    if (hipMemsetAsync((char*)d_ws + WS_CTL, 0, CTL_BYTES, stream) != hipSuccess) { fprintf(stderr, "kernel_launch: memset failed\n"); return; }
    Args a{};
    for (int i = 0; i < 25; ++i) a.in[i] = (const float*)d_in[i];
    a.out = (float*)d_out; a.ws = (unsigned char*)d_ws;
    void* kargs[] = {&a};
    hipError_t e = hipLaunchCooperativeKernel((const void*)mega_fwd, dim3(grid), dim3(NWAVES * 64), kargs, LDS_BYTES, stream);
    if (e != hipSuccess) fprintf(stderr, "kernel_launch: cooperative launch failed: %s (grid %d)\n", hipGetErrorString(e), grid);
}
```

```cpp
#include <hip/hip_runtime.h>
#include <hip/hip_cooperative_groups.h>
#include <hip/hip_bf16.h>
#include <cstdio>
#include <cstdint>
#include <cmath>
namespace cg = cooperative_groups;
#define GL(T, p) (*(const __attribute__((address_space(1))) T*)(p))
#define GS(T, p) (*(__attribute__((address_space(1))) T*)(p))
#define GLB(T, base, boff) (*(const __attribute__((address_space(1))) T*)((const __attribute__((address_space(1))) char*)(base) + (unsigned)(boff)))
#define GSB(T, base, boff) (*(__attribute__((address_space(1))) T*)((__attribute__((address_space(1))) char*)(base) + (unsigned)(boff)))
__device__ __forceinline__ int lautid() { int t = threadIdx.x; asm volatile("" : "+v"(t)); return t; }
namespace pg8 {
#define PG8_LAS __attribute__((address_space(3)))
typedef unsigned short bf16_t;
typedef short bf16x8 __attribute__((ext_vector_type(8)));
typedef float f32x4 __attribute__((ext_vector_type(4)));
typedef unsigned u32x4 __attribute__((ext_vector_type(4)));
constexpr int BM = 256, BK = 64, HALF = 128, HTB = HALF * BK * 2  , STAGE_BYTES = 8 * HTB, NXCD = 8, WGM = 8;

__host__ __device__ __forceinline__ int lds_byte(int r, int c) { const int st = (r >> 4) * 2 + (c >> 5), rr = r & 15, cc = c & 31, ob = rr * 64 + cc * 2; return st * 1024 + (ob ^ (((ob >> 9) & 1) << 5)); }
__host__ __device__ __forceinline__ void stage_rc(int b, int& R, int& C) { const int st = b / 1024, sb = b % 1024, swz = sb ^ (((sb >> 9) & 1) << 5); R = (st >> 1) * 16 + swz / 64; C = (st & 1) * 32 + (swz % 64) / 2; }
__host__ __device__ __forceinline__ int perm32(int rho) { const int n = rho >> 4, i = rho & 15; return 8 * (i >> 2) + 4 * n + (i & 3); }

struct Unit { int pm, pn, k0, nt, br; };
struct Gemm { const bf16_t* A; const bf16_t* Bt; int lda, ldb; };

struct Order {
    int nM, nN, nwg, G, c, nt, mode;
    __device__ __forceinline__ void init(int M, int N, int G_, int c_, int nt_, int mode_) { nM = M / BM; nN = N / BM; nwg = nM * nN; G = G_; c = c_; nt = nt_; mode = mode_; asm volatile("" : "+s"(nt)); }
    __device__ __forceinline__ bool next(int i, Unit& u) const {
        const int ii = mode ? i / 3 : i;
        const int L = ii * G + c; if (L >= nwg) return false;
        int wgid = L; { const int q = nwg / NXCD, r = nwg % NXCD, xcd = wgid % NXCD, off = wgid / NXCD; wgid = (xcd < r ? xcd * (q + 1) : r * (q + 1) + (xcd - r) * q) + off; }
        const int nig = WGM * nN, gid = wgid / nig, fm = gid * WGM, gsz = (nM - fm) < WGM ? (nM - fm) : WGM;
        u.pm = fm + ((wgid % nig) % gsz); u.pn = (wgid % nig) / gsz;
        if (mode) { const int br = i - ii * 3; u.br = br; u.k0 = br * 384; u.nt = (br == 2) ? 4 : 6; } else { u.br = 0; u.k0 = 0; u.nt = nt; }
        return true;
    }
    __device__ __forceinline__ void a_ready(const Unit&) const {}
    __device__ __forceinline__ void done(const Unit&) const {}
};
typedef float f32x2_cv __attribute__((ext_vector_type(2))); typedef __bf16 bf16x2_cv __attribute__((ext_vector_type(2)));
__device__ __forceinline__ unsigned cvt_pk_bf16(float lo, float hi) { f32x2_cv v = {lo, hi}; bf16x2_cv b = __builtin_convertvector(v, bf16x2_cv); return __builtin_bit_cast(unsigned, b); }
template <class Epi, class Sched, bool ALIGN_EPI = false, bool SP2 = false>
__device__ __forceinline__ void gemm_phase(PG8_LAS unsigned char* lds, const Gemm g, const Sched& S, const Epi& E) {
    const int tid = lautid(), wid = __builtin_amdgcn_readfirstlane(tid >> 6), lane = tid & 63, wr = wid >> 2, wc = wid & 3, fr = lane & 15, fq = lane >> 4;
    int nt;
    unsigned voffA[2], voffB[2];
#pragma unroll
    for (int i = 0; i < 2; ++i) { int R, C; stage_rc(tid * 16 + i * 8192, R, C); const int Rb = Epi::PERM ? ((R & ~31) + perm32(R & 31)) : R;
        voffA[i] = (unsigned)(R * g.lda + C) * 2u; voffB[i] = (unsigned)(Rb * g.ldb + C) * 2u; }
    const size_t kstep = (size_t)(BK * 2);
    const size_t hstepA = (size_t)HALF * g.lda * 2, hstepB = (size_t)HALF * g.ldb * 2;
    const size_t tstepA = 2 * hstepA, tstepB = 2 * hstepB;
    const unsigned ldsw = (unsigned)wid * 1024u;
    const int aoff = lds_byte(wr * 64 + fr, fq * 8), boff = lds_byte(wc * 32 + fr, fq * 8);
#define PG8_SA(b, h) (((b) * 2 + (h)) * HTB)
#define PG8_SB(b, h) ((4 + (b) * 2 + (h)) * HTB)
#define PG8_STAGE(bufoff, gbase, voff) do { _Pragma("unroll") for (int _i = 0; _i < 2; ++_i) \
        __builtin_amdgcn_global_load_lds((const unsigned*)((const char*)(gbase) + (voff)[_i]), (PG8_LAS unsigned*)(lds + (bufoff) + ldsw + _i * 8192), 16, 0, 0); } while (0)
#define PG8_LDA(dst, b, h) do { _Pragma("unroll") for (int m = 0; m < 4; ++m) _Pragma("unroll") for (int k = 0; k < 2; ++k) dst[m][k] = *(const PG8_LAS bf16x8*)(lds + PG8_SA(b, h) + aoff + m * 2048 + k * 1024); } while (0)
#define PG8_LDB(dst, b, h) do { _Pragma("unroll") for (int n = 0; n < 2; ++n) _Pragma("unroll") for (int k = 0; k < 2; ++k) dst[n][k] = *(const PG8_LAS bf16x8*)(lds + PG8_SB(b, h) + boff + n * 2048 + k * 1024); } while (0)
#define PG8_MMA(ai, bj, At, Bt) do { __builtin_amdgcn_s_setprio(1); _Pragma("unroll") for (int m = 0; m < 4; ++m) _Pragma("unroll") for (int n = 0; n < 2; ++n) _Pragma("unroll") for (int k = 0; k < 2; ++k) \
        acc[ai][bj][m][n] = __builtin_amdgcn_mfma_f32_16x16x32_bf16(Bt[n][k], At[m][k], acc[ai][bj][m][n], 0, 0, 0); __builtin_amdgcn_s_setprio(0); } while (0)
#define PG8_WAIT_V(n) asm volatile("s_waitcnt vmcnt(" #n ")" ::: "memory")
#define PG8_WAIT_L(n) asm volatile("s_waitcnt lgkmcnt(" #n ")" ::: "memory")
#define PG8_BAR __builtin_amdgcn_s_barrier()
#define PG8_SCHED __builtin_amdgcn_sched_barrier(0)
    Unit cur, nxt; int ui = 0;
    if (!S.next(0, cur)) return;
    f32x4 acc[2][2][4][2];
#pragma unroll
    for (int a = 0; a < 2; ++a)
#pragma unroll
        for (int b = 0; b < 2; ++b)
#pragma unroll
            for (int m = 0; m < 4; ++m)
#pragma unroll
                for (int n = 0; n < 2; ++n) acc[a][b][m][n] = (f32x4){0.f, 0.f, 0.f, 0.f};
    bf16x8 At[4][2], B0[2][2], B1[2][2];
    const char* cA = (const char*)g.A + (size_t)cur.pm * tstepA + (size_t)cur.k0 * 2; const char* cB = (const char*)g.Bt + (size_t)cur.pn * tstepB + (size_t)cur.k0 * 2; nt = cur.nt;
    S.a_ready(cur);
    if constexpr (SP2) {
        PG8_STAGE(PG8_SB(0, 0), cB, voffB); PG8_STAGE(PG8_SB(0, 1), cB + hstepB, voffB); PG8_STAGE(PG8_SA(0, 0), cA, voffA); PG8_STAGE(PG8_SA(0, 1), cA + hstepA, voffA);
        if (wr == 1) PG8_BAR;
        PG8_WAIT_V(2); PG8_BAR;
        PG8_STAGE(PG8_SB(1, 0), cB + kstep, voffB); PG8_STAGE(PG8_SA(1, 0), cA + kstep, voffA); PG8_STAGE(PG8_SB(1, 1), cB + hstepB + kstep, voffB);
        PG8_WAIT_V(6); PG8_BAR;
    } else {
        PG8_STAGE(PG8_SB(0, 0), cB, voffB); PG8_STAGE(PG8_SA(0, 0), cA, voffA); PG8_STAGE(PG8_SB(0, 1), cB + hstepB, voffB); PG8_STAGE(PG8_SA(0, 1), cA + hstepA, voffA);
        if (wr == 1) PG8_BAR;
        PG8_WAIT_V(4); PG8_BAR;
        PG8_STAGE(PG8_SB(1, 0), cB + kstep, voffB); PG8_STAGE(PG8_SA(1, 0), cA + kstep, voffA); PG8_STAGE(PG8_SB(1, 1), cB + hstepB + kstep, voffB);
        PG8_WAIT_V(6); PG8_BAR;
    }
    for (;;) {
        const bool has_next = S.next(ui + 1, nxt);
        const char* nA = has_next ? (const char*)g.A + (size_t)nxt.pm * tstepA + (size_t)nxt.k0 * 2 : cA; const char* nB = has_next ? (const char*)g.Bt + (size_t)nxt.pn * tstepB + (size_t)nxt.k0 * 2 : cB;
        for (int t = 0; t < nt; t += 2) {
            const bool last = (t == nt - 2);
            const char* a1 = cA + (size_t)(t + 1) * kstep;
            const char* a2 = last ? nA : cA + (size_t)(t + 2) * kstep; const char* b2 = last ? nB : cB + (size_t)(t + 2) * kstep;
            const char* a3 = a2 + kstep; const char* b3 = b2 + kstep;
            if (last && has_next) S.a_ready(nxt);
            if constexpr (SP2) {
            PG8_LDB(B0, 0, 0); PG8_LDB(B1, 0, 1); PG8_SCHED; PG8_LDA(At, 0, 0); PG8_STAGE(PG8_SA(1, 1), a1 + hstepA, voffA);
            PG8_WAIT_V(8); PG8_WAIT_L(0); PG8_BAR; PG8_MMA(0, 0, At, B0); PG8_MMA(0, 1, At, B1); PG8_BAR; PG8_SCHED;
            PG8_LDA(At, 0, 1); PG8_STAGE(PG8_SB(0, 0), b2, voffB); PG8_STAGE(PG8_SB(0, 1), b2 + hstepB, voffB); PG8_STAGE(PG8_SA(0, 0), a2, voffA);
            PG8_WAIT_V(8); PG8_WAIT_L(0); PG8_BAR; PG8_MMA(1, 0, At, B0); PG8_MMA(1, 1, At, B1); PG8_BAR; PG8_SCHED;
            PG8_LDB(B0, 1, 0); PG8_LDB(B1, 1, 1); PG8_SCHED; PG8_LDA(At, 1, 0); PG8_STAGE(PG8_SA(0, 1), a2 + hstepA, voffA);
            PG8_WAIT_V(8); PG8_WAIT_L(0); PG8_BAR; PG8_MMA(0, 0, At, B0); PG8_MMA(0, 1, At, B1); PG8_BAR; PG8_SCHED;
            PG8_LDA(At, 1, 1); PG8_STAGE(PG8_SB(1, 0), b3, voffB); PG8_STAGE(PG8_SB(1, 1), b3 + hstepB, voffB); PG8_STAGE(PG8_SA(1, 0), a3, voffA);
            PG8_WAIT_V(8); PG8_WAIT_L(0); PG8_BAR; PG8_MMA(1, 0, At, B0); PG8_MMA(1, 1, At, B1); PG8_BAR; PG8_SCHED;
            } else {
            PG8_LDB(B0, 0, 0); PG8_SCHED; PG8_LDA(At, 0, 0); PG8_STAGE(PG8_SA(1, 1), a1 + hstepA, voffA);
            PG8_WAIT_L(8); PG8_BAR; PG8_WAIT_L(0); PG8_MMA(0, 0, At, B0); PG8_BAR; PG8_SCHED;
            PG8_LDB(B1, 0, 1); PG8_STAGE(PG8_SB(0, 0), b2, voffB);
            PG8_BAR; PG8_WAIT_L(0); PG8_MMA(0, 1, At, B1); PG8_BAR;
            PG8_LDA(At, 0, 1); PG8_STAGE(PG8_SA(0, 0), a2, voffA);
            PG8_BAR; PG8_WAIT_L(0); PG8_MMA(1, 0, At, B0); PG8_BAR; PG8_SCHED;
            PG8_STAGE(PG8_SB(0, 1), b2 + hstepB, voffB);
            PG8_WAIT_V(6); PG8_BAR; PG8_MMA(1, 1, At, B1); PG8_BAR;
            PG8_LDB(B0, 1, 0); PG8_SCHED; PG8_LDA(At, 1, 0); PG8_STAGE(PG8_SA(0, 1), a2 + hstepA, voffA);
            PG8_WAIT_L(8); PG8_BAR; PG8_WAIT_L(0); PG8_MMA(0, 0, At, B0); PG8_BAR; PG8_SCHED;
            PG8_LDB(B1, 1, 1); PG8_STAGE(PG8_SB(1, 0), b3, voffB);
            PG8_BAR; PG8_WAIT_L(0); PG8_MMA(0, 1, At, B1); PG8_BAR;
            PG8_LDA(At, 1, 1); PG8_STAGE(PG8_SA(1, 0), a3, voffA);
            PG8_BAR; PG8_WAIT_L(0); PG8_MMA(1, 0, At, B0); PG8_BAR; PG8_SCHED;
            PG8_STAGE(PG8_SB(1, 1), b3 + hstepB, voffB);
            PG8_WAIT_V(6); PG8_BAR; PG8_MMA(1, 1, At, B1); PG8_BAR;
            }
        }
        if constexpr (ALIGN_EPI) { if (wr == 0) PG8_BAR; }
        if constexpr (!Epi::AFTER_DRAIN) { E(acc, cur, wr, wc, fr, fq); S.done(cur); }
        if (!has_next) break;
#pragma unroll
        for (int a = 0; a < 2; ++a)
#pragma unroll
            for (int b = 0; b < 2; ++b)
#pragma unroll
                for (int m = 0; m < 4; ++m)
#pragma unroll
                    for (int n = 0; n < 2; ++n) acc[a][b][m][n] = (f32x4){0.f, 0.f, 0.f, 0.f};
        cur = nxt; cA = nA; cB = nB; ++ui; nt = cur.nt;
        if constexpr (ALIGN_EPI) { if (wr == 1) PG8_BAR; }
    }
    PG8_WAIT_V(0);
    if constexpr (!ALIGN_EPI) { if (wr == 0) PG8_BAR; }
    PG8_BAR;
    if constexpr (Epi::AFTER_DRAIN) { E.fused(acc, cur, wr, wc, fr, fq, lds, wid, lane); S.done(cur); }
#undef PG8_SA
#undef PG8_SB
#undef PG8_STAGE
#undef PG8_LDA
#undef PG8_LDB
#undef PG8_MMA
#undef PG8_WAIT_V
#undef PG8_WAIT_L
#undef PG8_BAR
#undef PG8_SCHED
}
}
constexpr int MTOK = 65536, DM = 1024, SEQ = 2048, NB = 32, FF = 2816, NGU = 5632, NIN = 4864, NYS = 1792, NMOD = 9216;
constexpr float EPS = 1e-6f, LOG2E = 1.4426950408889634f;
constexpr float C2A = 0.125f * LOG2E;
constexpr float C2C = 0.10206207261596575f * LOG2E;

namespace pg8 {
__device__ __forceinline__ float fsigmoid(float x) { return __builtin_amdgcn_rcpf(1.0f + __builtin_amdgcn_exp2f(-x * LOG2E)); }
__device__ __forceinline__ void load_rstd(const float* rstdv, int row0, float (&rs)[2][4]) {
#pragma unroll
    for (int ai = 0; ai < 2; ++ai)
#pragma unroll
        for (int m = 0; m < 4; ++m) rs[ai][m] = GL(float, rstdv + row0 + ai * HALF + m * 16);
}
struct EpiGU {
    static constexpr bool PERM = true, AFTER_DRAIN = false;
    bf16_t* H; const float* rowss; const float* shW;
    __device__ __forceinline__ void operator()(const f32x4 (&acc)[2][2][4][2], const Unit& u, int wr, int wc, int fr, int fq) const {
        const int row0 = u.pm * BM + wr * 64 + fr, b = u.pm >> 3;
        const int cg0 = u.pn * BM + wc * 32 + 8 * fq, hc = u.pn * HALF + wc * 32 + 8 * fq;
        f32x4 sg[2], su[2];
#pragma unroll
        for (int n = 0; n < 2; ++n) { sg[n] = GL(f32x4, shW + (size_t)b * NGU + cg0 + 4 * n); su[n] = GL(f32x4, shW + (size_t)b * NGU + cg0 + HALF + 4 * n); }
        float rs[2][4]; load_rstd(rowss, row0, rs);
#pragma unroll
        for (int ai = 0; ai < 2; ++ai)
#pragma unroll
            for (int m = 0; m < 4; ++m) {
                const float r = rs[ai][m]; float h[8];
#pragma unroll
                for (int n = 0; n < 2; ++n) { const f32x4 g = acc[ai][0][m][n] * r + sg[n], up = acc[ai][1][m][n] * r + su[n];
#pragma unroll
                    for (int j = 0; j < 4; ++j) h[4 * n + j] = g[j] * fsigmoid(g[j]) * up[j]; }
                u32x4 w; w.x = cvt_pk_bf16(h[0], h[1]); w.y = cvt_pk_bf16(h[2], h[3]); w.z = cvt_pk_bf16(h[4], h[5]); w.w = cvt_pk_bf16(h[6], h[7]);
                GS(u32x4, H + (size_t)(row0 + ai * HALF + m * 16) * FF + hc) = w;
            }
    }
};
struct EpiRes {
    static constexpr bool PERM = false, AFTER_DRAIN = false;
    const float* base; float* out; const float* gate; bf16_t* AP; const float* gain; const float* sc; float* rowss; PG8_LAS unsigned char* stg; float gscale; int pad;
    __device__ __forceinline__ void operator()(const f32x4 (&acc)[2][2][4][2], const Unit& u, int wr, int wc, int fr, int fq) const {
        typedef unsigned u32x2 __attribute__((ext_vector_type(2)));
        const unsigned row0 = u.pm * BM + wr * 64 + fr, b = u.pm >> 3, col0 = u.pn * BM + wc * 32 + 4 * fq;
        const int lane = fq * 16 + fr, r8 = lane >> 3, c8 = lane & 7;
        PG8_LAS float* st = (PG8_LAS float*)(stg + (wr * 4 + wc) * 2304);
        f32x4 gv[2][2], mu2[2];
#pragma unroll
        for (int bj = 0; bj < 2; ++bj) {
#pragma unroll
            for (int n = 0; n < 2; ++n) gv[bj][n] = GLB(f32x4, gate, (b * NMOD + col0 + bj * HALF + n * 16) * 4u) * gscale;
            const unsigned cb2 = u.pn * BM + bj * HALF + wc * 32 + 4 * c8;
            if (AP) mu2[bj] = GLB(f32x4, gain, cb2 * 4u) * (GLB(f32x4, sc, (b * NMOD + cb2) * 4u) + 1.0f); else mu2[bj] = (f32x4){0.f, 0.f, 0.f, 0.f};
        }
#pragma unroll
        for (int ai = 0; ai < 2; ++ai) {
            f32x4 xb[4][2][2];
#pragma unroll
            for (int m = 0; m < 4; ++m)
#pragma unroll
                for (int bj = 0; bj < 2; ++bj)
#pragma unroll
                    for (int n = 0; n < 2; ++n) xb[m][bj][n] = GLB(f32x4, base, ((row0 + ai * HALF + m * 16) * DM + col0 + bj * HALF + n * 16) * 4u);
#pragma unroll
            for (int m = 0; m < 4; ++m) {
                const unsigned row = row0 + ai * HALF + m * 16, rowb = u.pm * BM + wr * 64 + ai * HALF + m * 16; float ss = 0.f;
#pragma unroll
                for (int bj = 0; bj < 2; ++bj) {
#pragma unroll
                    for (int n = 0; n < 2; ++n) { const f32x4 x = xb[m][bj][n] + gv[bj][n] * acc[ai][bj][m][n];
                        ss += (x[0] * x[0] + x[1] * x[1]) + (x[2] * x[2] + x[3] * x[3]);
                        *(PG8_LAS f32x4*)(st + fr * 36 + n * 16 + fq * 4) = x; }
                    asm volatile("s_waitcnt lgkmcnt(0)" ::: "memory");
#pragma unroll
                    for (int h = 0; h < 2; ++h) { const f32x4 v = *(const PG8_LAS f32x4*)(st + (h * 8 + r8) * 36 + c8 * 4);
                        const unsigned off = (rowb + h * 8 + r8) * DM + u.pn * BM + bj * HALF + wc * 32 + 4 * c8;
                        GSB(f32x4, out, off * 4u) = v;
                        if (AP) { const f32x4 y = v * mu2[bj]; u32x2 w; w.x = cvt_pk_bf16(y[0], y[1]); w.y = cvt_pk_bf16(y[2], y[3]); GSB(u32x2, AP, off * 2u) = w; } }
                    asm volatile("s_waitcnt lgkmcnt(0)" ::: "memory");
                }
                ss += __shfl_xor(ss, 16); ss += __shfl_xor(ss, 32);
                if (fq == 0) GSB(float, rowss, (row * 16 + u.pn * 4 + wc) * 4u) = ss;
            }
        }
    }
};
struct EpiIn {
    static constexpr bool PERM = true, AFTER_DRAIN = false;
    bf16_t* YS; bf16_t* YG; const float* rowss; const float* shW;
    __device__ __forceinline__ void operator()(const f32x4 (&acc)[2][2][4][2], const Unit& u, int wr, int wc, int fr, int fq) const {
        const int row0 = u.pm * BM + wr * 64 + fr, b = u.pm >> 3;
        float rs[2][4]; load_rstd(rowss, row0, rs);
        if (u.pn >= 7) {
#pragma unroll
            for (int bj = 0; bj < 2; ++bj) {
                const int cb = u.pn * BM + bj * HALF, col = cb + wc * 32 + 8 * fq, gc = cb - NYS;
                f32x4 sh[2];
#pragma unroll
                for (int n = 0; n < 2; ++n) sh[n] = GL(f32x4, shW + (size_t)b * NIN + col + 4 * n);
                bf16_t* dst = YG + (size_t)(gc >> 10) * ((size_t)MTOK * DM) + (gc & 1023) + wc * 32 + 8 * fq;
#pragma unroll
                for (int ai = 0; ai < 2; ++ai)
#pragma unroll
                    for (int m = 0; m < 4; ++m) {
                        const float r = rs[ai][m]; float h[8];
#pragma unroll
                        for (int n = 0; n < 2; ++n) { const f32x4 v = acc[ai][bj][m][n] * r + sh[n];
#pragma unroll
                            for (int j = 0; j < 4; ++j) h[4 * n + j] = fsigmoid(v[j]); }
                        u32x4 w; w.x = cvt_pk_bf16(h[0], h[1]); w.y = cvt_pk_bf16(h[2], h[3]); w.z = cvt_pk_bf16(h[4], h[5]); w.w = cvt_pk_bf16(h[6], h[7]);
                        GS(u32x4, dst + (size_t)(row0 + ai * HALF + m * 16) * DM) = w;
                    }
            }
        } else {
#pragma unroll
            for (int bj = 0; bj < 2; ++bj) {
                const int cb = u.pn * BM + bj * HALF, col = cb + wc * 32 + 8 * fq;
                f32x4 sh[2];
#pragma unroll
                for (int n = 0; n < 2; ++n) sh[n] = GL(f32x4, shW + (size_t)b * NIN + col + 4 * n);
                const float scale = (cb >= 640 && cb < 1024) ? C2A : 1.0f;
                bf16_t* dst = YS + col;
#pragma unroll
                for (int ai = 0; ai < 2; ++ai)
#pragma unroll
                    for (int m = 0; m < 4; ++m) {
                        const float r = rs[ai][m];
                        const f32x4 v0 = (acc[ai][bj][m][0] * r + sh[0]) * scale, v1 = (acc[ai][bj][m][1] * r + sh[1]) * scale;
                        u32x4 w; w.x = cvt_pk_bf16(v0[0], v0[1]); w.y = cvt_pk_bf16(v0[2], v0[3]); w.z = cvt_pk_bf16(v1[0], v1[1]); w.w = cvt_pk_bf16(v1[2], v1[3]);
                        GS(u32x4, dst + (size_t)(row0 + ai * HALF + m * 16) * NYS) = w;
                    }
            }
        }
    }
};
struct EpiQup {
    static constexpr bool PERM = false, AFTER_DRAIN = false;
    bf16_t* QC; const float* cs; const float* sn;
    __device__ __forceinline__ void operator()(const f32x4 (&acc)[2][2][4][2], const Unit& u, int wr, int wc, int fr, int fq) const {
        typedef unsigned u32x2 __attribute__((ext_vector_type(2)));
        const int row0 = u.pm * BM + wr * 64 + fr;
#pragma unroll
        for (int bj = 0; bj < 2; ++bj) {
            const int cb = u.pn * BM + bj * HALF + wc * 32;
            if (cb >= 384) continue;
            const bool rope = (cb % 96) == 64;
#pragma unroll
            for (int ai = 0; ai < 2; ++ai)
#pragma unroll
                for (int m = 0; m < 4; ++m) {
                    const int row = row0 + ai * HALF + m * 16, t = row & (SEQ - 1);
                    f32x4 x0 = acc[ai][bj][m][0], x1 = acc[ai][bj][m][1];
                    if (rope) { const f32x4 c = GL(f32x4, cs + t * 16 + 4 * fq), s = GL(f32x4, sn + t * 16 + 4 * fq);
                        const f32x4 y0 = x0 * c - x1 * s, y1 = x0 * s + x1 * c; x0 = y0; x1 = y1; }
                    x0 = x0 * C2C; x1 = x1 * C2C;
                    u32x2 w0, w1; w0.x = cvt_pk_bf16(x0[0], x0[1]); w0.y = cvt_pk_bf16(x0[2], x0[3]); w1.x = cvt_pk_bf16(x1[0], x1[1]); w1.y = cvt_pk_bf16(x1[2], x1[3]);
                    bf16_t* d = QC + (size_t)row * 384 + cb + 4 * fq;
                    *(u32x2*)d = w0; GS(u32x2, d + 16) = w1;
                }
        }
    }
};
struct EpiPlain {
    static constexpr bool PERM = true, AFTER_DRAIN = false;
    bf16_t* O; int ldc;
    __device__ __forceinline__ void operator()(const f32x4 (&acc)[2][2][4][2], const Unit& u, int wr, int wc, int fr, int fq) const {
        const int row0 = u.pm * BM + wr * 64 + fr, col0 = u.pn * BM + wc * 32 + 8 * fq;
#pragma unroll
        for (int ai = 0; ai < 2; ++ai)
#pragma unroll
            for (int m = 0; m < 4; ++m)
#pragma unroll
                for (int bj = 0; bj < 2; ++bj) { const f32x4 v0 = acc[ai][bj][m][0], v1 = acc[ai][bj][m][1];
                    u32x4 w; w.x = cvt_pk_bf16(v0[0], v0[1]); w.y = cvt_pk_bf16(v0[2], v0[3]); w.z = cvt_pk_bf16(v1[0], v1[1]); w.w = cvt_pk_bf16(v1[2], v1[3]);
                    GS(u32x4, O + (size_t)(row0 + ai * HALF + m * 16) * ldc + col0 + bj * HALF) = w; asm volatile("" ::: "memory"); }
    }
};
struct EpiBr {
    static constexpr bool PERM = true, AFTER_DRAIN = false;
    bf16_t* YG; float* MG;
    __device__ __forceinline__ void operator()(const f32x4 (&acc)[2][2][4][2], const Unit& u, int wr, int wc, int fr, int fq) const {
        const unsigned row0 = u.pm * BM + wr * 64 + fr, col0 = u.pn * BM + wc * 32 + 8 * fq;
        const bf16_t* G = YG + (size_t)u.br * ((size_t)MTOK * DM);
#pragma unroll
        for (int ai = 0; ai < 2; ++ai) {
            u32x4 gw[4][2], mw[4][2];
#pragma unroll
            for (int m = 0; m < 4; ++m)
#pragma unroll
                for (int bj = 0; bj < 2; ++bj) { const unsigned off = ((row0 + ai * HALF + m * 16) * DM + col0 + bj * HALF) * 2u;
                    gw[m][bj] = GLB(u32x4, G, off); mw[m][bj] = (u.br > 0) ? GLB(u32x4, YG, off) : (u32x4){0u, 0u, 0u, 0u}; }
#pragma unroll
            for (int m = 0; m < 4; ++m)
#pragma unroll
                for (int bj = 0; bj < 2; ++bj) { const unsigned off = ((row0 + ai * HALF + m * 16) * DM + col0 + bj * HALF) * 2u;
                    const u32x4 g = gw[m][bj], r = mw[m][bj]; f32x4 g0, g1, r0, r1;
                    g0[0] = __uint_as_float(g.x << 16); g0[1] = __uint_as_float(g.x & 0xffff0000u); g0[2] = __uint_as_float(g.y << 16); g0[3] = __uint_as_float(g.y & 0xffff0000u);
                    g1[0] = __uint_as_float(g.z << 16); g1[1] = __uint_as_float(g.z & 0xffff0000u); g1[2] = __uint_as_float(g.w << 16); g1[3] = __uint_as_float(g.w & 0xffff0000u);
                    r0[0] = __uint_as_float(r.x << 16); r0[1] = __uint_as_float(r.x & 0xffff0000u); r0[2] = __uint_as_float(r.y << 16); r0[3] = __uint_as_float(r.y & 0xffff0000u);
                    r1[0] = __uint_as_float(r.z << 16); r1[1] = __uint_as_float(r.z & 0xffff0000u); r1[2] = __uint_as_float(r.w << 16); r1[3] = __uint_as_float(r.w & 0xffff0000u);
                    const f32x4 v0 = acc[ai][bj][m][0] * g0 + r0, v1 = acc[ai][bj][m][1] * g1 + r1;
                    u32x4 w; w.x = cvt_pk_bf16(v0[0], v0[1]); w.y = cvt_pk_bf16(v0[2], v0[3]); w.z = cvt_pk_bf16(v1[0], v1[1]); w.w = cvt_pk_bf16(v1[2], v1[3]); GSB(u32x4, YG, off) = w; }
        }
    }
};
}
namespace att {
using bf16 = unsigned short;
using bf16x8 = __attribute__((ext_vector_type(8))) short;
using s16x4 = __attribute__((ext_vector_type(4))) short;
using f32x16 = __attribute__((ext_vector_type(16))) float;
using u32x4 = __attribute__((ext_vector_type(4))) unsigned;
constexpr int LDS_K = 0, KSLOT_MAX = 12288, LDS_V = 2 * KSLOT_MAX, LDS_WS = LDS_V + 2 * 8192, LDS_BIAS = LDS_WS + 2048, LDS_OST = LDS_BIAS + 2048, LDS_BYTES = LDS_OST + 8 * 4096;
__device__ __forceinline__ int crow(int r, int hi) { return (r & 3) + 8 * (r >> 2) + 4 * hi; }
__device__ __forceinline__ void glds16(const void* gsrc, unsigned lds_dst) { unsigned keep;
    asm volatile("s_mov_b32 %0, m0\n\ts_mov_b32 m0, %2\n\ts_nop 0\n\tglobal_load_lds_dwordx4 %1, off\n\ts_mov_b32 m0, %0" : "=&s"(keep) : "v"(gsrc), "s"(lds_dst) : "memory"); }
typedef float f32x2_t __attribute__((ext_vector_type(2))); typedef __bf16 bf16x2_t __attribute__((ext_vector_type(2)));
__device__ __forceinline__ unsigned cvtpk_s(float lo, float hi) { f32x2_t v = {lo, hi}; bf16x2_t b = __builtin_convertvector(v, bf16x2_t); return __builtin_bit_cast(unsigned, b); }
typedef __attribute__((address_space(3))) char* ATT_LAS_T;
__device__ __forceinline__ float max3f(float a, float b, float c) { float r; asm("v_max3_f32 %0, %1, %2, %3" : "=v"(r) : "v"(a), "v"(b), "v"(c)); return r; }
__device__ __forceinline__ float max2f(float a, float b) { float r; asm("v_max_f32_e32 %0, %1, %2" : "=v"(r) : "v"(a), "v"(b)); return r; }
struct Desc { const bf16* Q; int ldq; const bf16* K0; int ldk0; const bf16* K1; int ldk1; const bf16* V; int ldv; bf16* O; int ldo; };

__device__ __forceinline__ void pv(f32x16* o, int vb, bf16x8 pa0, bf16x8 pa1, bf16x8 pa2, bf16x8 pa3) {
#pragma unroll
    for (int d0 = 0; d0 < 2; ++d0) { s16x4 lo[4], hi[4];
#pragma unroll
        for (int ks = 0; ks < 4; ++ks) {
            asm volatile("ds_read_b64_tr_b16 %0,%1 offset:%c2" : "=&v"(lo[ks]) : "v"(vb), "i"(d0 * 4096 + ks * 1024) : "memory");
            asm volatile("ds_read_b64_tr_b16 %0,%1 offset:%c2" : "=&v"(hi[ks]) : "v"(vb), "i"(d0 * 4096 + ks * 1024 + 512) : "memory"); }
        asm volatile("s_waitcnt lgkmcnt(0)" ::: "memory"); __builtin_amdgcn_sched_barrier(0);
#define ATT_PK(k) (bf16x8){lo[k][0], lo[k][1], lo[k][2], lo[k][3], hi[k][0], hi[k][1], hi[k][2], hi[k][3]}
        o[d0] = __builtin_amdgcn_mfma_f32_32x32x16_bf16(pa0, ATT_PK(0), o[d0], 0, 0, 0);
        o[d0] = __builtin_amdgcn_mfma_f32_32x32x16_bf16(pa1, ATT_PK(1), o[d0], 0, 0, 0);
        o[d0] = __builtin_amdgcn_mfma_f32_32x32x16_bf16(pa2, ATT_PK(2), o[d0], 0, 0, 0);
        o[d0] = __builtin_amdgcn_mfma_f32_32x32x16_bf16(pa3, ATT_PK(3), o[d0], 0, 0, 0);
#undef ATT_PK
    }
}
#define ATT_LAS __attribute__((address_space(3)))
template <int DQK, int MODE> __device__ __forceinline__ void unit(const Desc& d, int q0, ATT_LAS char* shm, const float* biasg, float sinkl2) {
    constexpr int NCH = DQK / 8, KSLOT = DQK * 128, ND0 = DQK / 16; constexpr float THR = 8.0f, NEGBIG = -1e30f;
    const int tid = lautid(), lane = tid & 63, r32 = lane & 31, hi = lane >> 5; const int wid = __builtin_amdgcn_readfirstlane(tid >> 6);
    const unsigned lds0 = (unsigned)(uintptr_t)shm;
    ATT_LAS float* wsf = (ATT_LAS float*)(shm + LDS_WS) + wid * 64;
    ATT_LAS float* bias_l = (ATT_LAS float*)(shm + LDS_BIAS);
    const int qw = q0 + wid * 32;
    int t0 = 0, t1 = 32, wt0 = 0, wt1 = 32;
    if (MODE == 1) { t0 = q0 >= 128 ? (q0 - 128) >> 6 : 0; t1 = ((q0 + 383) >> 6) + 1; if (t1 > 32) t1 = 32;
                     wt0 = qw >= 128 ? (qw - 128) >> 6 : 0; wt1 = ((qw + 159) >> 6) + 1; if (wt1 > 32) wt1 = 32; }
#define ATT_DMA(t, bsel) do { \
        _Pragma("unroll") for (int c_ = 0; c_ < 2; ++c_) { const int ch_ = wid + 8 * c_; if (ch_ < NCH) { \
            const bf16* s_ = (ch_ < 8) ? d.K0 + (size_t)((t) * 64 + lane) * d.ldk0 + ch_ * 8 : d.K1 + (size_t)((t) * 64 + lane) * d.ldk1 + (ch_ - 8) * 8; \
            glds16(s_, (unsigned)__builtin_amdgcn_readfirstlane(lds0 + LDS_K + (bsel) * KSLOT + ch_ * 1024)); } } \
        { const bf16* v_ = d.V + (size_t)((t) * 64 + 16 * (wid & 3) + (lane >> 2)) * d.ldv + (wid >> 2) * 32 + (lane & 3) * 8; \
          glds16(v_, (unsigned)__builtin_amdgcn_readfirstlane(lds0 + LDS_V + (bsel) * 8192 + wid * 1024)); } } while (0)
    if (MODE == 1) { const int idx = tid - 128; bias_l[tid] = (idx >= 0 && idx <= 256) ? biasg[idx] : NEGBIG; }
    ATT_DMA(t0, 0);
    bf16x8 qr[ND0];
    { const bf16* Qw = d.Q + (size_t)(qw + r32) * d.ldq + hi * 8;
#pragma unroll
      for (int d0 = 0; d0 < ND0; ++d0) qr[d0] = GL(bf16x8, Qw + d0 * 16); }
    float mhat = 0.f, l_reg = 0.f; f32x16 o[2]; o[0] = f32x16{}; o[1] = f32x16{}; f32x16 negm = f32x16{};
    constexpr bool MSUM = true;
    f32x16 lacc = f32x16{}; const bf16x8 ones8 = (bf16x8){0x3f80, 0x3f80, 0x3f80, 0x3f80, 0x3f80, 0x3f80, 0x3f80, 0x3f80};
    const int vb0 = (int)(lds0 + LDS_V) + ((lane >> 4) & 1) * 32 + (lane & 3) * 8 + (4 * hi + ((lane & 15) >> 2)) * 64;
    int buf = 0;
    for (int t = t0; t < t1; ++t) {
        asm volatile("s_waitcnt vmcnt(0) lgkmcnt(0)\n\ts_barrier" ::: "memory");
        if (t + 1 < t1) ATT_DMA(t + 1, buf ^ 1);
        const bool active = (MODE == 0) || (t >= wt0 && t < wt1);
        if (active) {
            f32x16 p0, p1;
            { const ATT_LAS char* kb = shm + LDS_K + buf * KSLOT + hi * 1024 + r32 * 16;
#pragma unroll
              for (int d0 = 0; d0 < ND0; ++d0) {
                  const bf16x8 b0 = *(const ATT_LAS bf16x8*)(kb + d0 * 2048);
                  const bf16x8 b1 = *(const ATT_LAS bf16x8*)(kb + d0 * 2048 + 512);
                  if (d0 == 0) { p0 = __builtin_amdgcn_mfma_f32_32x32x16_bf16(b0, qr[0], negm, 0, 0, 0); p1 = __builtin_amdgcn_mfma_f32_32x32x16_bf16(b1, qr[0], negm, 0, 0, 0); }
                  else { p0 = __builtin_amdgcn_mfma_f32_32x32x16_bf16(b0, qr[d0], p0, 0, 0, 0); p1 = __builtin_amdgcn_mfma_f32_32x32x16_bf16(b1, qr[d0], p1, 0, 0, 0); } } }
            if (MODE == 1) {
                const ATT_LAS float* bp = bias_l + (64 * t - (qw + r32) + 256 + 4 * hi);
#pragma unroll
                for (int r = 0; r < 16; ++r) { p0[r] += bp[(r & 3) + 8 * (r >> 2)]; p1[r] += bp[(r & 3) + 8 * (r >> 2) + 32]; }
            }
            asm volatile("s_nop 15\n\ts_nop 7" : "+v"(p0), "+v"(p1));
            float rm, rmb;
            rm = max3f(p0[0], p0[1], p1[0]); rmb = max3f(p0[2], p0[3], p1[1]); rm = max3f(rm, p1[2], p1[3]);
#pragma unroll
            for (int r = 4; r < 16; r += 4) { rm = max3f(rm, p0[r], p0[r + 1]); rmb = max3f(rmb, p0[r + 2], p0[r + 3]); rm = max3f(rm, p1[r], p1[r + 1]); rmb = max3f(rmb, p1[r + 2], p1[r + 3]); }
            rm = max2f(rm, rmb);
            { auto rr = __builtin_amdgcn_permlane32_swap(__float_as_uint(rm), __float_as_uint(rm), false, false); rm = max2f(__uint_as_float(rr[0]), __uint_as_float(rr[1])); }
            const bool first = (t == wt0);
            if (first) {
                mhat = rm;
#pragma unroll
                for (int r = 0; r < 16; ++r) { p0[r] -= rm; p1[r] -= rm; }
#pragma unroll
                for (int r = 0; r < 16; ++r) negm[r] = -mhat;
            } else if (__any(rm > THR)) {
                const float dl = fmaxf(rm, 0.f); mhat += dl;
#pragma unroll
                for (int r = 0; r < 16; ++r) { p0[r] -= dl; p1[r] -= dl; }
#pragma unroll
                for (int r = 0; r < 16; ++r) negm[r] = -mhat;
                const float f = __builtin_amdgcn_exp2f(-dl); l_reg *= f; if (hi == 0) wsf[r32] = f;
                asm volatile("s_waitcnt lgkmcnt(0)" ::: "memory");
#pragma unroll
                for (int d_ = 0; d_ < 2; ++d_)
#pragma unroll
                    for (int r = 0; r < 16; ++r) o[d_][r] *= wsf[crow(r, hi)];
                if (MSUM) {
#pragma unroll
                    for (int r = 0; r < 16; ++r) lacc[r] *= wsf[crow(r, hi)];
                }
                asm volatile("s_waitcnt lgkmcnt(0)" ::: "memory");
            }
            if (MSUM) {
#pragma unroll
                for (int r = 0; r < 16; ++r) { p0[r] = __builtin_amdgcn_exp2f(p0[r]); p1[r] = __builtin_amdgcn_exp2f(p1[r]); }
            } else {
                float sacc = 0.f;
#pragma unroll
                for (int r = 0; r < 16; ++r) { p0[r] = __builtin_amdgcn_exp2f(p0[r]); p1[r] = __builtin_amdgcn_exp2f(p1[r]); sacc += p0[r] + p1[r]; }
                l_reg += sacc;
            }
            u32x4 pw0, pw1, pw2, pw3;
            pw0 = (u32x4){cvtpk_s(p0[0], p0[1]), cvtpk_s(p0[2], p0[3]), cvtpk_s(p0[4], p0[5]), cvtpk_s(p0[6], p0[7])};
            pw1 = (u32x4){cvtpk_s(p0[8], p0[9]), cvtpk_s(p0[10], p0[11]), cvtpk_s(p0[12], p0[13]), cvtpk_s(p0[14], p0[15])};
            pw2 = (u32x4){cvtpk_s(p1[0], p1[1]), cvtpk_s(p1[2], p1[3]), cvtpk_s(p1[4], p1[5]), cvtpk_s(p1[6], p1[7])};
            pw3 = (u32x4){cvtpk_s(p1[8], p1[9]), cvtpk_s(p1[10], p1[11]), cvtpk_s(p1[12], p1[13]), cvtpk_s(p1[14], p1[15])};
            pv(o, vb0 + buf * 8192, __builtin_bit_cast(bf16x8, pw0), __builtin_bit_cast(bf16x8, pw1), __builtin_bit_cast(bf16x8, pw2), __builtin_bit_cast(bf16x8, pw3));
            if (MSUM) {
                lacc = __builtin_amdgcn_mfma_f32_32x32x16_bf16(__builtin_bit_cast(bf16x8, pw0), ones8, lacc, 0, 0, 0);
                lacc = __builtin_amdgcn_mfma_f32_32x32x16_bf16(__builtin_bit_cast(bf16x8, pw1), ones8, lacc, 0, 0, 0);
                lacc = __builtin_amdgcn_mfma_f32_32x32x16_bf16(__builtin_bit_cast(bf16x8, pw2), ones8, lacc, 0, 0, 0);
                lacc = __builtin_amdgcn_mfma_f32_32x32x16_bf16(__builtin_bit_cast(bf16x8, pw3), ones8, lacc, 0, 0, 0);
            }
        }
        buf ^= 1;
    }
    float rli[16];
    if (MSUM) {
        if (MODE == 1) { if (hi == 0) wsf[32 + r32] = __builtin_amdgcn_exp2f(sinkl2 - mhat); asm volatile("s_waitcnt lgkmcnt(0)" ::: "memory"); }
#pragma unroll
        for (int r = 0; r < 16; ++r) rli[r] = __builtin_amdgcn_rcpf(lacc[r] + (MODE == 1 ? wsf[32 + crow(r, hi)] : 0.f));
    } else {
        { auto rr = __builtin_amdgcn_permlane32_swap(__float_as_uint(l_reg), __float_as_uint(l_reg), false, false); l_reg = __uint_as_float(rr[0]) + __uint_as_float(rr[1]); }
        if (MODE == 1) l_reg += __builtin_amdgcn_exp2f(sinkl2 - mhat);
        if (hi == 0) wsf[32 + r32] = l_reg; asm volatile("s_waitcnt lgkmcnt(0)" ::: "memory");
#pragma unroll
        for (int r = 0; r < 16; ++r) rli[r] = __builtin_amdgcn_rcpf(wsf[32 + crow(r, hi)]);
    }
    bf16* Ow = d.O + (size_t)qw * d.ldo;
    { ATT_LAS bf16* stg = (ATT_LAS bf16*)(shm + LDS_OST) + wid * 2048;
#pragma unroll
      for (int r = 0; r < 16; ++r) { const int orow = crow(r, hi);
#pragma unroll
          for (int d0 = 0; d0 < 2; ++d0) { const unsigned w = cvtpk_s(o[d0][r] * rli[r], 0.f); stg[orow * 64 + d0 * 32 + r32] = (bf16)(w & 0xffffu); } }
      asm volatile("s_waitcnt lgkmcnt(0)" ::: "memory");
#pragma unroll
      for (int i = 0; i < 4; ++i) { const int row = i * 8 + (lane >> 3), ch = lane & 7; const u32x4 v = *(const ATT_LAS u32x4*)(stg + row * 64 + ch * 8); GS(u32x4, Ow + (size_t)row * d.ldo + ch * 8) = v; } }
    asm volatile("s_waitcnt lgkmcnt(0)\n\ts_barrier" ::: "memory");
#undef ATT_DMA
}
}
#define GAS __attribute__((address_space(1)))
#define LAS __attribute__((address_space(3)))
typedef unsigned short bf16;
typedef unsigned v4u __attribute__((ext_vector_type(4)));
typedef float f32x4 __attribute__((ext_vector_type(4)));
typedef float f32x16 __attribute__((ext_vector_type(16)));
constexpr int NWAVES = 8;
constexpr int LDS_BYTES = 155648;
constexpr size_t MiB = 1u << 20;
constexpr size_t WS_MODS = 0;
constexpr size_t WS_SHW = 3 * MiB;
constexpr size_t SHW_L = (size_t)32 * (NGU + NIN + NGU) * 4;
constexpr size_t WS_ROWSS = 8 * MiB;
constexpr size_t WS_RSTD = 13 * MiB;
constexpr size_t WS_CS = 12 * MiB, WS_SN = WS_CS + 131072;
constexpr size_t WS_BIAS = WS_SN + 131072;
constexpr size_t WS_CTL = 15 * MiB, CTL_BYTES = 16384;
constexpr size_t WS_W = 16 * MiB, W_LAYER = 48 * MiB;
constexpr size_t W_GU1 = 0, W_DN1 = 11 * MiB, W_GU2 = W_DN1 + 5632 * 1024, W_DN2 = W_GU2 + 11 * MiB, W_IN = 33 * MiB, W_QUP = W_IN + (size_t)NIN * 1024 * 2, W_KVUP = W_QUP + 262144, W_BR = 43 * MiB, W_OUT = 45 * MiB;
constexpr size_t WS_AP = 112 * MiB;
constexpr size_t WS_YS = 240 * MiB;
constexpr size_t WS_QC = 464 * MiB;
constexpr size_t WS_KVC = 512 * MiB;
constexpr size_t WS_YG = 576 * MiB;
constexpr size_t WS_H = 240 * MiB;
constexpr size_t WS_MG = 240 * MiB;
constexpr size_t WS_END = 960 * MiB;
static_assert(W_DN2 + 5632 * 1024 <= W_IN && W_KVUP + 131072 <= W_BR && W_OUT + 2 * MiB <= W_LAYER && WS_W + 2 * W_LAYER <= WS_AP, "weight map");
static_assert(WS_H + (size_t)MTOK * FF * 2 <= WS_YG + 3 * (size_t)MTOK * DM * 2 && WS_MG + (size_t)MTOK * DM * 4 <= WS_KVC && WS_SHW + 2 * SHW_L <= WS_ROWSS, "ws map");

struct Args { const float* in[25]; float* out; unsigned char* ws; };
__device__ __forceinline__ int lauint(int k) { asm volatile("" : "+s"(k)); return k; }
__device__ __forceinline__ unsigned char* lau(unsigned char* p) { asm volatile("" : "+s"(p)); return p; }

__device__ __forceinline__ unsigned f2bf(float f) { unsigned u = __builtin_bit_cast(unsigned, f); return (u + 0x7fffu + ((u >> 16) & 1u)) >> 16; }
__device__ __forceinline__ unsigned pk2(float lo, float hi) { return f2bf(lo) | (f2bf(hi) << 16); }
__device__ __forceinline__ float bflo(unsigned w) { return __uint_as_float(w << 16); }
__device__ __forceinline__ float bfhi(unsigned w) { return __uint_as_float(w & 0xffff0000u); }
__device__ __forceinline__ float wave_sum(float v) {
#pragma unroll
    for (int o = 1; o < 64; o <<= 1) v += __shfl_xor(v, o);
    return v;
}
__device__ __forceinline__ void tr_item(const float* W, int N, int k0, int n0, bf16* WT, int ldk, int drow0, int dk0, const float* kscale, LAS float* scr, int lane) {
#pragma unroll
    for (int i = 0; i < 32; ++i) { const int kk = 2 * i + (lane >> 5); float v = W[(size_t)(k0 + kk) * N + n0 + (lane & 31)]; if (kscale) v *= kscale[k0 + kk]; scr[kk * 33 + (lane & 31)] = v; }
    asm volatile("s_waitcnt lgkmcnt(0)" ::: "memory");
    const int c = lane & 7;
#pragma unroll
    for (int j = 0; j < 4; ++j) { const int n = (lane >> 3) + 8 * j; const LAS float* s = scr + (8 * c) * 33 + n;
        v4u o; o.x = pk2(s[0 * 33], s[1 * 33]); o.y = pk2(s[2 * 33], s[3 * 33]); o.z = pk2(s[4 * 33], s[5 * 33]); o.w = pk2(s[6 * 33], s[7 * 33]);
        GS(v4u, WT + (size_t)(drow0 + n) * ldk + dk0 + k0 + 8 * c) = o; }
    asm volatile("s_waitcnt lgkmcnt(0)" ::: "memory");
}
__device__ __forceinline__ void tr_matrix(const float* W, int K, int N, bf16* WT, int ldk, int dk0, int remap, const float* kscale, LAS float* scr, int lane, int gw, int NGW) {
    const int nblk = N / 32, items = (K / 64) * nblk;
    for (int it = gw; it < items; it += NGW) {
        const int kb = it / nblk, nb = it - kb * nblk, n0 = nb * 32;
        int dr = n0;
        if (remap == 1) dr = (n0 < FF) ? (n0 / 128) * 256 + (n0 % 128) : ((n0 - FF) / 128) * 256 + 128 + ((n0 - FF) % 128);
        else if (remap == 2) dr = (n0 < 1696) ? n0 : n0 + 96;
        tr_item(W, N, kb * 64, n0, WT, ldk, dr, dk0, kscale, scr, lane);
    }
}
__device__ __forceinline__ void sg_item(const float* in, int in_stride, bool do_silu, const float* W, int N, int n0, float* out, int out_stride, int dcol0, const float* bias, int lane) {
    const int i = lane & 31, hi = lane >> 5;
    f32x16 acc = f32x16{};
    const float* ip = in + (size_t)i * in_stride + 4 * hi;
    const float* wp = W + (size_t)(4 * hi) * N + n0 + i;
#pragma unroll 4
    for (int k0 = 0; k0 < 1024; k0 += 8) {
        f32x4 a = GL(f32x4, ip + k0);
        if (do_silu) { a[0] = a[0] / (1.0f + __expf(-a[0])); a[1] = a[1] / (1.0f + __expf(-a[1])); a[2] = a[2] / (1.0f + __expf(-a[2])); a[3] = a[3] / (1.0f + __expf(-a[3])); }
        const float b0 = wp[(size_t)(k0 + 0) * N], b1 = wp[(size_t)(k0 + 1) * N], b2 = wp[(size_t)(k0 + 2) * N], b3 = wp[(size_t)(k0 + 3) * N];
        acc = __builtin_amdgcn_mfma_f32_32x32x2f32(a[0], b0, acc, 0, 0, 0);
        acc = __builtin_amdgcn_mfma_f32_32x32x2f32(a[1], b1, acc, 0, 0, 0);
        acc = __builtin_amdgcn_mfma_f32_32x32x2f32(a[2], b2, acc, 0, 0, 0);
        acc = __builtin_amdgcn_mfma_f32_32x32x2f32(a[3], b3, acc, 0, 0, 0);
    }
    const float bv = bias ? bias[n0 + i] : 0.f;
#pragma unroll
    for (int r = 0; r < 16; ++r) { const int b = (r & 3) + 8 * (r >> 2) + 4 * hi; out[(size_t)b * out_stride + dcol0 + i] = acc[r] + bv; }
}
__device__ __forceinline__ void sincos_d(float af, float& sv, float& cv) {
    const double a = (double)af; const double kq = rint(a * 0.63661977236758134308); const double r = (a - kq * 1.57079632679489655800) - kq * 6.123233995736766e-17;
    const double r2 = r * r;
    const double s = r * (1.0 - r2 * (1.0 / 6.0 - r2 * (1.0 / 120.0 - r2 * (1.0 / 5040.0 - r2 * (1.0 / 362880.0 - r2 * (1.0 / 39916800.0 - r2 * (1.0 / 6227020800.0 - r2 * (1.0 / 1307674368000.0))))))));
    const double c = 1.0 - r2 * (0.5 - r2 * (1.0 / 24.0 - r2 * (1.0 / 720.0 - r2 * (1.0 / 40320.0 - r2 * (1.0 / 3628800.0 - r2 * (1.0 / 479001600.0 - r2 * (1.0 / 87178291200.0 - r2 * (1.0 / 20922789888000.0))))))));
    const int q = ((int)kq) & 3;
    const double ss = (q == 0) ? s : (q == 1) ? c : (q == 2) ? -s : -c;
    const double cc = (q == 0) ? c : (q == 1) ? -s : (q == 2) ? -c : s;
    sv = (float)ss; cv = (float)cc;
}
#define XB_TMO      128
#define XB_XCNT(j)  (256  + 64 * (j))
#define XB_XSUB(j)  (1280 + 64 * (j))
#define XB_XGEN(j)  (2304 + 64 * (j))
#define XB_TOP      3328
#define XB_TOPGEN   3392
#define XCD_BAR_WORDS 3456
#define XB_SPIN_CAP (1u << 18)

__device__ __forceinline__ unsigned xb_ld(unsigned* p)              { return __hip_atomic_load(p, __ATOMIC_RELAXED, __HIP_MEMORY_SCOPE_AGENT); }
__device__ __forceinline__ unsigned xb_add(unsigned* p, unsigned v) { return __hip_atomic_fetch_add(p, v, __ATOMIC_RELAXED, __HIP_MEMORY_SCOPE_AGENT); }
__device__ __forceinline__ unsigned xb_xcc_id() { return (unsigned)__builtin_amdgcn_s_getreg((3 << 11) | 20) & 0xFu; }
#define XB_SPIN(cond, bar) do { unsigned _sp = 0; while (cond) { __builtin_amdgcn_s_sleep(1); \
    if ((++_sp & 255u) == 0u) { if (xb_ld(&(bar)[XB_TMO])) break; if (_sp > XB_SPIN_CAP) { atomicAdd(&(bar)[XB_TMO], 1u); break; } } } } while (0)

struct XcdBarrier {
    unsigned* bar; unsigned x;
    volatile LAS unsigned* st;
};

__device__ __forceinline__ XcdBarrier xcd_barrier_post(unsigned* bar, volatile LAS unsigned* st) {
    XcdBarrier b; b.bar = bar; b.x = (unsigned)__builtin_amdgcn_readfirstlane((int)xb_xcc_id()); b.st = st;
    if (threadIdx.x == 0) (void)xb_add(&bar[XB_XCNT(b.x)], 1u);
    return b;
}
__device__ __forceinline__ void xcd_barrier_complete(unsigned* bar, unsigned x, unsigned& nloc, unsigned& nx) {
    const unsigned G = gridDim.x * gridDim.y * gridDim.z;
    unsigned sum, cnt, mine, sp = 0u;
    for (;;) {
        sum = 0u; cnt = 0u; mine = 0u;
#pragma unroll
        for (unsigned j = 0; j < 16; ++j) { const unsigned c = xb_ld(&bar[XB_XCNT(j)]); sum += c; cnt += (c > 0u) ? 1u : 0u; mine = (j == x) ? c : mine; }
        if (sum == G) break;
        __builtin_amdgcn_s_sleep(1);
        if ((++sp & 255u) == 0u) { if (xb_ld(&bar[XB_TMO])) break; if (sp > XB_SPIN_CAP) { atomicAdd(&bar[XB_TMO], 1u); break; } }
    }
    nloc = mine > 0u ? mine : 1u; nx = cnt > 0u ? cnt : 1u;
}

__device__ __forceinline__ void xcd_barrier(const XcdBarrier& b) {
    asm volatile("s_waitcnt vmcnt(0)" ::: "memory");
    __syncthreads();
    if (threadIdx.x == 0) {
        unsigned* bar = b.bar;
        __builtin_amdgcn_s_waitcnt(0);
        unsigned nloc = b.st[0], nx = b.st[1];
        if (nloc == 0u) { xcd_barrier_complete(bar, b.x, nloc, nx); b.st[0] = nloc; b.st[1] = nx; }
        const unsigned old = xb_add(&bar[XB_XSUB(b.x)], 1u);
        const unsigned gen = old / nloc;
        if (old + 1u == (gen + 1u) * nloc) {
            __builtin_amdgcn_fence(__ATOMIC_RELEASE, "agent");
            asm volatile("s_waitcnt vmcnt(0)" ::: "memory");
            const unsigned og = xb_add(&bar[XB_TOP], 1u);
            const unsigned tg = og / nx;
            if (og + 1u == (tg + 1u) * nx) xb_add(&bar[XB_TOPGEN], 1u);
            else XB_SPIN(xb_ld(&bar[XB_TOPGEN]) == tg, bar);
            __builtin_amdgcn_fence(__ATOMIC_ACQUIRE, "agent");
            xb_add(&bar[XB_XGEN(b.x)], 1u);
            asm volatile("s_waitcnt vmcnt(0)" ::: "memory");
        } else {
            XB_SPIN(xb_ld(&bar[XB_XGEN(b.x)]) == gen, bar);
            __builtin_amdgcn_fence(__ATOMIC_ACQUIRE, "agent");
            asm volatile("s_waitcnt vmcnt(0)" ::: "memory");
        }
    }
    __syncthreads();
}

#ifndef PHMASK
#define PHMASK 0x1FFF
#endif
#define PH_ON(k) (((PHMASK) >> (k)) & 1)
#define INP(k) (args.in[lauint(k)])
__global__ void __launch_bounds__(NWAVES * 64, 2) mega_fwd(Args args) {
    extern __shared__ __attribute__((aligned(16))) unsigned char lds[];
    cg::grid_group grid = cg::this_grid();
    const int G = gridDim.x, bx = blockIdx.x;
    const int vcu = (G % 8 == 0) ? (bx % 8) * (G / 8) + bx / 8 : bx;
    const int NGW = G * NWAVES;
    volatile LAS unsigned* MISC = (volatile LAS unsigned*)((LAS unsigned char*)lds + 131072 + 320);
    if (threadIdx.x < 32) MISC[threadIdx.x] = 0u;
    __syncthreads();
    XcdBarrier xbar = xcd_barrier_post((unsigned*)(args.ws + WS_CTL), MISC + 8);
#define GRID_BAR() do { XcdBarrier bb_ = xbar; bb_.bar = (unsigned*)lau((unsigned char*)bb_.bar); bb_.x = (unsigned)lauint((int)bb_.x); xcd_barrier(bb_); } while (0)
#define PTRS const int tid = lautid(), lane = tid & 63, wave = __builtin_amdgcn_readfirstlane(tid >> 6), gw = vcu * NWAVES + wave; (void)lane; (void)gw; unsigned char* ws = lau(args.ws); float* X = (float*)lau((unsigned char*)args.out); (void)X; \
    float* mods = (float*)(ws + WS_MODS); float* rowss = (float*)(ws + WS_ROWSS); float* rstdv = (float*)(ws + WS_RSTD); (void)rstdv; float* cs = (float*)(ws + WS_CS); float* sn = (float*)(ws + WS_SN); float* biasT = (float*)(ws + WS_BIAS); \
    bf16* AP = (bf16*)(ws + WS_AP); bf16* YS = (bf16*)(ws + WS_YS); bf16* QC = (bf16*)(ws + WS_QC); bf16* KVC = (bf16*)(ws + WS_KVC); bf16* YG = (bf16*)(ws + WS_YG); bf16* HB = (bf16*)(ws + WS_H); float* MG = (float*)(ws + WS_MG); \
    (void)mods; (void)rowss; (void)cs; (void)sn; (void)biasT; (void)AP; (void)YS; (void)QC; (void)KVC; (void)YG; (void)HB; (void)MG; \
    unsigned char* wl = ws + WS_W + (size_t)l * W_LAYER; const float* ml = mods + (size_t)l * NB * NMOD; const float* shw = (const float*)(ws + WS_SHW + (size_t)l * SHW_L); (void)wl; (void)ml; (void)shw;
    LAS unsigned char* ldsl = (LAS unsigned char*)lds;

    if (PH_ON(0)) {
        const int l = 0; PTRS
        for (int it = gw; it < 2 * (NMOD / 32); it += NGW) { const int l = it / (NMOD / 32), n0 = (it % (NMOD / 32)) * 32;
            sg_item(INP(1), DM, true, INP(2) + (size_t)l * DM * NMOD, NMOD, n0, mods + (size_t)l * NB * NMOD, NMOD, n0, INP(3) + (size_t)l * NMOD, lane); }
        for (int e = bx * 512 + tid; e < 2048 * 16; e += G * 512) { const int p = e >> 4, i = e & 15; const float inv = powf(10000.0f, -(float)(2 * i) / 32.0f); const float ang = (float)p * inv; float s, c; sincos_d(ang, s, c); cs[e] = c; sn[e] = s; }
        for (int e = bx * 512 + tid; e < 6 * 257; e += G * 512) { const int h = e / 257, idx = e % 257, rel = idx - 128, n = rel < 0 ? -rel : rel;
            int bk = rel > 0 ? 16 : 0; if (n < 8) bk += n; else { int lg = 31 - __clz(n * n); int large = 2 + lg; if (large > 15) large = 15; bk += large; }
            biasT[h * 260 + idx] = INP(12)[bk * 6 + h] * LOG2E; }
        LAS float* scr = (LAS float*)(ldsl + wave * 16384);
#pragma unroll 1
        for (int l2 = 0; l2 < 2; ++l2) { const int l = l2;
            unsigned char* wl = ws + WS_W + (size_t)l * W_LAYER;
            tr_matrix(INP(5) + (size_t)l * DM * NGU, DM, NGU, (bf16*)(wl + W_GU1), DM, 0, 1, nullptr, scr, lane, gw, NGW);
            tr_matrix(INP(6) + (size_t)l * FF * DM, FF, DM, (bf16*)(wl + W_DN1), FF, 0, 0, nullptr, scr, lane, gw, NGW);
            tr_matrix(INP(22) + (size_t)l * DM * NGU, DM, NGU, (bf16*)(wl + W_GU2), DM, 0, 1, nullptr, scr, lane, gw, NGW);
            tr_matrix(INP(23) + (size_t)l * FF * DM, FF, DM, (bf16*)(wl + W_DN2), FF, 0, 0, nullptr, scr, lane, gw, NGW);
            tr_matrix(INP(8) + (size_t)l * DM * 4768, DM, 4768, (bf16*)(wl + W_IN), DM, 0, 2, nullptr, scr, lane, gw, NGW);
            tr_matrix(INP(14) + (size_t)l * 256 * 384, 256, 384, (bf16*)(wl + W_QUP), 256, 0, 0, INP(13) + l * 256, scr, lane, gw, NGW);
            tr_matrix(INP(16) + (size_t)l * 128 * 512, 128, 512, (bf16*)(wl + W_KVUP), 128, 0, 0, INP(15) + l * 128, scr, lane, gw, NGW);
            tr_matrix(INP(17) + (size_t)l * 384 * DM, 384, DM, (bf16*)(wl + W_BR), DM, 0, 0, nullptr, scr, lane, gw, NGW);
            tr_matrix(INP(18) + (size_t)l * 384 * DM, 384, DM, (bf16*)(wl + W_BR), DM, 384, 0, nullptr, scr, lane, gw, NGW);
            tr_matrix(INP(19) + (size_t)l * 256 * DM, 256, DM, (bf16*)(wl + W_BR), DM, 768, 0, nullptr, scr, lane, gw, NGW);
            tr_matrix(INP(20) + (size_t)l * DM * DM, DM, DM, (bf16*)(wl + W_OUT), DM, 0, 0, nullptr, scr, lane, gw, NGW);
            for (int e = bx * 512 + tid; e < 96 * 1024 / 8; e += G * 512) ((v4u*)(wl + W_IN + (size_t)1696 * 1024 * 2))[e] = (v4u){0u, 0u, 0u, 0u};
            for (int e = bx * 512 + tid; e < 128 * 256 / 8; e += G * 512) ((v4u*)(wl + W_QUP + (size_t)384 * 256 * 2))[e] = (v4u){0u, 0u, 0u, 0u};
        }
    }
    grid.sync();
    if (PH_ON(1)) {
        const int l = 0; PTRS
#pragma unroll 1
        for (int l2 = 0; l2 < 2; ++l2) { const int l = l2;
            float* shw = (float*)(ws + WS_SHW + (size_t)l * SHW_L); const float* ml = mods + (size_t)l * NB * NMOD;
            for (int it = gw; it < (NGU + 4768 + NGU) / 32; it += NGW) {
                int n0 = it * 32;
                if (n0 < NGU) { const int dr = (n0 < FF) ? (n0 / 128) * 256 + (n0 % 128) : ((n0 - FF) / 128) * 256 + 128 + ((n0 - FF) % 128);
                    sg_item(ml + 0 * DM, NMOD, false, INP(5) + (size_t)l * DM * NGU, NGU, n0, shw, NGU, dr, nullptr, lane); continue; }
                n0 -= NGU;
                if (n0 < 4768) { const int dr = (n0 < 1696) ? n0 : n0 + 96;
                    sg_item(ml + 3 * DM, NMOD, false, INP(8) + (size_t)l * DM * 4768, 4768, n0, shw + 32 * NGU, NIN, dr, nullptr, lane); continue; }
                n0 -= 4768;
                { const int dr = (n0 < FF) ? (n0 / 128) * 256 + (n0 % 128) : ((n0 - FF) / 128) * 256 + 128 + ((n0 - FF) % 128);
                    sg_item(ml + 6 * DM, NMOD, false, INP(22) + (size_t)l * DM * NGU, NGU, n0, shw + 32 * NGU + 32 * NIN, NGU, dr, nullptr, lane); }
            }
        }
        const float* gain = INP(4);
#pragma unroll 2
        for (int m = gw; m < MTOK; m += NGW) {
            const int b = m >> 11; const f32x4* xr = (const f32x4*)(INP(0) + (size_t)m * DM) + lane; const float* scp = mods + (size_t)b * NMOD + 1 * DM;
            f32x4 v[4]; float s = 0.f;
#pragma unroll
            for (int j = 0; j < 4; ++j) { v[j] = xr[64 * j]; s += (v[j][0] * v[j][0] + v[j][1] * v[j][1]) + (v[j][2] * v[j][2] + v[j][3] * v[j][3]); }
            s = wave_sum(s);
            if (lane < 16) rowss[(size_t)m * 16 + lane] = lane == 0 ? s : 0.f;
            unsigned long long* o8 = (unsigned long long*)(AP + (size_t)m * DM) + lane;
#pragma unroll
            for (int j = 0; j < 4; ++j) { const int col = 4 * lane + 256 * j; const f32x4 g = GL(f32x4, gain + col), sc = GL(f32x4, scp + col); const f32x4 y = v[j] * g * (sc + 1.0f);
                o8[64 * j] = (unsigned long long)pk2(y[0], y[1]) | ((unsigned long long)pk2(y[2], y[3]) << 32); }
        }
    }
    GRID_BAR();

#pragma unroll 1
    for (int ph = 0; ph < 26; ++ph) {
        const int l = ph >= 13 ? 1 : 0, k = ph - 13 * l, f = k >= 10 ? 1 : 0;
        if ((k == 0 || k == 3 || k == 10) && PH_ON(12)) { PTRS  for (int row = bx * 512 + tid; row < MTOK; row += G * 512) { const f32x4 a = GL(f32x4, rowss + (size_t)row * 16), b = GL(f32x4, rowss + (size_t)row * 16 + 4), c = GL(f32x4, rowss + (size_t)row * 16 + 8), d = GL(f32x4, rowss + (size_t)row * 16 + 12); const float sq = ((a[0] + a[1]) + (a[2] + a[3])) + ((b[0] + b[1]) + (b[2] + b[3])) + ((c[0] + c[1]) + (c[2] + c[3])) + ((d[0] + d[1]) + (d[2] + d[3])); rstdv[row] = 1.0f / sqrtf(sq * (1.0f / 1024.0f) + EPS); } }
        {
            {
                if (k == 4 && PH_ON(2)) { PTRS   pg8::Gemm g{AP, (const bf16*)(wl + W_IN), DM, DM}; pg8::Order S; S.init(MTOK, NIN, G, bx, DM / 64, 0);
                  pg8::EpiIn E{YS, YG, rstdv, shw + 32 * NGU};
                  pg8::gemm_phase<pg8::EpiIn, pg8::Order, true, true>(ldsl, g, S, E); }
                if (k == 5 && PH_ON(3)) { PTRS
                    const float* gq = INP(9) + l * 64; const float* gk = INP(10) + l * 64;
#pragma unroll 2
                    for (int m = gw; m < MTOK; m += NGW) {
                        const int t = m & (SEQ - 1), rp = t >> 6, cp = t & 63;
                        bf16* yr = YS + (size_t)m * NYS;
                        const v4u w1 = GL(v4u, yr + lane * 8), w2 = GL(v4u, yr + 1280 + lane * 8);
                        { float v[8] = {bflo(w1.x), bfhi(w1.x), bflo(w1.y), bfhi(w1.y), bflo(w1.z), bfhi(w1.z), bflo(w1.w), bfhi(w1.w)};
                          const int hh = lane >> 3, j = lane & 7;
                          float ss = 0.f;
#pragma unroll
                          for (int e = 0; e < 8; ++e) ss += v[e] * v[e];
                          ss += __shfl_xor(ss, 1); ss += __shfl_xor(ss, 2); ss += __shfl_xor(ss, 4);
                          const float rstd = 1.0f / sqrtf(ss * (1.0f / 64.0f) + EPS);
                          const float* gp = (hh < 6 ? gq : gk) + j * 8;
                          const int pos = (j < 4) ? rp : cp; const float* cp_ = cs + pos * 16 + (j & 1) * 8; const float* sp_ = sn + pos * 16 + (j & 1) * 8;
                          const float osc = hh < 6 ? C2A : 1.0f; float o[8];
#pragma unroll
                          for (int e = 0; e < 8; ++e) { const float a = v[e] * rstd * gp[e]; const float pa = __shfl_xor(a, 2); const float c = cp_[e], s = sp_[e];
                              o[e] = ((j & 2) == 0 ? a * c - pa * s : pa * s + a * c) * osc; }
                          v4u ow; ow.x = pk2(o[0], o[1]); ow.y = pk2(o[2], o[3]); ow.z = pk2(o[4], o[5]); ow.w = pk2(o[6], o[7]);
                          GS(v4u, yr + lane * 8) = ow; }
                        { float v[8] = {bflo(w2.x), bfhi(w2.x), bflo(w2.y), bfhi(w2.y), bflo(w2.z), bfhi(w2.z), bflo(w2.w), bfhi(w2.w)};
                          float ss = 0.f;
#pragma unroll
                          for (int e = 0; e < 8; ++e) ss += v[e] * v[e];
                          ss += __shfl_xor(ss, 1); ss += __shfl_xor(ss, 2); ss += __shfl_xor(ss, 4); ss += __shfl_xor(ss, 8);
                          const float s32 = ss + __shfl_xor(ss, 16);
                          const float rstd = lane < 32 ? 1.0f / sqrtf(s32 * (1.0f / 256.0f) + EPS) : 1.0f / sqrtf(ss * (1.0f / 128.0f) + EPS);
                          const int j = lane & 3; const float* cp_ = cs + t * 16 + (j & 1) * 8; const float* sp_ = sn + t * 16 + (j & 1) * 8;
                          float o[8];
#pragma unroll
                          for (int e = 0; e < 8; ++e) { const float pa = __shfl_xor(v[e], 2); const float c = cp_[e], s = sp_[e];
                              o[e] = lane < 48 ? v[e] * rstd : ((j & 2) == 0 ? v[e] * c - pa * s : pa * s + v[e] * c); }
                          v4u ow; ow.x = pk2(o[0], o[1]); ow.y = pk2(o[2], o[3]); ow.z = pk2(o[4], o[5]); ow.w = pk2(o[6], o[7]);
                          if (lane < 52) GS(v4u, yr + 1280 + lane * 8) = ow; }
                    }
                }
                if (k == 6 && PH_ON(4)) { PTRS  pg8::Gemm g{YS + 1280, (const bf16*)(wl + W_QUP), NYS, 256}; pg8::Order S; S.init(MTOK, 512, G, bx, 4, 0);
                  pg8::EpiQup E{QC, cs, sn};
                  pg8::gemm_phase<pg8::EpiQup, pg8::Order, true, true>(ldsl, g, S, E); }
                if (k == 6 && PH_ON(5)) { PTRS  pg8::Gemm g{YS + 1536, (const bf16*)(wl + W_KVUP), NYS, 128}; pg8::Order S; S.init(MTOK, 512, G, bx, 2, 0);
                  pg8::EpiPlain E{KVC, 512};
                  pg8::gemm_phase<pg8::EpiPlain, pg8::Order, true, true>(ldsl, g, S, E); }
#ifndef ATT_REP
#define ATT_REP 1
#endif
                for (int rep = 0; rep < ATT_REP; ++rep) if (k == 7 && PH_ON(6)) { PTRS
                    const int b = vcu >> 3, jj = vcu & 7; const size_t r0 = (size_t)b * SEQ;
#pragma unroll 1
                    for (int i = 0; i < 6; ++i) { const int e = (jj & 3) * 6 + i, h = (jj >> 2) * 3 + (e >> 3), qb = e & 7, kvh = jj >> 2;
                        att::Desc d{YS + r0 * NYS + h * 64, NYS, YS + r0 * NYS + 384 + kvh * 64, NYS, nullptr, 0, YS + r0 * NYS + 512 + kvh * 64, NYS, AP + r0 * DM + h * 64, DM};
                        att::unit<64, 0>(d, qb * 256, (att::ATT_LAS_T)lds, nullptr, 0.f); }
#pragma unroll 1
                    for (int i = 0; i < 4; ++i) { const int e = jj * 4 + i, h = e >> 3, qb = e & 7;
                        att::Desc d{QC + r0 * 384 + h * 96, 384, KVC + r0 * 512 + h * 128, 512, YS + r0 * NYS + 1664, NYS, KVC + r0 * 512 + h * 128 + 64, 512, AP + r0 * DM + 768 + h * 64, DM};
                        att::unit<96, 0>(d, qb * 256, (att::ATT_LAS_T)lds, nullptr, 0.f); }
#pragma unroll 1
                    for (int i = 0; i < 6; ++i) { const int e = (jj & 3) * 6 + i, h = (jj >> 2) * 3 + (e >> 3), qb = e & 7, kvh = jj >> 2;
                        att::Desc d{YS + r0 * NYS + 640 + h * 64, NYS, YS + r0 * NYS + 1024 + kvh * 64, NYS, nullptr, 0, YS + r0 * NYS + 1152 + kvh * 64, NYS, AP + r0 * DM + 384 + h * 64, DM};
                        att::unit<64, 1>(d, qb * 256, (att::ATT_LAS_T)lds, biasT + h * 260, INP(11)[l * 6 + h] * LOG2E); }
                }
                if (k == 8 && PH_ON(7)) { PTRS  pg8::Gemm g{AP, (const bf16*)(wl + W_BR), DM, DM}; pg8::Order S; S.init(MTOK, DM, G, bx, 0, 1);
                  pg8::EpiBr E{YG, MG};
                  pg8::gemm_phase<pg8::EpiBr, pg8::Order, true, true>(ldsl, g, S, E); }
                if (k == 9 && PH_ON(8)) { PTRS  pg8::Gemm g{YG, (const bf16*)(wl + W_OUT), DM, DM}; pg8::Order S; S.init(MTOK, DM, G, bx, DM / 64, 0);
                  pg8::EpiRes E{X, X, ml + 5 * DM, AP, INP(21) + l * DM, ml + 7 * DM, rowss, ldsl + 131072 + 1024, 1.0f, 0};
                  pg8::gemm_phase<pg8::EpiRes, pg8::Order, true, true>(ldsl, g, S, E); }
            }
            if ((k == 1 || k == 11) && PH_ON(9)) { PTRS   pg8::Gemm g{AP, (const bf16*)(wl + (f ? W_GU2 : W_GU1)), DM, DM}; pg8::Order S; S.init(MTOK, NGU, G, bx, DM / 64, 0);
              pg8::EpiGU E{HB, rstdv, shw + (f ? 32 * NGU + 32 * NIN : 0)};
              pg8::gemm_phase<pg8::EpiGU, pg8::Order, true, true>(ldsl, g, S, E); }
            if ((k == 2 || k == 12) && PH_ON(10)) { PTRS  pg8::Gemm g{HB, (const bf16*)(wl + (f ? W_DN2 : W_DN1)), FF, FF}; pg8::Order S; S.init(MTOK, DM, G, bx, FF / 64, 0);
              const float* base = (l == 0 && f == 0) ? INP(0) : X;
              const bool has_next = !(l == 1 && f == 1);
              const float* ngain = f == 0 ? INP(7) + l * DM : INP(4) + (l + 1) * DM;
              const float* nsc = f == 0 ? ml + 4 * DM : ml + (size_t)NB * NMOD + 1 * DM;
              pg8::EpiRes E{base, X, ml + (f ? 8 : 2) * DM, has_next ? AP : nullptr, ngain, nsc, rowss, ldsl + 131072 + 1024, 0.5f, 0};
              pg8::gemm_phase<pg8::EpiRes, pg8::Order, true, true>(ldsl, g, S, E); }
        }
        GRID_BAR();
    }
    if (PH_ON(11)) {
        const int l = 0; PTRS
        const float* gain = INP(24);
        for (int m = gw; m < MTOK; m += 2 * NGW) {
            f32x4* xr0 = (f32x4*)(X + (size_t)m * DM) + lane; f32x4* xr1 = (f32x4*)(X + (size_t)(m + NGW) * DM) + lane; f32x4 v[2][4]; float s0 = 0.f, s1 = 0.f;
#pragma unroll
            for (int j = 0; j < 4; ++j) { v[0][j] = GL(f32x4, xr0 + 64 * j); v[1][j] = GL(f32x4, xr1 + 64 * j); }
#pragma unroll
            for (int j = 0; j < 4; ++j) { s0 += (v[0][j][0] * v[0][j][0] + v[0][j][1] * v[0][j][1]) + (v[0][j][2] * v[0][j][2] + v[0][j][3] * v[0][j][3]); s1 += (v[1][j][0] * v[1][j][0] + v[1][j][1] * v[1][j][1]) + (v[1][j][2] * v[1][j][2] + v[1][j][3] * v[1][j][3]); }
            const float r0 = 1.0f / sqrtf(wave_sum(s0) * (1.0f / 1024.0f) + EPS), r1 = 1.0f / sqrtf(wave_sum(s1) * (1.0f / 1024.0f) + EPS);
#pragma unroll
            for (int j = 0; j < 4; ++j) { const f32x4 g = GL(f32x4, gain + 4 * lane + 256 * j); GS(f32x4, xr0 + 64 * j) = v[0][j] * r0 * g; GS(f32x4, xr1 + 64 * j) = v[1][j] * r1 * g; }
        }
    }
}

extern "C" void kernel_launch(void* const* d_in, const int* in_sizes, int n_in, void* d_out, int out_size, void* d_ws, size_t ws_size, hipStream_t stream) {
    static int grid = 0;
    if (grid == 0) {
        if (n_in != 25 || out_size != MTOK * DM || ws_size < WS_END) { fprintf(stderr, "kernel_launch: unexpected shapes (n_in %d, out %d, ws %zu)\n", n_in, out_size, ws_size); grid = -1; return; }
        int dev = 0, cus = 0, per_cu = 0;
        hipGetDevice(&dev); hipDeviceGetAttribute(&cus, hipDeviceAttributeMultiprocessorCount, dev);
        if (hipFuncSetAttribute((const void*)mega_fwd, hipFuncAttributeMaxDynamicSharedMemorySize, LDS_BYTES) != hipSuccess) { fprintf(stderr, "kernel_launch: hipFuncSetAttribute failed\n"); grid = -1; return; }
        if (hipOccupancyMaxActiveBlocksPerMultiprocessor(&per_cu, (const void*)mega_fwd, NWAVES * 64, LDS_BYTES) != hipSuccess || per_cu < 1) { fprintf(stderr, "kernel_launch: occupancy query failed (%d)\n", per_cu); per_cu = 1; }
        (void)hipGetLastError();
        grid = cus * (per_cu > 1 ? 1 : per_cu);
        fprintf(stderr, "kernel_launch: grid %d (cus %d, per_cu %d)\n", grid, cus, per_cu);
    }
    if (grid < 0) return;
    if (hipMemsetAsync((char*)d_ws + WS_CTL, 0, CTL_BYTES, stream) != hipSuccess) { fprintf(stderr, "kernel_launch: memset failed\n"); return; }
    Args a{};
    for (int i = 0; i < 25; ++i) a.in[i] = (const float*)d_in[i];
    a.out = (float*)d_out; a.ws = (unsigned char*)d_ws;
    void* kargs[] = {&a};
    hipError_t e = hipLaunchCooperativeKernel((const void*)mega_fwd, dim3(grid), dim3(NWAVES * 64), kargs, LDS_BYTES, stream);
    if (e != hipSuccess) fprintf(stderr, "kernel_launch: cooperative launch failed: %s (grid %d)\n", hipGetErrorString(e), grid);
}
```

```cpp
#include <hip/hip_runtime.h>
#include <hip/hip_cooperative_groups.h>
#include <hip/hip_bf16.h>
#include <cstdio>
#include <cstdint>
#include <cmath>
namespace cg = cooperative_groups;
#define GL(T, p) (*(const __attribute__((address_space(1))) T*)(p))
#define GS(T, p) (*(__attribute__((address_space(1))) T*)(p))
#define GLB(T, base, boff) (*(const __attribute__((address_space(1))) T*)((const __attribute__((address_space(1))) char*)(base) + (unsigned)(boff)))
#define GSB(T, base, boff) (*(__attribute__((address_space(1))) T*)((__attribute__((address_space(1))) char*)(base) + (unsigned)(boff)))
__device__ __forceinline__ int lautid() { int t = threadIdx.x; asm volatile("" : "+v"(t)); return t; }
namespace pg8 {
#define PG8_LAS __attribute__((address_space(3)))
typedef unsigned short bf16_t;
typedef short bf16x8 __attribute__((ext_vector_type(8)));
typedef float f32x4 __attribute__((ext_vector_type(4)));
typedef unsigned u32x4 __attribute__((ext_vector_type(4)));
constexpr int BM = 256, BK = 64, HALF = 128, HTB = HALF * BK * 2  , STAGE_BYTES = 8 * HTB, NXCD = 8, WGM = 8;

__host__ __device__ __forceinline__ int lds_byte(int r, int c) { const int st = (r >> 4) * 2 + (c >> 5), rr = r & 15, cc = c & 31, ob = rr * 64 + cc * 2; return st * 1024 + (ob ^ (((ob >> 9) & 1) << 5)); }
__host__ __device__ __forceinline__ void stage_rc(int b, int& R, int& C) { const int st = b / 1024, sb = b % 1024, swz = sb ^ (((sb >> 9) & 1) << 5); R = (st >> 1) * 16 + swz / 64; C = (st & 1) * 32 + (swz % 64) / 2; }
__host__ __device__ __forceinline__ int perm32(int rho) { const int n = rho >> 4, i = rho & 15; return 8 * (i >> 2) + 4 * n + (i & 3); }

struct Unit { int pm, pn, k0, nt, br; };
struct Gemm { const bf16_t* A; const bf16_t* Bt; int lda, ldb; };

struct Order {
    int nM, nN, nwg, G, c, nt, mode;
    __device__ __forceinline__ void init(int M, int N, int G_, int c_, int nt_, int mode_) { nM = M / BM; nN = N / BM; nwg = nM * nN; G = G_; c = c_; nt = nt_; mode = mode_; asm volatile("" : "+s"(nt)); }
    __device__ __forceinline__ bool next(int i, Unit& u) const {
        const int ii = mode ? i / 3 : i;
        const int L = ii * G + c; if (L >= nwg) return false;
        int wgid = L; { const int q = nwg / NXCD, r = nwg % NXCD, xcd = wgid % NXCD, off = wgid / NXCD; wgid = (xcd < r ? xcd * (q + 1) : r * (q + 1) + (xcd - r) * q) + off; }
        const int nig = WGM * nN, gid = wgid / nig, fm = gid * WGM, gsz = (nM - fm) < WGM ? (nM - fm) : WGM;
        u.pm = fm + ((wgid % nig) % gsz); u.pn = (wgid % nig) / gsz;
        if (mode) { const int br = i - ii * 3; u.br = br; u.k0 = br * 384; u.nt = (br == 2) ? 4 : 6; } else { u.br = 0; u.k0 = 0; u.nt = nt; }
        return true;
    }
    __device__ __forceinline__ void a_ready(const Unit&) const {}
    __device__ __forceinline__ void done(const Unit&) const {}
};
typedef float f32x2_cv __attribute__((ext_vector_type(2))); typedef __bf16 bf16x2_cv __attribute__((ext_vector_type(2)));
__device__ __forceinline__ unsigned cvt_pk_bf16(float lo, float hi) { f32x2_cv v = {lo, hi}; bf16x2_cv b = __builtin_convertvector(v, bf16x2_cv); return __builtin_bit_cast(unsigned, b); }
template <class Epi, class Sched, bool ALIGN_EPI = false, bool SP2 = false>
__device__ __forceinline__ void gemm_phase(PG8_LAS unsigned char* lds, const Gemm g, const Sched& S, const Epi& E) {
    const int tid = lautid(), wid = __builtin_amdgcn_readfirstlane(tid >> 6), lane = tid & 63, wr = wid >> 2, wc = wid & 3, fr = lane & 15, fq = lane >> 4;
    int nt;
    unsigned voffA[2], voffB[2];
#pragma unroll
    for (int i = 0; i < 2; ++i) { int R, C; stage_rc(tid * 16 + i * 8192, R, C); const int Rb = Epi::PERM ? ((R & ~31) + perm32(R & 31)) : R;
        voffA[i] = (unsigned)(R * g.lda + C) * 2u; voffB[i] = (unsigned)(Rb * g.ldb + C) * 2u; }
    const size_t kstep = (size_t)(BK * 2);
    const size_t hstepA = (size_t)HALF * g.lda * 2, hstepB = (size_t)HALF * g.ldb * 2;
    const size_t tstepA = 2 * hstepA, tstepB = 2 * hstepB;
    const unsigned ldsw = (unsigned)wid * 1024u;
    const int aoff = lds_byte(wr * 64 + fr, fq * 8), boff = lds_byte(wc * 32 + fr, fq * 8);
#define PG8_SA(b, h) (((b) * 2 + (h)) * HTB)
#define PG8_SB(b, h) ((4 + (b) * 2 + (h)) * HTB)
#define PG8_STAGE(bufoff, gbase, voff) do { _Pragma("unroll") for (int _i = 0; _i < 2; ++_i) \
        __builtin_amdgcn_global_load_lds((const unsigned*)((const char*)(gbase) + (voff)[_i]), (PG8_LAS unsigned*)(lds + (bufoff) + ldsw + _i * 8192), 16, 0, 0); } while (0)
#define PG8_LDA(dst, b, h) do { _Pragma("unroll") for (int m = 0; m < 4; ++m) _Pragma("unroll") for (int k = 0; k < 2; ++k) dst[m][k] = *(const PG8_LAS bf16x8*)(lds + PG8_SA(b, h) + aoff + m * 2048 + k * 1024); } while (0)
#define PG8_LDB(dst, b, h) do { _Pragma("unroll") for (int n = 0; n < 2; ++n) _Pragma("unroll") for (int k = 0; k < 2; ++k) dst[n][k] = *(const PG8_LAS bf16x8*)(lds + PG8_SB(b, h) + boff + n * 2048 + k * 1024); } while (0)
#define PG8_MMA(ai, bj, At, Bt) do { __builtin_amdgcn_s_setprio(1); _Pragma("unroll") for (int m = 0; m < 4; ++m) _Pragma("unroll") for (int n = 0; n < 2; ++n) _Pragma("unroll") for (int k = 0; k < 2; ++k) \
        acc[ai][bj][m][n] = __builtin_amdgcn_mfma_f32_16x16x32_bf16(Bt[n][k], At[m][k], acc[ai][bj][m][n], 0, 0, 0); __builtin_amdgcn_s_setprio(0); } while (0)
#define PG8_WAIT_V(n) asm volatile("s_waitcnt vmcnt(" #n ")" ::: "memory")
#define PG8_WAIT_L(n) asm volatile("s_waitcnt lgkmcnt(" #n ")" ::: "memory")
#define PG8_BAR __builtin_amdgcn_s_barrier()
#define PG8_SCHED __builtin_amdgcn_sched_barrier(0)
    Unit cur, nxt; int ui = 0;
    if (!S.next(0, cur)) return;
    f32x4 acc[2][2][4][2];
#pragma unroll
    for (int a = 0; a < 2; ++a)
#pragma unroll
        for (int b = 0; b < 2; ++b)
#pragma unroll
            for (int m = 0; m < 4; ++m)
#pragma unroll
                for (int n = 0; n < 2; ++n) acc[a][b][m][n] = (f32x4){0.f, 0.f, 0.f, 0.f};
    bf16x8 At[4][2], B0[2][2], B1[2][2];
    const char* cA = (const char*)g.A + (size_t)cur.pm * tstepA + (size_t)cur.k0 * 2; const char* cB = (const char*)g.Bt + (size_t)cur.pn * tstepB + (size_t)cur.k0 * 2; nt = cur.nt;
    S.a_ready(cur);
    if constexpr (SP2) {
        PG8_STAGE(PG8_SB(0, 0), cB, voffB); PG8_STAGE(PG8_SB(0, 1), cB + hstepB, voffB); PG8_STAGE(PG8_SA(0, 0), cA, voffA); PG8_STAGE(PG8_SA(0, 1), cA + hstepA, voffA);
        if (wr == 1) PG8_BAR;
        PG8_WAIT_V(2); PG8_BAR;
        PG8_STAGE(PG8_SB(1, 0), cB + kstep, voffB); PG8_STAGE(PG8_SA(1, 0), cA + kstep, voffA); PG8_STAGE(PG8_SB(1, 1), cB + hstepB + kstep, voffB);
        PG8_WAIT_V(6); PG8_BAR;
    } else {
        PG8_STAGE(PG8_SB(0, 0), cB, voffB); PG8_STAGE(PG8_SA(0, 0), cA, voffA); PG8_STAGE(PG8_SB(0, 1), cB + hstepB, voffB); PG8_STAGE(PG8_SA(0, 1), cA + hstepA, voffA);
        if (wr == 1) PG8_BAR;
        PG8_WAIT_V(4); PG8_BAR;
        PG8_STAGE(PG8_SB(1, 0), cB + kstep, voffB); PG8_STAGE(PG8_SA(1, 0), cA + kstep, voffA); PG8_STAGE(PG8_SB(1, 1), cB + hstepB + kstep, voffB);
        PG8_WAIT_V(6); PG8_BAR;
    }
    for (;;) {
        const bool has_next = S.next(ui + 1, nxt);
        const char* nA = has_next ? (const char*)g.A + (size_t)nxt.pm * tstepA + (size_t)nxt.k0 * 2 : cA; const char* nB = has_next ? (const char*)g.Bt + (size_t)nxt.pn * tstepB + (size_t)nxt.k0 * 2 : cB;
        for (int t = 0; t < nt; t += 2) {
            const bool last = (t == nt - 2);
            const char* a1 = cA + (size_t)(t + 1) * kstep;
            const char* a2 = last ? nA : cA + (size_t)(t + 2) * kstep; const char* b2 = last ? nB : cB + (size_t)(t + 2) * kstep;
            const char* a3 = a2 + kstep; const char* b3 = b2 + kstep;
            if (last && has_next) S.a_ready(nxt);
            if constexpr (SP2) {
            PG8_LDB(B0, 0, 0); PG8_LDB(B1, 0, 1); PG8_SCHED; PG8_LDA(At, 0, 0); PG8_STAGE(PG8_SA(1, 1), a1 + hstepA, voffA);
            PG8_WAIT_V(8); PG8_WAIT_L(0); PG8_BAR; PG8_MMA(0, 0, At, B0); PG8_MMA(0, 1, At, B1); PG8_BAR; PG8_SCHED;
            PG8_LDA(At, 0, 1); PG8_STAGE(PG8_SB(0, 0), b2, voffB); PG8_STAGE(PG8_SB(0, 1), b2 + hstepB, voffB); PG8_STAGE(PG8_SA(0, 0), a2, voffA);
            PG8_WAIT_V(8); PG8_WAIT_L(0); PG8_BAR; PG8_MMA(1, 0, At, B0); PG8_MMA(1, 1, At, B1); PG8_BAR; PG8_SCHED;
            PG8_LDB(B0, 1, 0); PG8_LDB(B1, 1, 1); PG8_SCHED; PG8_LDA(At, 1, 0); PG8_STAGE(PG8_SA(0, 1), a2 + hstepA, voffA);
            PG8_WAIT_V(8); PG8_WAIT_L(0); PG8_BAR; PG8_MMA(0, 0, At, B0); PG8_MMA(0, 1, At, B1); PG8_BAR; PG8_SCHED;
            PG8_LDA(At, 1, 1); PG8_STAGE(PG8_SB(1, 0), b3, voffB); PG8_STAGE(PG8_SB(1, 1), b3 + hstepB, voffB); PG8_STAGE(PG8_SA(1, 0), a3, voffA);
            PG8_WAIT_V(8); PG8_WAIT_L(0); PG8_BAR; PG8_MMA(1, 0, At, B0); PG8_MMA(1, 1, At, B1); PG8_BAR; PG8_SCHED;
            } else {
            PG8_LDB(B0, 0, 0); PG8_SCHED; PG8_LDA(At, 0, 0); PG8_STAGE(PG8_SA(1, 1), a1 + hstepA, voffA);
            PG8_WAIT_L(8); PG8_BAR; PG8_WAIT_L(0); PG8_MMA(0, 0, At, B0); PG8_BAR; PG8_SCHED;
            PG8_LDB(B1, 0, 1); PG8_STAGE(PG8_SB(0, 0), b2, voffB);
            PG8_BAR; PG8_WAIT_L(0); PG8_MMA(0, 1, At, B1); PG8_BAR;
            PG8_LDA(At, 0, 1); PG8_STAGE(PG8_SA(0, 0), a2, voffA);
            PG8_BAR; PG8_WAIT_L(0); PG8_MMA(1, 0, At, B0); PG8_BAR; PG8_SCHED;
            PG8_STAGE(PG8_SB(0, 1), b2 + hstepB, voffB);
            PG8_WAIT_V(6); PG8_BAR; PG8_MMA(1, 1, At, B1); PG8_BAR;
            PG8_LDB(B0, 1, 0); PG8_SCHED; PG8_LDA(At, 1, 0); PG8_STAGE(PG8_SA(0, 1), a2 + hstepA, voffA);
            PG8_WAIT_L(8); PG8_BAR; PG8_WAIT_L(0); PG8_MMA(0, 0, At, B0); PG8_BAR; PG8_SCHED;
            PG8_LDB(B1, 1, 1); PG8_STAGE(PG8_SB(1, 0), b3, voffB);
            PG8_BAR; PG8_WAIT_L(0); PG8_MMA(0, 1, At, B1); PG8_BAR;
            PG8_LDA(At, 1, 1); PG8_STAGE(PG8_SA(1, 0), a3, voffA);
            PG8_BAR; PG8_WAIT_L(0); PG8_MMA(1, 0, At, B0); PG8_BAR; PG8_SCHED;
            PG8_STAGE(PG8_SB(1, 1), b3 + hstepB, voffB);
            PG8_WAIT_V(6); PG8_BAR; PG8_MMA(1, 1, At, B1); PG8_BAR;
            }
        }
        if constexpr (ALIGN_EPI) { if (wr == 0) PG8_BAR; }
        if constexpr (!Epi::AFTER_DRAIN) { E(acc, cur, wr, wc, fr, fq); S.done(cur); }
        if (!has_next) break;
#pragma unroll
        for (int a = 0; a < 2; ++a)
#pragma unroll
            for (int b = 0; b < 2; ++b)
#pragma unroll
                for (int m = 0; m < 4; ++m)
#pragma unroll
                    for (int n = 0; n < 2; ++n) acc[a][b][m][n] = (f32x4){0.f, 0.f, 0.f, 0.f};
        cur = nxt; cA = nA; cB = nB; ++ui; nt = cur.nt;
        if constexpr (ALIGN_EPI) { if (wr == 1) PG8_BAR; }
    }
    PG8_WAIT_V(0);
    if constexpr (!ALIGN_EPI) { if (wr == 0) PG8_BAR; }
    PG8_BAR;
    if constexpr (Epi::AFTER_DRAIN) { E.fused(acc, cur, wr, wc, fr, fq, lds, wid, lane); S.done(cur); }
#undef PG8_SA
#undef PG8_SB
#undef PG8_STAGE
#undef PG8_LDA
#undef PG8_LDB
#undef PG8_MMA
#undef PG8_WAIT_V
#undef PG8_WAIT_L
#undef PG8_BAR
#undef PG8_SCHED
}
}
constexpr int MTOK = 65536, DM = 1024, SEQ = 2048, NB = 32, FF = 2816, NGU = 5632, NIN = 4864, NYS = 1792, NMOD = 9216;
constexpr float EPS = 1e-6f, LOG2E = 1.4426950408889634f;
constexpr float C2A = 0.125f * LOG2E;
constexpr float C2C = 0.10206207261596575f * LOG2E;

namespace pg8 {
__device__ __forceinline__ float fsigmoid(float x) { return __builtin_amdgcn_rcpf(1.0f + __builtin_amdgcn_exp2f(-x * LOG2E)); }
__device__ __forceinline__ void load_rstd(const float* rstdv, int row0, float (&rs)[2][4]) {
#pragma unroll
    for (int ai = 0; ai < 2; ++ai)
#pragma unroll
        for (int m = 0; m < 4; ++m) rs[ai][m] = GL(float, rstdv + row0 + ai * HALF + m * 16);
}
struct EpiGU {
    static constexpr bool PERM = true, AFTER_DRAIN = false;
    bf16_t* H; const float* rowss; const float* shW;
    __device__ __forceinline__ void operator()(const f32x4 (&acc)[2][2][4][2], const Unit& u, int wr, int wc, int fr, int fq) const {
        const int row0 = u.pm * BM + wr * 64 + fr, b = u.pm >> 3;
        const int cg0 = u.pn * BM + wc * 32 + 8 * fq, hc = u.pn * HALF + wc * 32 + 8 * fq;
        f32x4 sg[2], su[2];
#pragma unroll
        for (int n = 0; n < 2; ++n) { sg[n] = GL(f32x4, shW + (size_t)b * NGU + cg0 + 4 * n); su[n] = GL(f32x4, shW + (size_t)b * NGU + cg0 + HALF + 4 * n); }
        float rs[2][4]; load_rstd(rowss, row0, rs);
#pragma unroll
        for (int ai = 0; ai < 2; ++ai)
#pragma unroll
            for (int m = 0; m < 4; ++m) {
                const float r = rs[ai][m]; float h[8];
#pragma unroll
                for (int n = 0; n < 2; ++n) { const f32x4 g = acc[ai][0][m][n] * r + sg[n], up = acc[ai][1][m][n] * r + su[n];
#pragma unroll
                    for (int j = 0; j < 4; ++j) h[4 * n + j] = g[j] * fsigmoid(g[j]) * up[j]; }
                u32x4 w; w.x = cvt_pk_bf16(h[0], h[1]); w.y = cvt_pk_bf16(h[2], h[3]); w.z = cvt_pk_bf16(h[4], h[5]); w.w = cvt_pk_bf16(h[6], h[7]);
                GS(u32x4, H + (size_t)(row0 + ai * HALF + m * 16) * FF + hc) = w;
            }
    }
};
struct EpiRes {
    static constexpr bool PERM = false, AFTER_DRAIN = false;
    const float* base; float* out; const float* gate; bf16_t* AP; const float* gain; const float* sc; float* rowss; PG8_LAS unsigned char* stg; float gscale; int pad;
    __device__ __forceinline__ void operator()(const f32x4 (&acc)[2][2][4][2], const Unit& u, int wr, int wc, int fr, int fq) const {
        typedef unsigned u32x2 __attribute__((ext_vector_type(2)));
        const unsigned row0 = u.pm * BM + wr * 64 + fr, b = u.pm >> 3, col0 = u.pn * BM + wc * 32 + 4 * fq;
        const int lane = fq * 16 + fr, r8 = lane >> 3, c8 = lane & 7;
        PG8_LAS float* st = (PG8_LAS float*)(stg + (wr * 4 + wc) * 2304);
        f32x4 gv[2][2], mu2[2];
#pragma unroll
        for (int bj = 0; bj < 2; ++bj) {
#pragma unroll
            for (int n = 0; n < 2; ++n) gv[bj][n] = GLB(f32x4, gate, (b * NMOD + col0 + bj * HALF + n * 16) * 4u) * gscale;
            const unsigned cb2 = u.pn * BM + bj * HALF + wc * 32 + 4 * c8;
            if (AP) mu2[bj] = GLB(f32x4, gain, cb2 * 4u) * (GLB(f32x4, sc, (b * NMOD + cb2) * 4u) + 1.0f); else mu2[bj] = (f32x4){0.f, 0.f, 0.f, 0.f};
        }
#pragma unroll
        for (int ai = 0; ai < 2; ++ai) {
            f32x4 xb[4][2][2];
#pragma unroll
            for (int m = 0; m < 4; ++m)
#pragma unroll
                for (int bj = 0; bj < 2; ++bj)
#pragma unroll
                    for (int n = 0; n < 2; ++n) xb[m][bj][n] = GLB(f32x4, base, ((row0 + ai * HALF + m * 16) * DM + col0 + bj * HALF + n * 16) * 4u);
#pragma unroll
            for (int m = 0; m < 4; ++m) {
                const unsigned row = row0 + ai * HALF + m * 16, rowb = u.pm * BM + wr * 64 + ai * HALF + m * 16; float ss = 0.f;
#pragma unroll
                for (int bj = 0; bj < 2; ++bj) {
#pragma unroll
                    for (int n = 0; n < 2; ++n) { const f32x4 x = xb[m][bj][n] + gv[bj][n] * acc[ai][bj][m][n];
                        ss += (x[0] * x[0] + x[1] * x[1]) + (x[2] * x[2] + x[3] * x[3]);
                        *(PG8_LAS f32x4*)(st + fr * 36 + n * 16 + fq * 4) = x; }
                    asm volatile("s_waitcnt lgkmcnt(0)" ::: "memory");
#pragma unroll
                    for (int h = 0; h < 2; ++h) { const f32x4 v = *(const PG8_LAS f32x4*)(st + (h * 8 + r8) * 36 + c8 * 4);
                        const unsigned off = (rowb + h * 8 + r8) * DM + u.pn * BM + bj * HALF + wc * 32 + 4 * c8;
                        GSB(f32x4, out, off * 4u) = v;
                        if (AP) { const f32x4 y = v * mu2[bj]; u32x2 w; w.x = cvt_pk_bf16(y[0], y[1]); w.y = cvt_pk_bf16(y[2], y[3]); GSB(u32x2, AP, off * 2u) = w; } }
                    asm volatile("s_waitcnt lgkmcnt(0)" ::: "memory");
                }
                ss += __shfl_xor(ss, 16); ss += __shfl_xor(ss, 32);
                if (fq == 0) GSB(float, rowss, (row * 16 + u.pn * 4 + wc) * 4u) = ss;
            }
        }
    }
};
struct EpiIn {
    static constexpr bool PERM = true, AFTER_DRAIN = false;
    bf16_t* YS; bf16_t* YG; const float* rowss; const float* shW; PG8_LAS unsigned char* stg;
    __device__ __forceinline__ void operator()(const f32x4 (&acc)[2][2][4][2], const Unit& u, int wr, int wc, int fr, int fq) const {
        const int row0 = u.pm * BM + wr * 64 + fr, b = u.pm >> 3;
        const int lane = fq * 16 + fr, r8 = lane >> 3, c8 = lane & 7;
        PG8_LAS unsigned char* st = stg + (wr * 4 + wc) * 2304;
        float rs[2][4]; load_rstd(rowss, row0, rs);
        const bool gates = u.pn >= 7;
        f32x4 sh[2][2]; float scale[2];
#pragma unroll
        for (int bj = 0; bj < 2; ++bj) { const int cg = u.pn * BM + 64 * wc + 32 * bj;
            scale[bj] = (!gates && cg >= 640 && cg < 1024) ? C2A : 1.0f;
#pragma unroll
            for (int n = 0; n < 2; ++n) sh[bj][n] = GL(f32x4, shW + (size_t)b * NIN + cg + 8 * fq + 4 * n); }
        bf16_t* dst; unsigned ld;
        if (gates) { dst = YG + (size_t)((u.pn - 7) >> 2) * ((size_t)MTOK * DM) + ((u.pn - 7) & 3) * BM + 64 * wc + 8 * c8; ld = DM; }
        else { dst = YS + u.pn * BM + 64 * wc + 8 * c8; ld = NYS; }
        const unsigned rowa = u.pm * BM + wr * 64;
        if (gates) body<true>(acc, rs, sh, scale, st, dst, ld, rowa, fr, fq, r8, c8); else body<false>(acc, rs, sh, scale, st, dst, ld, rowa, fr, fq, r8, c8);
    }
    template <bool GATES> __device__ __forceinline__ void body(const f32x4 (&acc)[2][2][4][2], const float (&rs)[2][4], const f32x4 (&sh)[2][2], const float (&scale)[2], PG8_LAS unsigned char* st,
                                                                bf16_t* dst, unsigned ld, unsigned rowa, int fr, int fq, int r8, int c8) const {
#pragma unroll
        for (int ai = 0; ai < 2; ++ai)
#pragma unroll
            for (int m = 0; m < 4; ++m) {
                const float r = rs[ai][m];
#pragma unroll
                for (int bj = 0; bj < 2; ++bj) { float h[8];
#pragma unroll
                    for (int n = 0; n < 2; ++n) { const f32x4 v = acc[ai][bj][m][n] * r + sh[bj][n];
#pragma unroll
                        for (int j = 0; j < 4; ++j) h[4 * n + j] = GATES ? fsigmoid(v[j]) : v[j] * scale[bj]; }
                    u32x4 w; w.x = cvt_pk_bf16(h[0], h[1]); w.y = cvt_pk_bf16(h[2], h[3]); w.z = cvt_pk_bf16(h[4], h[5]); w.w = cvt_pk_bf16(h[6], h[7]);
                    *(PG8_LAS u32x4*)(st + fr * 144 + bj * 64 + fq * 16) = w; }
                asm volatile("s_waitcnt lgkmcnt(0)" ::: "memory");
#pragma unroll
                for (int h2 = 0; h2 < 2; ++h2) { const u32x4 w = *(const PG8_LAS u32x4*)(st + (h2 * 8 + r8) * 144 + c8 * 16);
                    GS(u32x4, dst + (size_t)(rowa + ai * HALF + m * 16 + h2 * 8 + r8) * ld) = w; }
                asm volatile("s_waitcnt lgkmcnt(0)" ::: "memory");
            }
    }
};
struct EpiQup {
    static constexpr bool PERM = false, AFTER_DRAIN = false;
    bf16_t* QC; const float* cs; const float* sn;
    __device__ __forceinline__ void operator()(const f32x4 (&acc)[2][2][4][2], const Unit& u, int wr, int wc, int fr, int fq) const {
        typedef unsigned u32x2 __attribute__((ext_vector_type(2)));
        const int row0 = u.pm * BM + wr * 64 + fr;
#pragma unroll
        for (int bj = 0; bj < 2; ++bj) {
            const int cb = u.pn * BM + bj * HALF + wc * 32;
            if (cb >= 384) continue;
            const bool rope = (cb % 96) == 64;
#pragma unroll
            for (int ai = 0; ai < 2; ++ai)
#pragma unroll
                for (int m = 0; m < 4; ++m) {
                    const int row = row0 + ai * HALF + m * 16, t = row & (SEQ - 1);
                    f32x4 x0 = acc[ai][bj][m][0], x1 = acc[ai][bj][m][1];
                    if (rope) { const f32x4 c = GL(f32x4, cs + t * 16 + 4 * fq), s = GL(f32x4, sn + t * 16 + 4 * fq);
                        const f32x4 y0 = x0 * c - x1 * s, y1 = x0 * s + x1 * c; x0 = y0; x1 = y1; }
                    x0 = x0 * C2C; x1 = x1 * C2C;
                    u32x2 w0, w1; w0.x = cvt_pk_bf16(x0[0], x0[1]); w0.y = cvt_pk_bf16(x0[2], x0[3]); w1.x = cvt_pk_bf16(x1[0], x1[1]); w1.y = cvt_pk_bf16(x1[2], x1[3]);
                    bf16_t* d = QC + (size_t)row * 384 + cb + 4 * fq;
                    *(u32x2*)d = w0; GS(u32x2, d + 16) = w1;
                }
        }
    }
};
struct EpiPlain {
    static constexpr bool PERM = true, AFTER_DRAIN = false;
    bf16_t* O; int ldc;
    __device__ __forceinline__ void operator()(const f32x4 (&acc)[2][2][4][2], const Unit& u, int wr, int wc, int fr, int fq) const {
        const int row0 = u.pm * BM + wr * 64 + fr, col0 = u.pn * BM + wc * 32 + 8 * fq;
#pragma unroll
        for (int ai = 0; ai < 2; ++ai)
#pragma unroll
            for (int m = 0; m < 4; ++m)
#pragma unroll
                for (int bj = 0; bj < 2; ++bj) { const f32x4 v0 = acc[ai][bj][m][0], v1 = acc[ai][bj][m][1];
                    u32x4 w; w.x = cvt_pk_bf16(v0[0], v0[1]); w.y = cvt_pk_bf16(v0[2], v0[3]); w.z = cvt_pk_bf16(v1[0], v1[1]); w.w = cvt_pk_bf16(v1[2], v1[3]);
                    GS(u32x4, O + (size_t)(row0 + ai * HALF + m * 16) * ldc + col0 + bj * HALF) = w; asm volatile("" ::: "memory"); }
    }
};
struct EpiBr {
    static constexpr bool PERM = true, AFTER_DRAIN = false;
    bf16_t* YG; float* MG;
    __device__ __forceinline__ void operator()(const f32x4 (&acc)[2][2][4][2], const Unit& u, int wr, int wc, int fr, int fq) const {
        const unsigned row0 = u.pm * BM + wr * 64 + fr, col0 = u.pn * BM + wc * 32 + 8 * fq;
        const bf16_t* G = YG + (size_t)u.br * ((size_t)MTOK * DM);
#pragma unroll
        for (int ai = 0; ai < 2; ++ai) {
            u32x4 gw[4][2], mw[4][2];
#pragma unroll
            for (int m = 0; m < 4; ++m)
#pragma unroll
                for (int bj = 0; bj < 2; ++bj) { const unsigned off = ((row0 + ai * HALF + m * 16) * DM + col0 + bj * HALF) * 2u;
                    gw[m][bj] = GLB(u32x4, G, off); mw[m][bj] = (u.br > 0) ? GLB(u32x4, YG, off) : (u32x4){0u, 0u, 0u, 0u}; }
#pragma unroll
            for (int m = 0; m < 4; ++m)
#pragma unroll
                for (int bj = 0; bj < 2; ++bj) { const unsigned off = ((row0 + ai * HALF + m * 16) * DM + col0 + bj * HALF) * 2u;
                    const u32x4 g = gw[m][bj], r = mw[m][bj]; f32x4 g0, g1, r0, r1;
                    g0[0] = __uint_as_float(g.x << 16); g0[1] = __uint_as_float(g.x & 0xffff0000u); g0[2] = __uint_as_float(g.y << 16); g0[3] = __uint_as_float(g.y & 0xffff0000u);
                    g1[0] = __uint_as_float(g.z << 16); g1[1] = __uint_as_float(g.z & 0xffff0000u); g1[2] = __uint_as_float(g.w << 16); g1[3] = __uint_as_float(g.w & 0xffff0000u);
                    r0[0] = __uint_as_float(r.x << 16); r0[1] = __uint_as_float(r.x & 0xffff0000u); r0[2] = __uint_as_float(r.y << 16); r0[3] = __uint_as_float(r.y & 0xffff0000u);
                    r1[0] = __uint_as_float(r.z << 16); r1[1] = __uint_as_float(r.z & 0xffff0000u); r1[2] = __uint_as_float(r.w << 16); r1[3] = __uint_as_float(r.w & 0xffff0000u);
                    const f32x4 v0 = acc[ai][bj][m][0] * g0 + r0, v1 = acc[ai][bj][m][1] * g1 + r1;
                    u32x4 w; w.x = cvt_pk_bf16(v0[0], v0[1]); w.y = cvt_pk_bf16(v0[2], v0[3]); w.z = cvt_pk_bf16(v1[0], v1[1]); w.w = cvt_pk_bf16(v1[2], v1[3]); GSB(u32x4, YG, off) = w; }
        }
    }
};
}
namespace att {
using bf16 = unsigned short;
using bf16x8 = __attribute__((ext_vector_type(8))) short;
using s16x4 = __attribute__((ext_vector_type(4))) short;
using f32x16 = __attribute__((ext_vector_type(16))) float;
using u32x4 = __attribute__((ext_vector_type(4))) unsigned;
constexpr int LDS_K = 0, KSLOT_MAX = 12288, LDS_V = 2 * KSLOT_MAX, LDS_WS = LDS_V + 2 * 8192, LDS_BIAS = LDS_WS + 2048, LDS_OST = LDS_BIAS + 2048, LDS_BYTES = LDS_OST + 8 * 4096;
__device__ __forceinline__ int crow(int r, int hi) { return (r & 3) + 8 * (r >> 2) + 4 * hi; }
__device__ __forceinline__ void glds16(const void* gsrc, unsigned lds_dst) { unsigned keep;
    asm volatile("s_mov_b32 %0, m0\n\ts_mov_b32 m0, %2\n\ts_nop 0\n\tglobal_load_lds_dwordx4 %1, off\n\ts_mov_b32 m0, %0" : "=&s"(keep) : "v"(gsrc), "s"(lds_dst) : "memory"); }
typedef float f32x2_t __attribute__((ext_vector_type(2))); typedef __bf16 bf16x2_t __attribute__((ext_vector_type(2)));
__device__ __forceinline__ unsigned cvtpk_s(float lo, float hi) { f32x2_t v = {lo, hi}; bf16x2_t b = __builtin_convertvector(v, bf16x2_t); return __builtin_bit_cast(unsigned, b); }
typedef __attribute__((address_space(3))) char* ATT_LAS_T;
__device__ __forceinline__ float max3f(float a, float b, float c) { float r; asm("v_max3_f32 %0, %1, %2, %3" : "=v"(r) : "v"(a), "v"(b), "v"(c)); return r; }
__device__ __forceinline__ float max2f(float a, float b) { float r; asm("v_max_f32_e32 %0, %1, %2" : "=v"(r) : "v"(a), "v"(b)); return r; }
struct Desc { const bf16* Q; int ldq; const bf16* K0; int ldk0; const bf16* K1; int ldk1; const bf16* V; int ldv; bf16* O; int ldo; };

__device__ __forceinline__ void pv(f32x16* o, int vb, bf16x8 pa0, bf16x8 pa1, bf16x8 pa2, bf16x8 pa3) {
#pragma unroll
    for (int d0 = 0; d0 < 2; ++d0) { s16x4 lo[4], hi[4];
#pragma unroll
        for (int ks = 0; ks < 4; ++ks) {
            asm volatile("ds_read_b64_tr_b16 %0,%1 offset:%c2" : "=&v"(lo[ks]) : "v"(vb), "i"(d0 * 4096 + ks * 1024) : "memory");
            asm volatile("ds_read_b64_tr_b16 %0,%1 offset:%c2" : "=&v"(hi[ks]) : "v"(vb), "i"(d0 * 4096 + ks * 1024 + 512) : "memory"); }
        asm volatile("s_waitcnt lgkmcnt(0)" ::: "memory"); __builtin_amdgcn_sched_barrier(0);
#define ATT_PK(k) (bf16x8){lo[k][0], lo[k][1], lo[k][2], lo[k][3], hi[k][0], hi[k][1], hi[k][2], hi[k][3]}
        o[d0] = __builtin_amdgcn_mfma_f32_32x32x16_bf16(pa0, ATT_PK(0), o[d0], 0, 0, 0);
        o[d0] = __builtin_amdgcn_mfma_f32_32x32x16_bf16(pa1, ATT_PK(1), o[d0], 0, 0, 0);
        o[d0] = __builtin_amdgcn_mfma_f32_32x32x16_bf16(pa2, ATT_PK(2), o[d0], 0, 0, 0);
        o[d0] = __builtin_amdgcn_mfma_f32_32x32x16_bf16(pa3, ATT_PK(3), o[d0], 0, 0, 0);
#undef ATT_PK
    }
}
#define ATT_LAS __attribute__((address_space(3)))
template <int DQK, int MODE> __device__ __forceinline__ void unit(const Desc& d, int q0, ATT_LAS char* shm, const float* biasg, float sinkl2) {
    constexpr int NCH = DQK / 8, KSLOT = DQK * 128, ND0 = DQK / 16; constexpr float THR = 8.0f, NEGBIG = -1e30f;
    const int tid = lautid(), lane = tid & 63, r32 = lane & 31, hi = lane >> 5; const int wid = __builtin_amdgcn_readfirstlane(tid >> 6);
    const unsigned lds0 = (unsigned)(uintptr_t)shm;
    ATT_LAS float* wsf = (ATT_LAS float*)(shm + LDS_WS) + wid * 64;
    ATT_LAS float* bias_l = (ATT_LAS float*)(shm + LDS_BIAS);
    const int qw = q0 + wid * 32;
    int t0 = 0, t1 = 32, wt0 = 0, wt1 = 32;
    if (MODE == 1) { t0 = q0 >= 128 ? (q0 - 128) >> 6 : 0; t1 = ((q0 + 383) >> 6) + 1; if (t1 > 32) t1 = 32;
                     wt0 = qw >= 128 ? (qw - 128) >> 6 : 0; wt1 = ((qw + 159) >> 6) + 1; if (wt1 > 32) wt1 = 32; }
#define ATT_DMA(t, bsel) do { \
        _Pragma("unroll") for (int c_ = 0; c_ < 2; ++c_) { const int ch_ = wid + 8 * c_; if (ch_ < NCH) { \
            const bf16* s_ = (ch_ < 8) ? d.K0 + (size_t)((t) * 64 + lane) * d.ldk0 + ch_ * 8 : d.K1 + (size_t)((t) * 64 + lane) * d.ldk1 + (ch_ - 8) * 8; \
            glds16(s_, (unsigned)__builtin_amdgcn_readfirstlane(lds0 + LDS_K + (bsel) * KSLOT + ch_ * 1024)); } } \
        { const bf16* v_ = d.V + (size_t)((t) * 64 + 16 * (wid & 3) + (lane >> 2)) * d.ldv + (wid >> 2) * 32 + (lane & 3) * 8; \
          glds16(v_, (unsigned)__builtin_amdgcn_readfirstlane(lds0 + LDS_V + (bsel) * 8192 + wid * 1024)); } } while (0)
    if (MODE == 1) { const int idx = tid - 128; bias_l[tid] = (idx >= 0 && idx <= 256) ? biasg[idx] : NEGBIG; }
    ATT_DMA(t0, 0);
    bf16x8 qr[ND0];
    { const bf16* Qw = d.Q + (size_t)(qw + r32) * d.ldq + hi * 8;
#pragma unroll
      for (int d0 = 0; d0 < ND0; ++d0) qr[d0] = GL(bf16x8, Qw + d0 * 16); }
    float mhat = 0.f, l_reg = 0.f; f32x16 o[2]; o[0] = f32x16{}; o[1] = f32x16{}; f32x16 negm = f32x16{};
    constexpr bool MSUM = true;
    f32x16 lacc = f32x16{}; const bf16x8 ones8 = (bf16x8){0x3f80, 0x3f80, 0x3f80, 0x3f80, 0x3f80, 0x3f80, 0x3f80, 0x3f80};
    const int vb0 = (int)(lds0 + LDS_V) + ((lane >> 4) & 1) * 32 + (lane & 3) * 8 + (4 * hi + ((lane & 15) >> 2)) * 64;
    int buf = 0;
    for (int t = t0; t < t1; ++t) {
        asm volatile("s_waitcnt vmcnt(0) lgkmcnt(0)\n\ts_barrier" ::: "memory");
        if (t + 1 < t1) ATT_DMA(t + 1, buf ^ 1);
        const bool active = (MODE == 0) || (t >= wt0 && t < wt1);
        if (active) {
            f32x16 p0, p1;
            { const ATT_LAS char* kb = shm + LDS_K + buf * KSLOT + hi * 1024 + r32 * 16;
#pragma unroll
              for (int d0 = 0; d0 < ND0; ++d0) {
                  const bf16x8 b0 = *(const ATT_LAS bf16x8*)(kb + d0 * 2048);
                  const bf16x8 b1 = *(const ATT_LAS bf16x8*)(kb + d0 * 2048 + 512);
                  if (d0 == 0) { p0 = __builtin_amdgcn_mfma_f32_32x32x16_bf16(b0, qr[0], negm, 0, 0, 0); p1 = __builtin_amdgcn_mfma_f32_32x32x16_bf16(b1, qr[0], negm, 0, 0, 0); }
                  else { p0 = __builtin_amdgcn_mfma_f32_32x32x16_bf16(b0, qr[d0], p0, 0, 0, 0); p1 = __builtin_amdgcn_mfma_f32_32x32x16_bf16(b1, qr[d0], p1, 0, 0, 0); } } }
            if (MODE == 1) {
                const ATT_LAS float* bp = bias_l + (64 * t - (qw + r32) + 256 + 4 * hi);
#pragma unroll
                for (int r = 0; r < 16; ++r) { p0[r] += bp[(r & 3) + 8 * (r >> 2)]; p1[r] += bp[(r & 3) + 8 * (r >> 2) + 32]; }
            }
            asm volatile("s_nop 15\n\ts_nop 7" : "+v"(p0), "+v"(p1));
            float rm, rmb;
            rm = max3f(p0[0], p0[1], p1[0]); rmb = max3f(p0[2], p0[3], p1[1]); rm = max3f(rm, p1[2], p1[3]);
#pragma unroll
            for (int r = 4; r < 16; r += 4) { rm = max3f(rm, p0[r], p0[r + 1]); rmb = max3f(rmb, p0[r + 2], p0[r + 3]); rm = max3f(rm, p1[r], p1[r + 1]); rmb = max3f(rmb, p1[r + 2], p1[r + 3]); }
            rm = max2f(rm, rmb);
            { auto rr = __builtin_amdgcn_permlane32_swap(__float_as_uint(rm), __float_as_uint(rm), false, false); rm = max2f(__uint_as_float(rr[0]), __uint_as_float(rr[1])); }
            const bool first = (t == wt0);
            if (first) {
                mhat = rm;
#pragma unroll
                for (int r = 0; r < 16; ++r) { p0[r] -= rm; p1[r] -= rm; }
#pragma unroll
                for (int r = 0; r < 16; ++r) negm[r] = -mhat;
            } else if (__any(rm > THR)) {
                const float dl = fmaxf(rm, 0.f); mhat += dl;
#pragma unroll
                for (int r = 0; r < 16; ++r) { p0[r] -= dl; p1[r] -= dl; }
#pragma unroll
                for (int r = 0; r < 16; ++r) negm[r] = -mhat;
                const float f = __builtin_amdgcn_exp2f(-dl); l_reg *= f; if (hi == 0) wsf[r32] = f;
                asm volatile("s_waitcnt lgkmcnt(0)" ::: "memory");
#pragma unroll
                for (int d_ = 0; d_ < 2; ++d_)
#pragma unroll
                    for (int r = 0; r < 16; ++r) o[d_][r] *= wsf[crow(r, hi)];
                if (MSUM) {
#pragma unroll
                    for (int r = 0; r < 16; ++r) lacc[r] *= wsf[crow(r, hi)];
                }
                asm volatile("s_waitcnt lgkmcnt(0)" ::: "memory");
            }
            if (MSUM) {
#pragma unroll
                for (int r = 0; r < 16; ++r) { p0[r] = __builtin_amdgcn_exp2f(p0[r]); p1[r] = __builtin_amdgcn_exp2f(p1[r]); }
            } else {
                float sacc = 0.f;
#pragma unroll
                for (int r = 0; r < 16; ++r) { p0[r] = __builtin_amdgcn_exp2f(p0[r]); p1[r] = __builtin_amdgcn_exp2f(p1[r]); sacc += p0[r] + p1[r]; }
                l_reg += sacc;
            }
            u32x4 pw0, pw1, pw2, pw3;
            pw0 = (u32x4){cvtpk_s(p0[0], p0[1]), cvtpk_s(p0[2], p0[3]), cvtpk_s(p0[4], p0[5]), cvtpk_s(p0[6], p0[7])};
            pw1 = (u32x4){cvtpk_s(p0[8], p0[9]), cvtpk_s(p0[10], p0[11]), cvtpk_s(p0[12], p0[13]), cvtpk_s(p0[14], p0[15])};
            pw2 = (u32x4){cvtpk_s(p1[0], p1[1]), cvtpk_s(p1[2], p1[3]), cvtpk_s(p1[4], p1[5]), cvtpk_s(p1[6], p1[7])};
            pw3 = (u32x4){cvtpk_s(p1[8], p1[9]), cvtpk_s(p1[10], p1[11]), cvtpk_s(p1[12], p1[13]), cvtpk_s(p1[14], p1[15])};
            pv(o, vb0 + buf * 8192, __builtin_bit_cast(bf16x8, pw0), __builtin_bit_cast(bf16x8, pw1), __builtin_bit_cast(bf16x8, pw2), __builtin_bit_cast(bf16x8, pw3));
            if (MSUM) {
                lacc = __builtin_amdgcn_mfma_f32_32x32x16_bf16(__builtin_bit_cast(bf16x8, pw0), ones8, lacc, 0, 0, 0);
                lacc = __builtin_amdgcn_mfma_f32_32x32x16_bf16(__builtin_bit_cast(bf16x8, pw1), ones8, lacc, 0, 0, 0);
                lacc = __builtin_amdgcn_mfma_f32_32x32x16_bf16(__builtin_bit_cast(bf16x8, pw2), ones8, lacc, 0, 0, 0);
                lacc = __builtin_amdgcn_mfma_f32_32x32x16_bf16(__builtin_bit_cast(bf16x8, pw3), ones8, lacc, 0, 0, 0);
            }
        }
        buf ^= 1;
    }
    float rli[16];
    if (MSUM) {
        if (MODE == 1) { if (hi == 0) wsf[32 + r32] = __builtin_amdgcn_exp2f(sinkl2 - mhat); asm volatile("s_waitcnt lgkmcnt(0)" ::: "memory"); }
#pragma unroll
        for (int r = 0; r < 16; ++r) rli[r] = __builtin_amdgcn_rcpf(lacc[r] + (MODE == 1 ? wsf[32 + crow(r, hi)] : 0.f));
    } else {
        { auto rr = __builtin_amdgcn_permlane32_swap(__float_as_uint(l_reg), __float_as_uint(l_reg), false, false); l_reg = __uint_as_float(rr[0]) + __uint_as_float(rr[1]); }
        if (MODE == 1) l_reg += __builtin_amdgcn_exp2f(sinkl2 - mhat);
        if (hi == 0) wsf[32 + r32] = l_reg; asm volatile("s_waitcnt lgkmcnt(0)" ::: "memory");
#pragma unroll
        for (int r = 0; r < 16; ++r) rli[r] = __builtin_amdgcn_rcpf(wsf[32 + crow(r, hi)]);
    }
    bf16* Ow = d.O + (size_t)qw * d.ldo;
    { ATT_LAS bf16* stg = (ATT_LAS bf16*)(shm + LDS_OST) + wid * 2048;
#pragma unroll
      for (int r = 0; r < 16; ++r) { const int orow = crow(r, hi);
#pragma unroll
          for (int d0 = 0; d0 < 2; ++d0) { const unsigned w = cvtpk_s(o[d0][r] * rli[r], 0.f); stg[orow * 64 + d0 * 32 + r32] = (bf16)(w & 0xffffu); } }
      asm volatile("s_waitcnt lgkmcnt(0)" ::: "memory");
#pragma unroll
      for (int i = 0; i < 4; ++i) { const int row = i * 8 + (lane >> 3), ch = lane & 7; const u32x4 v = *(const ATT_LAS u32x4*)(stg + row * 64 + ch * 8); GS(u32x4, Ow + (size_t)row * d.ldo + ch * 8) = v; } }
    asm volatile("s_waitcnt lgkmcnt(0)\n\ts_barrier" ::: "memory");
#undef ATT_DMA
}
}
#define GAS __attribute__((address_space(1)))
#define LAS __attribute__((address_space(3)))
typedef unsigned short bf16;
typedef unsigned v4u __attribute__((ext_vector_type(4)));
typedef float f32x4 __attribute__((ext_vector_type(4)));
typedef float f32x16 __attribute__((ext_vector_type(16)));
constexpr int NWAVES = 8;
constexpr int LDS_BYTES = 155648;
constexpr size_t MiB = 1u << 20;
constexpr size_t WS_MODS = 0;
constexpr size_t WS_SHW = 3 * MiB;
constexpr size_t SHW_L = (size_t)32 * (NGU + NIN + NGU) * 4;
constexpr size_t WS_ROWSS = 8 * MiB;
constexpr size_t WS_RSTD = 13 * MiB;
constexpr size_t WS_CS = 12 * MiB, WS_SN = WS_CS + 131072;
constexpr size_t WS_BIAS = WS_SN + 131072;
constexpr size_t WS_CTL = 15 * MiB, CTL_BYTES = 16384;
constexpr size_t WS_W = 16 * MiB, W_LAYER = 48 * MiB;
constexpr size_t W_GU1 = 0, W_DN1 = 11 * MiB, W_GU2 = W_DN1 + 5632 * 1024, W_DN2 = W_GU2 + 11 * MiB, W_IN = 33 * MiB, W_QUP = W_IN + (size_t)NIN * 1024 * 2, W_KVUP = W_QUP + 262144, W_BR = 43 * MiB, W_OUT = 45 * MiB;
constexpr size_t WS_AP = 112 * MiB;
constexpr size_t WS_YS = 240 * MiB;
constexpr size_t WS_QC = 464 * MiB;
constexpr size_t WS_KVC = 512 * MiB;
constexpr size_t WS_YG = 576 * MiB;
constexpr size_t WS_H = 240 * MiB;
constexpr size_t WS_MG = 240 * MiB;
constexpr size_t WS_END = 960 * MiB;
static_assert(W_DN2 + 5632 * 1024 <= W_IN && W_KVUP + 131072 <= W_BR && W_OUT + 2 * MiB <= W_LAYER && WS_W + 2 * W_LAYER <= WS_AP, "weight map");
static_assert(WS_H + (size_t)MTOK * FF * 2 <= WS_YG + 3 * (size_t)MTOK * DM * 2 && WS_MG + (size_t)MTOK * DM * 4 <= WS_KVC && WS_SHW + 2 * SHW_L <= WS_ROWSS, "ws map");

struct Args { const float* in[25]; float* out; unsigned char* ws; };
__device__ __forceinline__ int lauint(int k) { asm volatile("" : "+s"(k)); return k; }
__device__ __forceinline__ unsigned char* lau(unsigned char* p) { asm volatile("" : "+s"(p)); return p; }

__device__ __forceinline__ unsigned f2bf(float f) { unsigned u = __builtin_bit_cast(unsigned, f); return (u + 0x7fffu + ((u >> 16) & 1u)) >> 16; }
__device__ __forceinline__ unsigned pk2(float lo, float hi) { return f2bf(lo) | (f2bf(hi) << 16); }
__device__ __forceinline__ float bflo(unsigned w) { return __uint_as_float(w << 16); }
__device__ __forceinline__ float bfhi(unsigned w) { return __uint_as_float(w & 0xffff0000u); }
__device__ __forceinline__ float wave_sum(float v) {
#pragma unroll
    for (int o = 1; o < 64; o <<= 1) v += __shfl_xor(v, o);
    return v;
}
__device__ __forceinline__ void tr_item(const float* W, int N, int k0, int n0, bf16* WT, int ldk, int drow0, int dk0, const float* kscale, LAS float* scr, int lane) {
#pragma unroll
    for (int i = 0; i < 32; ++i) { const int kk = 2 * i + (lane >> 5); float v = W[(size_t)(k0 + kk) * N + n0 + (lane & 31)]; if (kscale) v *= kscale[k0 + kk]; scr[kk * 33 + (lane & 31)] = v; }
    asm volatile("s_waitcnt lgkmcnt(0)" ::: "memory");
    const int c = lane & 7;
#pragma unroll
    for (int j = 0; j < 4; ++j) { const int n = (lane >> 3) + 8 * j; const LAS float* s = scr + (8 * c) * 33 + n;
        v4u o; o.x = pk2(s[0 * 33], s[1 * 33]); o.y = pk2(s[2 * 33], s[3 * 33]); o.z = pk2(s[4 * 33], s[5 * 33]); o.w = pk2(s[6 * 33], s[7 * 33]);
        GS(v4u, WT + (size_t)(drow0 + n) * ldk + dk0 + k0 + 8 * c) = o; }
    asm volatile("s_waitcnt lgkmcnt(0)" ::: "memory");
}
__device__ __forceinline__ void tr_matrix(const float* W, int K, int N, bf16* WT, int ldk, int dk0, int remap, const float* kscale, LAS float* scr, int lane, int gw, int NGW) {
    const int nblk = N / 32, items = (K / 64) * nblk;
    for (int it = gw; it < items; it += NGW) {
        const int kb = it / nblk, nb = it - kb * nblk, n0 = nb * 32;
        int dr = n0;
        if (remap == 1) dr = (n0 < FF) ? (n0 / 128) * 256 + (n0 % 128) : ((n0 - FF) / 128) * 256 + 128 + ((n0 - FF) % 128);
        else if (remap == 2) { dr = (n0 < 1696) ? n0 : n0 + 96; const int c = dr & 255; dr = (dr & ~255) + 128 * ((c & 63) >> 5) + 32 * (c >> 6); }
        tr_item(W, N, kb * 64, n0, WT, ldk, dr, dk0, kscale, scr, lane);
    }
}
__device__ __forceinline__ void sg_item(const float* in, int in_stride, bool do_silu, const float* W, int N, int n0, float* out, int out_stride, int dcol0, const float* bias, int lane) {
    const int i = lane & 31, hi = lane >> 5;
    f32x16 acc = f32x16{};
    const float* ip = in + (size_t)i * in_stride + 4 * hi;
    const float* wp = W + (size_t)(4 * hi) * N + n0 + i;
#pragma unroll 4
    for (int k0 = 0; k0 < 1024; k0 += 8) {
        f32x4 a = GL(f32x4, ip + k0);
        if (do_silu) { a[0] = a[0] / (1.0f + __expf(-a[0])); a[1] = a[1] / (1.0f + __expf(-a[1])); a[2] = a[2] / (1.0f + __expf(-a[2])); a[3] = a[3] / (1.0f + __expf(-a[3])); }
        const float b0 = wp[(size_t)(k0 + 0) * N], b1 = wp[(size_t)(k0 + 1) * N], b2 = wp[(size_t)(k0 + 2) * N], b3 = wp[(size_t)(k0 + 3) * N];
        acc = __builtin_amdgcn_mfma_f32_32x32x2f32(a[0], b0, acc, 0, 0, 0);
        acc = __builtin_amdgcn_mfma_f32_32x32x2f32(a[1], b1, acc, 0, 0, 0);
        acc = __builtin_amdgcn_mfma_f32_32x32x2f32(a[2], b2, acc, 0, 0, 0);
        acc = __builtin_amdgcn_mfma_f32_32x32x2f32(a[3], b3, acc, 0, 0, 0);
    }
    const float bv = bias ? bias[n0 + i] : 0.f;
#pragma unroll
    for (int r = 0; r < 16; ++r) { const int b = (r & 3) + 8 * (r >> 2) + 4 * hi; out[(size_t)b * out_stride + dcol0 + i] = acc[r] + bv; }
}
__device__ __forceinline__ void sincos_d(float af, float& sv, float& cv) {
    const double a = (double)af; const double kq = rint(a * 0.63661977236758134308); const double r = (a - kq * 1.57079632679489655800) - kq * 6.123233995736766e-17;
    const double r2 = r * r;
    const double s = r * (1.0 - r2 * (1.0 / 6.0 - r2 * (1.0 / 120.0 - r2 * (1.0 / 5040.0 - r2 * (1.0 / 362880.0 - r2 * (1.0 / 39916800.0 - r2 * (1.0 / 6227020800.0 - r2 * (1.0 / 1307674368000.0))))))));
    const double c = 1.0 - r2 * (0.5 - r2 * (1.0 / 24.0 - r2 * (1.0 / 720.0 - r2 * (1.0 / 40320.0 - r2 * (1.0 / 3628800.0 - r2 * (1.0 / 479001600.0 - r2 * (1.0 / 87178291200.0 - r2 * (1.0 / 20922789888000.0))))))));
    const int q = ((int)kq) & 3;
    const double ss = (q == 0) ? s : (q == 1) ? c : (q == 2) ? -s : -c;
    const double cc = (q == 0) ? c : (q == 1) ? -s : (q == 2) ? -c : s;
    sv = (float)ss; cv = (float)cc;
}
#define XB_TMO      128
#define XB_XCNT(j)  (256  + 64 * (j))
#define XB_XSUB(j)  (1280 + 64 * (j))
#define XB_XGEN(j)  (2304 + 64 * (j))
#define XB_TOP      3328
#define XB_TOPGEN   3392
#define XCD_BAR_WORDS 3456
#define XB_SPIN_CAP (1u << 18)

__device__ __forceinline__ unsigned xb_ld(unsigned* p)              { return __hip_atomic_load(p, __ATOMIC_RELAXED, __HIP_MEMORY_SCOPE_AGENT); }
__device__ __forceinline__ unsigned xb_add(unsigned* p, unsigned v) { return __hip_atomic_fetch_add(p, v, __ATOMIC_RELAXED, __HIP_MEMORY_SCOPE_AGENT); }
__device__ __forceinline__ unsigned xb_xcc_id() { return (unsigned)__builtin_amdgcn_s_getreg((3 << 11) | 20) & 0xFu; }
#define XB_SPIN(cond, bar) do { unsigned _sp = 0; while (cond) { __builtin_amdgcn_s_sleep(1); \
    if ((++_sp & 255u) == 0u) { if (xb_ld(&(bar)[XB_TMO])) break; if (_sp > XB_SPIN_CAP) { atomicAdd(&(bar)[XB_TMO], 1u); break; } } } } while (0)

struct XcdBarrier {
    unsigned* bar; unsigned x;
    volatile LAS unsigned* st;
};

__device__ __forceinline__ XcdBarrier xcd_barrier_post(unsigned* bar, volatile LAS unsigned* st) {
    XcdBarrier b; b.bar = bar; b.x = (unsigned)__builtin_amdgcn_readfirstlane((int)xb_xcc_id()); b.st = st;
    if (threadIdx.x == 0) (void)xb_add(&bar[XB_XCNT(b.x)], 1u);
    return b;
}
__device__ __forceinline__ void xcd_barrier_complete(unsigned* bar, unsigned x, unsigned& nloc, unsigned& nx) {
    const unsigned G = gridDim.x * gridDim.y * gridDim.z;
    unsigned sum, cnt, mine, sp = 0u;
    for (;;) {
        sum = 0u; cnt = 0u; mine = 0u;
#pragma unroll
        for (unsigned j = 0; j < 16; ++j) { const unsigned c = xb_ld(&bar[XB_XCNT(j)]); sum += c; cnt += (c > 0u) ? 1u : 0u; mine = (j == x) ? c : mine; }
        if (sum == G) break;
        __builtin_amdgcn_s_sleep(1);
        if ((++sp & 255u) == 0u) { if (xb_ld(&bar[XB_TMO])) break; if (sp > XB_SPIN_CAP) { atomicAdd(&bar[XB_TMO], 1u); break; } }
    }
    nloc = mine > 0u ? mine : 1u; nx = cnt > 0u ? cnt : 1u;
}

__device__ __forceinline__ void xcd_barrier(const XcdBarrier& b) {
    asm volatile("s_waitcnt vmcnt(0)" ::: "memory");
    __syncthreads();
    if (threadIdx.x == 0) {
        unsigned* bar = b.bar;
        __builtin_amdgcn_s_waitcnt(0);
        unsigned nloc = b.st[0], nx = b.st[1];
        if (nloc == 0u) { xcd_barrier_complete(bar, b.x, nloc, nx); b.st[0] = nloc; b.st[1] = nx; }
        const unsigned old = xb_add(&bar[XB_XSUB(b.x)], 1u);
        const unsigned gen = old / nloc;
        if (old + 1u == (gen + 1u) * nloc) {
            __builtin_amdgcn_fence(__ATOMIC_RELEASE, "agent");
            asm volatile("s_waitcnt vmcnt(0)" ::: "memory");
            const unsigned og = xb_add(&bar[XB_TOP], 1u);
            const unsigned tg = og / nx;
            if (og + 1u == (tg + 1u) * nx) xb_add(&bar[XB_TOPGEN], 1u);
            else XB_SPIN(xb_ld(&bar[XB_TOPGEN]) == tg, bar);
            __builtin_amdgcn_fence(__ATOMIC_ACQUIRE, "agent");
            xb_add(&bar[XB_XGEN(b.x)], 1u);
            asm volatile("s_waitcnt vmcnt(0)" ::: "memory");
        } else {
            XB_SPIN(xb_ld(&bar[XB_XGEN(b.x)]) == gen, bar);
            __builtin_amdgcn_fence(__ATOMIC_ACQUIRE, "agent");
            asm volatile("s_waitcnt vmcnt(0)" ::: "memory");
        }
    }
    __syncthreads();
}

#ifndef PHMASK
#define PHMASK 0x1FFF
#endif
#define PH_ON(k) (((PHMASK) >> (k)) & 1)
#define INP(k) (args.in[lauint(k)])
__global__ void __launch_bounds__(NWAVES * 64, 2) mega_fwd(Args args) {
    extern __shared__ __attribute__((aligned(16))) unsigned char lds[];
    cg::grid_group grid = cg::this_grid();
    const int G = gridDim.x, bx = blockIdx.x;
    const int vcu = (G % 8 == 0) ? (bx % 8) * (G / 8) + bx / 8 : bx;
    const int NGW = G * NWAVES;
    volatile LAS unsigned* MISC = (volatile LAS unsigned*)((LAS unsigned char*)lds + 131072 + 320);
    if (threadIdx.x < 32) MISC[threadIdx.x] = 0u;
    __syncthreads();
    XcdBarrier xbar = xcd_barrier_post((unsigned*)(args.ws + WS_CTL), MISC + 8);
#define GRID_BAR() do { XcdBarrier bb_ = xbar; bb_.bar = (unsigned*)lau((unsigned char*)bb_.bar); bb_.x = (unsigned)lauint((int)bb_.x); xcd_barrier(bb_); } while (0)
#define PTRS const int tid = lautid(), lane = tid & 63, wave = __builtin_amdgcn_readfirstlane(tid >> 6), gw = vcu * NWAVES + wave; (void)lane; (void)gw; unsigned char* ws = lau(args.ws); float* X = (float*)lau((unsigned char*)args.out); (void)X; \
    float* mods = (float*)(ws + WS_MODS); float* rowss = (float*)(ws + WS_ROWSS); float* rstdv = (float*)(ws + WS_RSTD); (void)rstdv; float* cs = (float*)(ws + WS_CS); float* sn = (float*)(ws + WS_SN); float* biasT = (float*)(ws + WS_BIAS); \
    bf16* AP = (bf16*)(ws + WS_AP); bf16* YS = (bf16*)(ws + WS_YS); bf16* QC = (bf16*)(ws + WS_QC); bf16* KVC = (bf16*)(ws + WS_KVC); bf16* YG = (bf16*)(ws + WS_YG); bf16* HB = (bf16*)(ws + WS_H); float* MG = (float*)(ws + WS_MG); \
    (void)mods; (void)rowss; (void)cs; (void)sn; (void)biasT; (void)AP; (void)YS; (void)QC; (void)KVC; (void)YG; (void)HB; (void)MG; \
    unsigned char* wl = ws + WS_W + (size_t)l * W_LAYER; const float* ml = mods + (size_t)l * NB * NMOD; const float* shw = (const float*)(ws + WS_SHW + (size_t)l * SHW_L); (void)wl; (void)ml; (void)shw;
    LAS unsigned char* ldsl = (LAS unsigned char*)lds;

    if (PH_ON(0)) {
        const int l = 0; PTRS
        for (int it = gw; it < 2 * (NMOD / 32); it += NGW) { const int l = it / (NMOD / 32), n0 = (it % (NMOD / 32)) * 32;
            sg_item(INP(1), DM, true, INP(2) + (size_t)l * DM * NMOD, NMOD, n0, mods + (size_t)l * NB * NMOD, NMOD, n0, INP(3) + (size_t)l * NMOD, lane); }
        for (int e = bx * 512 + tid; e < 2048 * 16; e += G * 512) { const int p = e >> 4, i = e & 15; const float inv = powf(10000.0f, -(float)(2 * i) / 32.0f); const float ang = (float)p * inv; float s, c; sincos_d(ang, s, c); cs[e] = c; sn[e] = s; }
        for (int e = bx * 512 + tid; e < 6 * 257; e += G * 512) { const int h = e / 257, idx = e % 257, rel = idx - 128, n = rel < 0 ? -rel : rel;
            int bk = rel > 0 ? 16 : 0; if (n < 8) bk += n; else { int lg = 31 - __clz(n * n); int large = 2 + lg; if (large > 15) large = 15; bk += large; }
            biasT[h * 260 + idx] = INP(12)[bk * 6 + h] * LOG2E; }
        LAS float* scr = (LAS float*)(ldsl + wave * 16384);
#pragma unroll 1
        for (int l2 = 0; l2 < 2; ++l2) { const int l = l2;
            unsigned char* wl = ws + WS_W + (size_t)l * W_LAYER;
            tr_matrix(INP(5) + (size_t)l * DM * NGU, DM, NGU, (bf16*)(wl + W_GU1), DM, 0, 1, nullptr, scr, lane, gw, NGW);
            tr_matrix(INP(6) + (size_t)l * FF * DM, FF, DM, (bf16*)(wl + W_DN1), FF, 0, 0, nullptr, scr, lane, gw, NGW);
            tr_matrix(INP(22) + (size_t)l * DM * NGU, DM, NGU, (bf16*)(wl + W_GU2), DM, 0, 1, nullptr, scr, lane, gw, NGW);
            tr_matrix(INP(23) + (size_t)l * FF * DM, FF, DM, (bf16*)(wl + W_DN2), FF, 0, 0, nullptr, scr, lane, gw, NGW);
            tr_matrix(INP(8) + (size_t)l * DM * 4768, DM, 4768, (bf16*)(wl + W_IN), DM, 0, 2, nullptr, scr, lane, gw, NGW);
            tr_matrix(INP(14) + (size_t)l * 256 * 384, 256, 384, (bf16*)(wl + W_QUP), 256, 0, 0, INP(13) + l * 256, scr, lane, gw, NGW);
            tr_matrix(INP(16) + (size_t)l * 128 * 512, 128, 512, (bf16*)(wl + W_KVUP), 128, 0, 0, INP(15) + l * 128, scr, lane, gw, NGW);
            tr_matrix(INP(17) + (size_t)l * 384 * DM, 384, DM, (bf16*)(wl + W_BR), DM, 0, 0, nullptr, scr, lane, gw, NGW);
            tr_matrix(INP(18) + (size_t)l * 384 * DM, 384, DM, (bf16*)(wl + W_BR), DM, 384, 0, nullptr, scr, lane, gw, NGW);
            tr_matrix(INP(19) + (size_t)l * 256 * DM, 256, DM, (bf16*)(wl + W_BR), DM, 768, 0, nullptr, scr, lane, gw, NGW);
            tr_matrix(INP(20) + (size_t)l * DM * DM, DM, DM, (bf16*)(wl + W_OUT), DM, 0, 0, nullptr, scr, lane, gw, NGW);
            for (int e = bx * 512 + tid; e < 96 * 1024 / 8; e += G * 512) { const int rr = e >> 7, r2 = rr < 32 ? 1536 + 96 + rr : 1536 + 192 + (rr - 32); ((v4u*)(wl + W_IN + (size_t)r2 * 1024 * 2))[e & 127] = (v4u){0u, 0u, 0u, 0u}; }
            for (int e = bx * 512 + tid; e < 128 * 256 / 8; e += G * 512) ((v4u*)(wl + W_QUP + (size_t)384 * 256 * 2))[e] = (v4u){0u, 0u, 0u, 0u};
        }
    }
    grid.sync();
    if (PH_ON(1)) {
        const int l = 0; PTRS
#pragma unroll 1
        for (int l2 = 0; l2 < 2; ++l2) { const int l = l2;
            float* shw = (float*)(ws + WS_SHW + (size_t)l * SHW_L); const float* ml = mods + (size_t)l * NB * NMOD;
            for (int it = gw; it < (NGU + 4768 + NGU) / 32; it += NGW) {
                int n0 = it * 32;
                if (n0 < NGU) { const int dr = (n0 < FF) ? (n0 / 128) * 256 + (n0 % 128) : ((n0 - FF) / 128) * 256 + 128 + ((n0 - FF) % 128);
                    sg_item(ml + 0 * DM, NMOD, false, INP(5) + (size_t)l * DM * NGU, NGU, n0, shw, NGU, dr, nullptr, lane); continue; }
                n0 -= NGU;
                if (n0 < 4768) { const int dr = (n0 < 1696) ? n0 : n0 + 96;
                    sg_item(ml + 3 * DM, NMOD, false, INP(8) + (size_t)l * DM * 4768, 4768, n0, shw + 32 * NGU, NIN, dr, nullptr, lane); continue; }
                n0 -= 4768;
                { const int dr = (n0 < FF) ? (n0 / 128) * 256 + (n0 % 128) : ((n0 - FF) / 128) * 256 + 128 + ((n0 - FF) % 128);
                    sg_item(ml + 6 * DM, NMOD, false, INP(22) + (size_t)l * DM * NGU, NGU, n0, shw + 32 * NGU + 32 * NIN, NGU, dr, nullptr, lane); }
            }
        }
        const float* gain = INP(4);
#pragma unroll 2
        for (int m = gw; m < MTOK; m += NGW) {
            const int b = m >> 11; const f32x4* xr = (const f32x4*)(INP(0) + (size_t)m * DM) + lane; const float* scp = mods + (size_t)b * NMOD + 1 * DM;
            f32x4 v[4]; float s = 0.f;
#pragma unroll
            for (int j = 0; j < 4; ++j) { v[j] = xr[64 * j]; s += (v[j][0] * v[j][0] + v[j][1] * v[j][1]) + (v[j][2] * v[j][2] + v[j][3] * v[j][3]); }
            s = wave_sum(s);
            if (lane < 16) rowss[(size_t)m * 16 + lane] = lane == 0 ? s : 0.f;
            unsigned long long* o8 = (unsigned long long*)(AP + (size_t)m * DM) + lane;
#pragma unroll
            for (int j = 0; j < 4; ++j) { const int col = 4 * lane + 256 * j; const f32x4 g = GL(f32x4, gain + col), sc = GL(f32x4, scp + col); const f32x4 y = v[j] * g * (sc + 1.0f);
                o8[64 * j] = (unsigned long long)pk2(y[0], y[1]) | ((unsigned long long)pk2(y[2], y[3]) << 32); }
        }
    }
    GRID_BAR();

#pragma unroll 1
    for (int ph = 0; ph < 26; ++ph) {
        const int l = ph >= 13 ? 1 : 0, k = ph - 13 * l, f = k >= 10 ? 1 : 0;
        if ((k == 0 || k == 3 || k == 10) && PH_ON(12)) { PTRS  for (int row = bx * 512 + tid; row < MTOK; row += G * 512) { const f32x4 a = GL(f32x4, rowss + (size_t)row * 16), b = GL(f32x4, rowss + (size_t)row * 16 + 4), c = GL(f32x4, rowss + (size_t)row * 16 + 8), d = GL(f32x4, rowss + (size_t)row * 16 + 12); const float sq = ((a[0] + a[1]) + (a[2] + a[3])) + ((b[0] + b[1]) + (b[2] + b[3])) + ((c[0] + c[1]) + (c[2] + c[3])) + ((d[0] + d[1]) + (d[2] + d[3])); rstdv[row] = 1.0f / sqrtf(sq * (1.0f / 1024.0f) + EPS); } }
        {
            {
                if (k == 4 && PH_ON(2)) { PTRS   pg8::Gemm g{AP, (const bf16*)(wl + W_IN), DM, DM}; pg8::Order S; S.init(MTOK, NIN, G, bx, DM / 64, 0);
                  pg8::EpiIn E{YS, YG, rstdv, shw + 32 * NGU, ldsl + 131072 + 1024};
                  pg8::gemm_phase<pg8::EpiIn, pg8::Order, true, true>(ldsl, g, S, E); }
                if (k == 5 && PH_ON(3)) { PTRS
                    const float* gq = INP(9) + l * 64; const float* gk = INP(10) + l * 64;
#pragma unroll 2
                    for (int m = gw; m < MTOK; m += NGW) {
                        const int t = m & (SEQ - 1), rp = t >> 6, cp = t & 63;
                        bf16* yr = YS + (size_t)m * NYS;
                        const v4u w1 = GL(v4u, yr + lane * 8), w2 = GL(v4u, yr + 1280 + lane * 8);
                        { float v[8] = {bflo(w1.x), bfhi(w1.x), bflo(w1.y), bfhi(w1.y), bflo(w1.z), bfhi(w1.z), bflo(w1.w), bfhi(w1.w)};
                          const int hh = lane >> 3, j = lane & 7;
                          float ss = 0.f;
#pragma unroll
                          for (int e = 0; e < 8; ++e) ss += v[e] * v[e];
                          ss += __shfl_xor(ss, 1); ss += __shfl_xor(ss, 2); ss += __shfl_xor(ss, 4);
                          const float rstd = 1.0f / sqrtf(ss * (1.0f / 64.0f) + EPS);
                          const float* gp = (hh < 6 ? gq : gk) + j * 8;
                          const int pos = (j < 4) ? rp : cp; const float* cp_ = cs + pos * 16 + (j & 1) * 8; const float* sp_ = sn + pos * 16 + (j & 1) * 8;
                          const float osc = hh < 6 ? C2A : 1.0f; float o[8];
#pragma unroll
                          for (int e = 0; e < 8; ++e) { const float a = v[e] * rstd * gp[e]; const float pa = __shfl_xor(a, 2); const float c = cp_[e], s = sp_[e];
                              o[e] = ((j & 2) == 0 ? a * c - pa * s : pa * s + a * c) * osc; }
                          v4u ow; ow.x = pk2(o[0], o[1]); ow.y = pk2(o[2], o[3]); ow.z = pk2(o[4], o[5]); ow.w = pk2(o[6], o[7]);
                          GS(v4u, yr + lane * 8) = ow; }
                        { float v[8] = {bflo(w2.x), bfhi(w2.x), bflo(w2.y), bfhi(w2.y), bflo(w2.z), bfhi(w2.z), bflo(w2.w), bfhi(w2.w)};
                          float ss = 0.f;
#pragma unroll
                          for (int e = 0; e < 8; ++e) ss += v[e] * v[e];
                          ss += __shfl_xor(ss, 1); ss += __shfl_xor(ss, 2); ss += __shfl_xor(ss, 4); ss += __shfl_xor(ss, 8);
                          const float s32 = ss + __shfl_xor(ss, 16);
                          const float rstd = lane < 32 ? 1.0f / sqrtf(s32 * (1.0f / 256.0f) + EPS) : 1.0f / sqrtf(ss * (1.0f / 128.0f) + EPS);
                          const int j = lane & 3; const float* cp_ = cs + t * 16 + (j & 1) * 8; const float* sp_ = sn + t * 16 + (j & 1) * 8;
                          float o[8];
#pragma unroll
                          for (int e = 0; e < 8; ++e) { const float pa = __shfl_xor(v[e], 2); const float c = cp_[e], s = sp_[e];
                              o[e] = lane < 48 ? v[e] * rstd : ((j & 2) == 0 ? v[e] * c - pa * s : pa * s + v[e] * c); }
                          v4u ow; ow.x = pk2(o[0], o[1]); ow.y = pk2(o[2], o[3]); ow.z = pk2(o[4], o[5]); ow.w = pk2(o[6], o[7]);
                          if (lane < 52) GS(v4u, yr + 1280 + lane * 8) = ow; }
                    }
                }
                if (k == 6 && PH_ON(4)) { PTRS  pg8::Gemm g{YS + 1280, (const bf16*)(wl + W_QUP), NYS, 256}; pg8::Order S; S.init(MTOK, 512, G, bx, 4, 0);
                  pg8::EpiQup E{QC, cs, sn};
                  pg8::gemm_phase<pg8::EpiQup, pg8::Order, true, true>(ldsl, g, S, E); }
                if (k == 6 && PH_ON(5)) { PTRS  pg8::Gemm g{YS + 1536, (const bf16*)(wl + W_KVUP), NYS, 128}; pg8::Order S; S.init(MTOK, 512, G, bx, 2, 0);
                  pg8::EpiPlain E{KVC, 512};
                  pg8::gemm_phase<pg8::EpiPlain, pg8::Order, true, true>(ldsl, g, S, E); }
#ifndef ATT_REP
#define ATT_REP 1
#endif
                for (int rep = 0; rep < ATT_REP; ++rep) if (k == 7 && PH_ON(6)) { PTRS
                    const int b = vcu >> 3, jj = vcu & 7; const size_t r0 = (size_t)b * SEQ;
#pragma unroll 1
                    for (int i = 0; i < 6; ++i) { const int e = (jj & 3) * 6 + i, h = (jj >> 2) * 3 + (e >> 3), qb = e & 7, kvh = jj >> 2;
                        att::Desc d{YS + r0 * NYS + h * 64, NYS, YS + r0 * NYS + 384 + kvh * 64, NYS, nullptr, 0, YS + r0 * NYS + 512 + kvh * 64, NYS, AP + r0 * DM + h * 64, DM};
                        att::unit<64, 0>(d, qb * 256, (att::ATT_LAS_T)lds, nullptr, 0.f); }
#pragma unroll 1
                    for (int i = 0; i < 4; ++i) { const int e = jj * 4 + i, h = e >> 3, qb = e & 7;
                        att::Desc d{QC + r0 * 384 + h * 96, 384, KVC + r0 * 512 + h * 128, 512, YS + r0 * NYS + 1664, NYS, KVC + r0 * 512 + h * 128 + 64, 512, AP + r0 * DM + 768 + h * 64, DM};
                        att::unit<96, 0>(d, qb * 256, (att::ATT_LAS_T)lds, nullptr, 0.f); }
#pragma unroll 1
                    for (int i = 0; i < 6; ++i) { const int e = (jj & 3) * 6 + i, h = (jj >> 2) * 3 + (e >> 3), qb = e & 7, kvh = jj >> 2;
                        att::Desc d{YS + r0 * NYS + 640 + h * 64, NYS, YS + r0 * NYS + 1024 + kvh * 64, NYS, nullptr, 0, YS + r0 * NYS + 1152 + kvh * 64, NYS, AP + r0 * DM + 384 + h * 64, DM};
                        att::unit<64, 1>(d, qb * 256, (att::ATT_LAS_T)lds, biasT + h * 260, INP(11)[l * 6 + h] * LOG2E); }
                }
                if (k == 8 && PH_ON(7)) { PTRS  pg8::Gemm g{AP, (const bf16*)(wl + W_BR), DM, DM}; pg8::Order S; S.init(MTOK, DM, G, bx, 0, 1);
                  pg8::EpiBr E{YG, MG};
                  pg8::gemm_phase<pg8::EpiBr, pg8::Order, true, true>(ldsl, g, S, E); }
                if (k == 9 && PH_ON(8)) { PTRS  pg8::Gemm g{YG, (const bf16*)(wl + W_OUT), DM, DM}; pg8::Order S; S.init(MTOK, DM, G, bx, DM / 64, 0);
                  pg8::EpiRes E{X, X, ml + 5 * DM, AP, INP(21) + l * DM, ml + 7 * DM, rowss, ldsl + 131072 + 1024, 1.0f, 0};
                  pg8::gemm_phase<pg8::EpiRes, pg8::Order, true, true>(ldsl, g, S, E); }
            }
            if ((k == 1 || k == 11) && PH_ON(9)) { PTRS   pg8::Gemm g{AP, (const bf16*)(wl + (f ? W_GU2 : W_GU1)), DM, DM}; pg8::Order S; S.init(MTOK, NGU, G, bx, DM / 64, 0);
              pg8::EpiGU E{HB, rstdv, shw + (f ? 32 * NGU + 32 * NIN : 0)};
              pg8::gemm_phase<pg8::EpiGU, pg8::Order, true, true>(ldsl, g, S, E); }
            if ((k == 2 || k == 12) && PH_ON(10)) { PTRS  pg8::Gemm g{HB, (const bf16*)(wl + (f ? W_DN2 : W_DN1)), FF, FF}; pg8::Order S; S.init(MTOK, DM, G, bx, FF / 64, 0);
              const float* base = (l == 0 && f == 0) ? INP(0) : X;
              const bool has_next = !(l == 1 && f == 1);
              const float* ngain = f == 0 ? INP(7) + l * DM : INP(4) + (l + 1) * DM;
              const float* nsc = f == 0 ? ml + 4 * DM : ml + (size_t)NB * NMOD + 1 * DM;
              pg8::EpiRes E{base, X, ml + (f ? 8 : 2) * DM, has_next ? AP : nullptr, ngain, nsc, rowss, ldsl + 131072 + 1024, 0.5f, 0};
              pg8::gemm_phase<pg8::EpiRes, pg8::Order, true, true>(ldsl, g, S, E); }
        }
        GRID_BAR();
    }
    if (PH_ON(11)) {
        const int l = 0; PTRS
        const float* gain = INP(24);
        for (int m = gw; m < MTOK; m += 2 * NGW) {
            f32x4* xr0 = (f32x4*)(X + (size_t)m * DM) + lane; f32x4* xr1 = (f32x4*)(X + (size_t)(m + NGW) * DM) + lane; f32x4 v[2][4]; float s0 = 0.f, s1 = 0.f;
#pragma unroll
            for (int j = 0; j < 4; ++j) { v[0][j] = GL(f32x4, xr0 + 64 * j); v[1][j] = GL(f32x4, xr1 + 64 * j); }
#pragma unroll
            for (int j = 0; j < 4; ++j) { s0 += (v[0][j][0] * v[0][j][0] + v[0][j][1] * v[0][j][1]) + (v[0][j][2] * v[0][j][2] + v[0][j][3] * v[0][j][3]); s1 += (v[1][j][0] * v[1][j][0] + v[1][j][1] * v[1][j][1]) + (v[1][j][2] * v[1][j][2] + v[1][j][3] * v[1][j][3]); }
            const float r0 = 1.0f / sqrtf(wave_sum(s0) * (1.0f / 1024.0f) + EPS), r1 = 1.0f / sqrtf(wave_sum(s1) * (1.0f / 1024.0f) + EPS);
#pragma unroll
            for (int j = 0; j < 4; ++j) { const f32x4 g = GL(f32x4, gain + 4 * lane + 256 * j); GS(f32x4, xr0 + 64 * j) = v[0][j] * r0 * g; GS(f32x4, xr1 + 64 * j) = v[1][j] * r1 * g; }
        }
    }
}

extern "C" void kernel_launch(void* const* d_in, const int* in_sizes, int n_in, void* d_out, int out_size, void* d_ws, size_t ws_size, hipStream_t stream) {
    static int grid = 0;
    if (grid == 0) {
        if (n_in != 25 || out_size != MTOK * DM || ws_size < WS_END) { fprintf(stderr, "kernel_launch: unexpected shapes (n_in %d, out %d, ws %zu)\n", n_in, out_size, ws_size); grid = -1; return; }
        int dev = 0, cus = 0, per_cu = 0;
        hipGetDevice(&dev); hipDeviceGetAttribute(&cus, hipDeviceAttributeMultiprocessorCount, dev);
        if (hipFuncSetAttribute((const void*)mega_fwd, hipFuncAttributeMaxDynamicSharedMemorySize, LDS_BYTES) != hipSuccess) { fprintf(stderr, "kernel_launch: hipFuncSetAttribute failed\n"); grid = -1; return; }
        if (hipOccupancyMaxActiveBlocksPerMultiprocessor(&per_cu, (const void*)mega_fwd, NWAVES * 64, LDS_BYTES) != hipSuccess || per_cu < 1) { fprintf(stderr, "kernel_launch: occupancy query failed (%d)\n", per_cu); per_cu = 1; }
        (void)hipGetLastError();
        grid = cus * (per_cu > 1 ? 1 : per_cu);
        fprintf(stderr, "kernel_launch: grid %d (cus %d, per_cu %d)\n", grid, cus, per_cu);
    }
    if (grid < 0) return;
    if (hipMemsetAsync((char*)d_ws + WS_CTL, 0, CTL_BYTES, stream) != hipSuccess) { fprintf(stderr, "kernel_launch: memset failed\n"); return; }
    Args a{};
    for (int i = 0; i < 25; ++i) a.in[i] = (const float*)d_in[i];
    a.out = (float*)d_out; a.ws = (unsigned char*)d_ws;
    void* kargs[] = {&a};
    hipError_t e = hipLaunchCooperativeKernel((const void*)mega_fwd, dim3(grid), dim3(NWAVES * 64), kargs, LDS_BYTES, stream);
    if (e != hipSuccess) fprintf(stderr, "kernel_launch: cooperative launch failed: %s (grid %d)\n", hipGetErrorString(e), grid);
}
```

```cpp
#include <hip/hip_runtime.h>
#include <hip/hip_cooperative_groups.h>
#include <hip/hip_bf16.h>
#include <cstdio>
#include <cstdint>
#include <cmath>
namespace cg = cooperative_groups;
#define GL(T, p) (*(const __attribute__((address_space(1))) T*)(p))
#define GS(T, p) (*(__attribute__((address_space(1))) T*)(p))
#define GLB(T, base, boff) (*(const __attribute__((address_space(1))) T*)((const __attribute__((address_space(1))) char*)(base) + (unsigned)(boff)))
#define GSB(T, base, boff) (*(__attribute__((address_space(1))) T*)((__attribute__((address_space(1))) char*)(base) + (unsigned)(boff)))
__device__ __forceinline__ int lautid() { int t = threadIdx.x; asm volatile("" : "+v"(t)); return t; }
namespace pg8 {
#define PG8_LAS __attribute__((address_space(3)))
typedef unsigned short bf16_t;
typedef short bf16x8 __attribute__((ext_vector_type(8)));
typedef float f32x4 __attribute__((ext_vector_type(4)));
typedef unsigned u32x4 __attribute__((ext_vector_type(4)));
constexpr int BM = 256, BK = 64, HALF = 128, HTB = HALF * BK * 2  , STAGE_BYTES = 8 * HTB, NXCD = 8, WGM = 8;

__host__ __device__ __forceinline__ int lds_byte(int r, int c) { const int st = (r >> 4) * 2 + (c >> 5), rr = r & 15, cc = c & 31, ob = rr * 64 + cc * 2; return st * 1024 + (ob ^ (((ob >> 9) & 1) << 5)); }
__host__ __device__ __forceinline__ void stage_rc(int b, int& R, int& C) { const int st = b / 1024, sb = b % 1024, swz = sb ^ (((sb >> 9) & 1) << 5); R = (st >> 1) * 16 + swz / 64; C = (st & 1) * 32 + (swz % 64) / 2; }
__host__ __device__ __forceinline__ int perm32(int rho) { const int n = rho >> 4, i = rho & 15; return 8 * (i >> 2) + 4 * n + (i & 3); }

struct Unit { int pm, pn, k0, nt, br; };
struct Gemm { const bf16_t* A; const bf16_t* Bt; int lda, ldb; };

struct Order {
    int nM, nN, nwg, G, c, nt, mode;
    __device__ __forceinline__ void init(int M, int N, int G_, int c_, int nt_, int mode_) { nM = M / BM; nN = N / BM; nwg = nM * nN; G = G_; c = c_; nt = nt_; mode = mode_; asm volatile("" : "+s"(nt)); }
    __device__ __forceinline__ bool next(int i, Unit& u) const {
        const int ii = mode ? i / 3 : i;
        const int L = ii * G + c; if (L >= nwg) return false;
        int wgid = L; { const int q = nwg / NXCD, r = nwg % NXCD, xcd = wgid % NXCD, off = wgid / NXCD; wgid = (xcd < r ? xcd * (q + 1) : r * (q + 1) + (xcd - r) * q) + off; }
        const int nig = WGM * nN, gid = wgid / nig, fm = gid * WGM, gsz = (nM - fm) < WGM ? (nM - fm) : WGM;
        u.pm = fm + ((wgid % nig) % gsz); u.pn = (wgid % nig) / gsz;
        if (mode) { const int br = i - ii * 3; u.br = br; u.k0 = br * 384; u.nt = (br == 2) ? 4 : 6; } else { u.br = 0; u.k0 = 0; u.nt = nt; }
        return true;
    }
    __device__ __forceinline__ void a_ready(const Unit&) const {}
    __device__ __forceinline__ void done(const Unit&) const {}
};
typedef float f32x2_cv __attribute__((ext_vector_type(2))); typedef __bf16 bf16x2_cv __attribute__((ext_vector_type(2)));
__device__ __forceinline__ unsigned cvt_pk_bf16(float lo, float hi) { f32x2_cv v = {lo, hi}; bf16x2_cv b = __builtin_convertvector(v, bf16x2_cv); return __builtin_bit_cast(unsigned, b); }
template <class Epi, class Sched, bool ALIGN_EPI = false, bool SP2 = false>
__device__ __forceinline__ void gemm_phase(PG8_LAS unsigned char* lds, const Gemm g, const Sched& S, const Epi& E) {
    const int tid = lautid(), wid = __builtin_amdgcn_readfirstlane(tid >> 6), lane = tid & 63, wr = wid >> 2, wc = wid & 3, fr = lane & 15, fq = lane >> 4;
    int nt;
    unsigned voffA[2], voffB[2];
#pragma unroll
    for (int i = 0; i < 2; ++i) { int R, C; stage_rc(tid * 16 + i * 8192, R, C); const int Rb = Epi::PERM ? ((R & ~31) + perm32(R & 31)) : R;
        voffA[i] = (unsigned)(R * g.lda + C) * 2u; voffB[i] = (unsigned)(Rb * g.ldb + C) * 2u; }
    const size_t kstep = (size_t)(BK * 2);
    const size_t hstepA = (size_t)HALF * g.lda * 2, hstepB = (size_t)HALF * g.ldb * 2;
    const size_t tstepA = 2 * hstepA, tstepB = 2 * hstepB;
    const unsigned ldsw = (unsigned)wid * 1024u;
    const int aoff = lds_byte(wr * 64 + fr, fq * 8), boff = lds_byte(wc * 32 + fr, fq * 8);
#define PG8_SA(b, h) (((b) * 2 + (h)) * HTB)
#define PG8_SB(b, h) ((4 + (b) * 2 + (h)) * HTB)
#define PG8_STAGE(bufoff, gbase, voff) do { _Pragma("unroll") for (int _i = 0; _i < 2; ++_i) \
        __builtin_amdgcn_global_load_lds((const unsigned*)((const char*)(gbase) + (voff)[_i]), (PG8_LAS unsigned*)(lds + (bufoff) + ldsw + _i * 8192), 16, 0, 0); } while (0)
#define PG8_LDA(dst, b, h) do { _Pragma("unroll") for (int m = 0; m < 4; ++m) _Pragma("unroll") for (int k = 0; k < 2; ++k) dst[m][k] = *(const PG8_LAS bf16x8*)(lds + PG8_SA(b, h) + aoff + m * 2048 + k * 1024); } while (0)
#define PG8_LDB(dst, b, h) do { _Pragma("unroll") for (int n = 0; n < 2; ++n) _Pragma("unroll") for (int k = 0; k < 2; ++k) dst[n][k] = *(const PG8_LAS bf16x8*)(lds + PG8_SB(b, h) + boff + n * 2048 + k * 1024); } while (0)
#define PG8_MMA(ai, bj, At, Bt) do { __builtin_amdgcn_s_setprio(1); _Pragma("unroll") for (int m = 0; m < 4; ++m) _Pragma("unroll") for (int n = 0; n < 2; ++n) _Pragma("unroll") for (int k = 0; k < 2; ++k) \
        acc[ai][bj][m][n] = __builtin_amdgcn_mfma_f32_16x16x32_bf16(Bt[n][k], At[m][k], acc[ai][bj][m][n], 0, 0, 0); __builtin_amdgcn_s_setprio(0); } while (0)
#define PG8_WAIT_V(n) asm volatile("s_waitcnt vmcnt(" #n ")" ::: "memory")
#define PG8_WAIT_L(n) asm volatile("s_waitcnt lgkmcnt(" #n ")" ::: "memory")
#define PG8_BAR __builtin_amdgcn_s_barrier()
#define PG8_SCHED __builtin_amdgcn_sched_barrier(0)
    Unit cur, nxt; int ui = 0;
    if (!S.next(0, cur)) return;
    f32x4 acc[2][2][4][2];
#pragma unroll
    for (int a = 0; a < 2; ++a)
#pragma unroll
        for (int b = 0; b < 2; ++b)
#pragma unroll
            for (int m = 0; m < 4; ++m)
#pragma unroll
                for (int n = 0; n < 2; ++n) acc[a][b][m][n] = (f32x4){0.f, 0.f, 0.f, 0.f};
    bf16x8 At[4][2], B0[2][2], B1[2][2];
    const char* cA = (const char*)g.A + (size_t)cur.pm * tstepA + (size_t)cur.k0 * 2; const char* cB = (const char*)g.Bt + (size_t)cur.pn * tstepB + (size_t)cur.k0 * 2; nt = cur.nt;
    S.a_ready(cur);
    if constexpr (SP2) {
        PG8_STAGE(PG8_SB(0, 0), cB, voffB); PG8_STAGE(PG8_SB(0, 1), cB + hstepB, voffB); PG8_STAGE(PG8_SA(0, 0), cA, voffA); PG8_STAGE(PG8_SA(0, 1), cA + hstepA, voffA);
        if (wr == 1) PG8_BAR;
        PG8_WAIT_V(2); PG8_BAR;
        PG8_STAGE(PG8_SB(1, 0), cB + kstep, voffB); PG8_STAGE(PG8_SA(1, 0), cA + kstep, voffA); PG8_STAGE(PG8_SB(1, 1), cB + hstepB + kstep, voffB);
        PG8_WAIT_V(6); PG8_BAR;
    } else {
        PG8_STAGE(PG8_SB(0, 0), cB, voffB); PG8_STAGE(PG8_SA(0, 0), cA, voffA); PG8_STAGE(PG8_SB(0, 1), cB + hstepB, voffB); PG8_STAGE(PG8_SA(0, 1), cA + hstepA, voffA);
        if (wr == 1) PG8_BAR;
        PG8_WAIT_V(4); PG8_BAR;
        PG8_STAGE(PG8_SB(1, 0), cB + kstep, voffB); PG8_STAGE(PG8_SA(1, 0), cA + kstep, voffA); PG8_STAGE(PG8_SB(1, 1), cB + hstepB + kstep, voffB);
        PG8_WAIT_V(6); PG8_BAR;
    }
    for (;;) {
        const bool has_next = S.next(ui + 1, nxt);
        const char* nA = has_next ? (const char*)g.A + (size_t)nxt.pm * tstepA + (size_t)nxt.k0 * 2 : cA; const char* nB = has_next ? (const char*)g.Bt + (size_t)nxt.pn * tstepB + (size_t)nxt.k0 * 2 : cB;
        for (int t = 0; t < nt; t += 2) {
            const bool last = (t == nt - 2);
            const char* a1 = cA + (size_t)(t + 1) * kstep;
            const char* a2 = last ? nA : cA + (size_t)(t + 2) * kstep; const char* b2 = last ? nB : cB + (size_t)(t + 2) * kstep;
            const char* a3 = a2 + kstep; const char* b3 = b2 + kstep;
            if (last && has_next) S.a_ready(nxt);
            if constexpr (SP2) {
            PG8_LDB(B0, 0, 0); PG8_LDB(B1, 0, 1); PG8_SCHED; PG8_LDA(At, 0, 0); PG8_STAGE(PG8_SA(1, 1), a1 + hstepA, voffA);
            PG8_WAIT_V(8); PG8_WAIT_L(0); PG8_BAR; PG8_MMA(0, 0, At, B0); PG8_MMA(0, 1, At, B1); PG8_BAR; PG8_SCHED;
            PG8_LDA(At, 0, 1); PG8_STAGE(PG8_SB(0, 0), b2, voffB); PG8_STAGE(PG8_SB(0, 1), b2 + hstepB, voffB); PG8_STAGE(PG8_SA(0, 0), a2, voffA);
            PG8_WAIT_V(8); PG8_WAIT_L(0); PG8_BAR; PG8_MMA(1, 0, At, B0); PG8_MMA(1, 1, At, B1); PG8_BAR; PG8_SCHED;
            PG8_LDB(B0, 1, 0); PG8_LDB(B1, 1, 1); PG8_SCHED; PG8_LDA(At, 1, 0); PG8_STAGE(PG8_SA(0, 1), a2 + hstepA, voffA);
            PG8_WAIT_V(8); PG8_WAIT_L(0); PG8_BAR; PG8_MMA(0, 0, At, B0); PG8_MMA(0, 1, At, B1); PG8_BAR; PG8_SCHED;
            PG8_LDA(At, 1, 1); PG8_STAGE(PG8_SB(1, 0), b3, voffB); PG8_STAGE(PG8_SB(1, 1), b3 + hstepB, voffB); PG8_STAGE(PG8_SA(1, 0), a3, voffA);
            PG8_WAIT_V(8); PG8_WAIT_L(0); PG8_BAR; PG8_MMA(1, 0, At, B0); PG8_MMA(1, 1, At, B1); PG8_BAR; PG8_SCHED;
            } else {
            PG8_LDB(B0, 0, 0); PG8_SCHED; PG8_LDA(At, 0, 0); PG8_STAGE(PG8_SA(1, 1), a1 + hstepA, voffA);
            PG8_WAIT_L(8); PG8_BAR; PG8_WAIT_L(0); PG8_MMA(0, 0, At, B0); PG8_BAR; PG8_SCHED;
            PG8_LDB(B1, 0, 1); PG8_STAGE(PG8_SB(0, 0), b2, voffB);
            PG8_BAR; PG8_WAIT_L(0); PG8_MMA(0, 1, At, B1); PG8_BAR;
            PG8_LDA(At, 0, 1); PG8_STAGE(PG8_SA(0, 0), a2, voffA);
            PG8_BAR; PG8_WAIT_L(0); PG8_MMA(1, 0, At, B0); PG8_BAR; PG8_SCHED;
            PG8_STAGE(PG8_SB(0, 1), b2 + hstepB, voffB);
            PG8_WAIT_V(6); PG8_BAR; PG8_MMA(1, 1, At, B1); PG8_BAR;
            PG8_LDB(B0, 1, 0); PG8_SCHED; PG8_LDA(At, 1, 0); PG8_STAGE(PG8_SA(0, 1), a2 + hstepA, voffA);
            PG8_WAIT_L(8); PG8_BAR; PG8_WAIT_L(0); PG8_MMA(0, 0, At, B0); PG8_BAR; PG8_SCHED;
            PG8_LDB(B1, 1, 1); PG8_STAGE(PG8_SB(1, 0), b3, voffB);
            PG8_BAR; PG8_WAIT_L(0); PG8_MMA(0, 1, At, B1); PG8_BAR;
            PG8_LDA(At, 1, 1); PG8_STAGE(PG8_SA(1, 0), a3, voffA);
            PG8_BAR; PG8_WAIT_L(0); PG8_MMA(1, 0, At, B0); PG8_BAR; PG8_SCHED;
            PG8_STAGE(PG8_SB(1, 1), b3 + hstepB, voffB);
            PG8_WAIT_V(6); PG8_BAR; PG8_MMA(1, 1, At, B1); PG8_BAR;
            }
        }
        if constexpr (ALIGN_EPI) { if (wr == 0) PG8_BAR; }
        if constexpr (!Epi::AFTER_DRAIN) { E(acc, cur, wr, wc, fr, fq); S.done(cur); }
        if (!has_next) break;
#pragma unroll
        for (int a = 0; a < 2; ++a)
#pragma unroll
            for (int b = 0; b < 2; ++b)
#pragma unroll
                for (int m = 0; m < 4; ++m)
#pragma unroll
                    for (int n = 0; n < 2; ++n) acc[a][b][m][n] = (f32x4){0.f, 0.f, 0.f, 0.f};
        cur = nxt; cA = nA; cB = nB; ++ui; nt = cur.nt;
        if constexpr (ALIGN_EPI) { if (wr == 1) PG8_BAR; }
    }
    PG8_WAIT_V(0);
    if constexpr (!ALIGN_EPI) { if (wr == 0) PG8_BAR; }
    PG8_BAR;
    if constexpr (Epi::AFTER_DRAIN) { E.fused(acc, cur, wr, wc, fr, fq, lds, wid, lane); S.done(cur); }
#undef PG8_SA
#undef PG8_SB
#undef PG8_STAGE
#undef PG8_LDA
#undef PG8_LDB
#undef PG8_MMA
#undef PG8_WAIT_V
#undef PG8_WAIT_L
#undef PG8_BAR
#undef PG8_SCHED
}
}
constexpr int MTOK = 65536, DM = 1024, SEQ = 2048, NB = 32, FF = 2816, NGU = 5632, NIN = 4864, NYS = 1792, NMOD = 9216;
constexpr float EPS = 1e-6f, LOG2E = 1.4426950408889634f;
constexpr float C2A = 0.125f * LOG2E;
constexpr float C2C = 0.10206207261596575f * LOG2E;

namespace pg8 {
__device__ __forceinline__ float fsigmoid(float x) { return __builtin_amdgcn_rcpf(1.0f + __builtin_amdgcn_exp2f(-x * LOG2E)); }
__device__ __forceinline__ void load_rstd(const float* rstdv, int row0, float (&rs)[2][4]) {
#pragma unroll
    for (int ai = 0; ai < 2; ++ai)
#pragma unroll
        for (int m = 0; m < 4; ++m) rs[ai][m] = GL(float, rstdv + row0 + ai * HALF + m * 16);
}
struct EpiGU {
    static constexpr bool PERM = true, AFTER_DRAIN = false;
    bf16_t* H; const float* rowss; const float* shW;
    __device__ __forceinline__ void operator()(const f32x4 (&acc)[2][2][4][2], const Unit& u, int wr, int wc, int fr, int fq) const {
        const int row0 = u.pm * BM + wr * 64 + fr, b = u.pm >> 3;
        const int cg0 = u.pn * BM + wc * 32 + 8 * fq, hc = u.pn * HALF + wc * 32 + 8 * fq;
        f32x4 sg[2], su[2];
#pragma unroll
        for (int n = 0; n < 2; ++n) { sg[n] = GL(f32x4, shW + (size_t)b * NGU + cg0 + 4 * n); su[n] = GL(f32x4, shW + (size_t)b * NGU + cg0 + HALF + 4 * n); }
        float rs[2][4]; load_rstd(rowss, row0, rs);
#pragma unroll
        for (int ai = 0; ai < 2; ++ai)
#pragma unroll
            for (int m = 0; m < 4; ++m) {
                const float r = rs[ai][m]; float h[8];
#pragma unroll
                for (int n = 0; n < 2; ++n) { const f32x4 g = acc[ai][0][m][n] * r + sg[n], up = acc[ai][1][m][n] * r + su[n];
#pragma unroll
                    for (int j = 0; j < 4; ++j) h[4 * n + j] = g[j] * fsigmoid(g[j]) * up[j]; }
                u32x4 w; w.x = cvt_pk_bf16(h[0], h[1]); w.y = cvt_pk_bf16(h[2], h[3]); w.z = cvt_pk_bf16(h[4], h[5]); w.w = cvt_pk_bf16(h[6], h[7]);
                GS(u32x4, H + (size_t)(row0 + ai * HALF + m * 16) * FF + hc) = w;
            }
    }
};
struct EpiRes {
    static constexpr bool PERM = false, AFTER_DRAIN = false;
    const float* base; float* out; const float* gate; bf16_t* AP; const float* gain; const float* sc; float* rowss; PG8_LAS unsigned char* stg; float gscale; int pad;
    __device__ __forceinline__ void operator()(const f32x4 (&acc)[2][2][4][2], const Unit& u, int wr, int wc, int fr, int fq) const {
        typedef unsigned u32x2 __attribute__((ext_vector_type(2)));
        const unsigned row0 = u.pm * BM + wr * 64 + fr, b = u.pm >> 3, col0 = u.pn * BM + wc * 32 + 4 * fq;
        const int lane = fq * 16 + fr, r8 = lane >> 3, c8 = lane & 7;
        PG8_LAS float* st = (PG8_LAS float*)(stg + (wr * 4 + wc) * 2304);
        f32x4 gv[2][2], mu2[2];
#pragma unroll
        for (int bj = 0; bj < 2; ++bj) {
#pragma unroll
            for (int n = 0; n < 2; ++n) gv[bj][n] = GLB(f32x4, gate, (b * NMOD + col0 + bj * HALF + n * 16) * 4u) * gscale;
            const unsigned cb2 = u.pn * BM + bj * HALF + wc * 32 + 4 * c8;
            if (AP) mu2[bj] = GLB(f32x4, gain, cb2 * 4u) * (GLB(f32x4, sc, (b * NMOD + cb2) * 4u) + 1.0f); else mu2[bj] = (f32x4){0.f, 0.f, 0.f, 0.f};
        }
#pragma unroll
        for (int ai = 0; ai < 2; ++ai) {
            f32x4 xb[4][2][2];
#pragma unroll
            for (int m = 0; m < 4; ++m)
#pragma unroll
                for (int bj = 0; bj < 2; ++bj)
#pragma unroll
                    for (int n = 0; n < 2; ++n) xb[m][bj][n] = GLB(f32x4, base, ((row0 + ai * HALF + m * 16) * DM + col0 + bj * HALF + n * 16) * 4u);
#pragma unroll
            for (int m = 0; m < 4; ++m) {
                const unsigned row = row0 + ai * HALF + m * 16, rowb = u.pm * BM + wr * 64 + ai * HALF + m * 16; float ss = 0.f;
#pragma unroll
                for (int bj = 0; bj < 2; ++bj) {
#pragma unroll
                    for (int n = 0; n < 2; ++n) { const f32x4 x = xb[m][bj][n] + gv[bj][n] * acc[ai][bj][m][n];
                        ss += (x[0] * x[0] + x[1] * x[1]) + (x[2] * x[2] + x[3] * x[3]);
                        *(PG8_LAS f32x4*)(st + fr * 36 + n * 16 + fq * 4) = x; }
                    asm volatile("s_waitcnt lgkmcnt(0)" ::: "memory");
#pragma unroll
                    for (int h = 0; h < 2; ++h) { const f32x4 v = *(const PG8_LAS f32x4*)(st + (h * 8 + r8) * 36 + c8 * 4);
                        const unsigned off = (rowb + h * 8 + r8) * DM + u.pn * BM + bj * HALF + wc * 32 + 4 * c8;
                        GSB(f32x4, out, off * 4u) = v;
                        if (AP) { const f32x4 y = v * mu2[bj]; u32x2 w; w.x = cvt_pk_bf16(y[0], y[1]); w.y = cvt_pk_bf16(y[2], y[3]); GSB(u32x2, AP, off * 2u) = w; } }
                    asm volatile("s_waitcnt lgkmcnt(0)" ::: "memory");
                }
                ss += __shfl_xor(ss, 16); ss += __shfl_xor(ss, 32);
                if (fq == 0) GSB(float, rowss, (row * 16 + u.pn * 4 + wc) * 4u) = ss;
            }
        }
    }
};
struct EpiIn {
    static constexpr bool PERM = true, AFTER_DRAIN = false;
    bf16_t* YS; bf16_t* YG; const float* rowss; const float* shW; PG8_LAS unsigned char* stg;
    __device__ __forceinline__ void operator()(const f32x4 (&acc)[2][2][4][2], const Unit& u, int wr, int wc, int fr, int fq) const {
        const int row0 = u.pm * BM + wr * 64 + fr, b = u.pm >> 3;
        const int lane = fq * 16 + fr, r8 = lane >> 3, c8 = lane & 7;
        PG8_LAS unsigned char* st = stg + (wr * 4 + wc) * 2304;
        float rs[2][4]; load_rstd(rowss, row0, rs);
        const bool gates = u.pn >= 7;
        f32x4 sh[2][2]; float scale[2];
#pragma unroll
        for (int bj = 0; bj < 2; ++bj) { const int cg = u.pn * BM + 64 * wc + 32 * bj;
            scale[bj] = (!gates && cg >= 640 && cg < 1024) ? C2A : 1.0f;
#pragma unroll
            for (int n = 0; n < 2; ++n) sh[bj][n] = GL(f32x4, shW + (size_t)b * NIN + cg + 8 * fq + 4 * n); }
        bf16_t* dst; unsigned ld;
        if (gates) { dst = YG + (size_t)((u.pn - 7) >> 2) * ((size_t)MTOK * DM) + ((u.pn - 7) & 3) * BM + 64 * wc + 8 * c8; ld = DM; }
        else { dst = YS + u.pn * BM + 64 * wc + 8 * c8; ld = NYS; }
        const unsigned rowa = u.pm * BM + wr * 64;
        if (gates) body<true>(acc, rs, sh, scale, st, dst, ld, rowa, fr, fq, r8, c8); else body<false>(acc, rs, sh, scale, st, dst, ld, rowa, fr, fq, r8, c8);
    }
    template <bool GATES> __device__ __forceinline__ void body(const f32x4 (&acc)[2][2][4][2], const float (&rs)[2][4], const f32x4 (&sh)[2][2], const float (&scale)[2], PG8_LAS unsigned char* st,
                                                                bf16_t* dst, unsigned ld, unsigned rowa, int fr, int fq, int r8, int c8) const {
#pragma unroll
        for (int ai = 0; ai < 2; ++ai)
#pragma unroll
            for (int m = 0; m < 4; ++m) {
                const float r = rs[ai][m];
#pragma unroll
                for (int bj = 0; bj < 2; ++bj) { float h[8];
#pragma unroll
                    for (int n = 0; n < 2; ++n) { const f32x4 v = acc[ai][bj][m][n] * r + sh[bj][n];
#pragma unroll
                        for (int j = 0; j < 4; ++j) h[4 * n + j] = GATES ? fsigmoid(v[j]) : v[j] * scale[bj]; }
                    u32x4 w; w.x = cvt_pk_bf16(h[0], h[1]); w.y = cvt_pk_bf16(h[2], h[3]); w.z = cvt_pk_bf16(h[4], h[5]); w.w = cvt_pk_bf16(h[6], h[7]);
                    *(PG8_LAS u32x4*)(st + fr * 144 + bj * 64 + fq * 16) = w; }
                asm volatile("s_waitcnt lgkmcnt(0)" ::: "memory");
#pragma unroll
                for (int h2 = 0; h2 < 2; ++h2) { const u32x4 w = *(const PG8_LAS u32x4*)(st + (h2 * 8 + r8) * 144 + c8 * 16);
                    GS(u32x4, dst + (size_t)(rowa + ai * HALF + m * 16 + h2 * 8 + r8) * ld) = w; }
                asm volatile("s_waitcnt lgkmcnt(0)" ::: "memory");
            }
    }
};
struct EpiQup {
    static constexpr bool PERM = false, AFTER_DRAIN = false;
    bf16_t* QC; const float* cs; const float* sn;
    __device__ __forceinline__ void operator()(const f32x4 (&acc)[2][2][4][2], const Unit& u, int wr, int wc, int fr, int fq) const {
        typedef unsigned u32x2 __attribute__((ext_vector_type(2)));
        const int row0 = u.pm * BM + wr * 64 + fr;
#pragma unroll
        for (int bj = 0; bj < 2; ++bj) {
            const int cb = u.pn * BM + bj * HALF + wc * 32;
            if (cb >= 384) continue;
            const bool rope = (cb % 96) == 64;
#pragma unroll
            for (int ai = 0; ai < 2; ++ai)
#pragma unroll
                for (int m = 0; m < 4; ++m) {
                    const int row = row0 + ai * HALF + m * 16, t = row & (SEQ - 1);
                    f32x4 x0 = acc[ai][bj][m][0], x1 = acc[ai][bj][m][1];
                    if (rope) { const f32x4 c = GL(f32x4, cs + t * 16 + 4 * fq), s = GL(f32x4, sn + t * 16 + 4 * fq);
                        const f32x4 y0 = x0 * c - x1 * s, y1 = x0 * s + x1 * c; x0 = y0; x1 = y1; }
                    x0 = x0 * C2C; x1 = x1 * C2C;
                    u32x2 w0, w1; w0.x = cvt_pk_bf16(x0[0], x0[1]); w0.y = cvt_pk_bf16(x0[2], x0[3]); w1.x = cvt_pk_bf16(x1[0], x1[1]); w1.y = cvt_pk_bf16(x1[2], x1[3]);
                    bf16_t* d = QC + (size_t)row * 384 + cb + 4 * fq;
                    *(u32x2*)d = w0; GS(u32x2, d + 16) = w1;
                }
        }
    }
};
struct EpiPlain {
    static constexpr bool PERM = true, AFTER_DRAIN = false;
    bf16_t* O; int ldc;
    __device__ __forceinline__ void operator()(const f32x4 (&acc)[2][2][4][2], const Unit& u, int wr, int wc, int fr, int fq) const {
        const int row0 = u.pm * BM + wr * 64 + fr, col0 = u.pn * BM + wc * 32 + 8 * fq;
#pragma unroll
        for (int ai = 0; ai < 2; ++ai)
#pragma unroll
            for (int m = 0; m < 4; ++m)
#pragma unroll
                for (int bj = 0; bj < 2; ++bj) { const f32x4 v0 = acc[ai][bj][m][0], v1 = acc[ai][bj][m][1];
                    u32x4 w; w.x = cvt_pk_bf16(v0[0], v0[1]); w.y = cvt_pk_bf16(v0[2], v0[3]); w.z = cvt_pk_bf16(v1[0], v1[1]); w.w = cvt_pk_bf16(v1[2], v1[3]);
                    GS(u32x4, O + (size_t)(row0 + ai * HALF + m * 16) * ldc + col0 + bj * HALF) = w; asm volatile("" ::: "memory"); }
    }
};
struct EpiBr {
    static constexpr bool PERM = true, AFTER_DRAIN = false;
    bf16_t* YG; float* MG;
    __device__ __forceinline__ void operator()(const f32x4 (&acc)[2][2][4][2], const Unit& u, int wr, int wc, int fr, int fq) const {
        const unsigned row0 = u.pm * BM + wr * 64 + fr, col0 = u.pn * BM + wc * 32 + 8 * fq;
        const bf16_t* G = YG + (size_t)u.br * ((size_t)MTOK * DM);
#pragma unroll
        for (int ai = 0; ai < 2; ++ai) {
            u32x4 gw[4][2], mw[4][2];
#pragma unroll
            for (int m = 0; m < 4; ++m)
#pragma unroll
                for (int bj = 0; bj < 2; ++bj) { const unsigned off = ((row0 + ai * HALF + m * 16) * DM + col0 + bj * HALF) * 2u;
                    gw[m][bj] = GLB(u32x4, G, off); mw[m][bj] = (u.br > 0) ? GLB(u32x4, YG, off) : (u32x4){0u, 0u, 0u, 0u}; }
#pragma unroll
            for (int m = 0; m < 4; ++m)
#pragma unroll
                for (int bj = 0; bj < 2; ++bj) { const unsigned off = ((row0 + ai * HALF + m * 16) * DM + col0 + bj * HALF) * 2u;
                    const u32x4 g = gw[m][bj], r = mw[m][bj]; f32x4 g0, g1, r0, r1;
                    g0[0] = __uint_as_float(g.x << 16); g0[1] = __uint_as_float(g.x & 0xffff0000u); g0[2] = __uint_as_float(g.y << 16); g0[3] = __uint_as_float(g.y & 0xffff0000u);
                    g1[0] = __uint_as_float(g.z << 16); g1[1] = __uint_as_float(g.z & 0xffff0000u); g1[2] = __uint_as_float(g.w << 16); g1[3] = __uint_as_float(g.w & 0xffff0000u);
                    r0[0] = __uint_as_float(r.x << 16); r0[1] = __uint_as_float(r.x & 0xffff0000u); r0[2] = __uint_as_float(r.y << 16); r0[3] = __uint_as_float(r.y & 0xffff0000u);
                    r1[0] = __uint_as_float(r.z << 16); r1[1] = __uint_as_float(r.z & 0xffff0000u); r1[2] = __uint_as_float(r.w << 16); r1[3] = __uint_as_float(r.w & 0xffff0000u);
                    const f32x4 v0 = acc[ai][bj][m][0] * g0 + r0, v1 = acc[ai][bj][m][1] * g1 + r1;
                    u32x4 w; w.x = cvt_pk_bf16(v0[0], v0[1]); w.y = cvt_pk_bf16(v0[2], v0[3]); w.z = cvt_pk_bf16(v1[0], v1[1]); w.w = cvt_pk_bf16(v1[2], v1[3]); GSB(u32x4, YG, off) = w; }
        }
    }
};
}
namespace att {
using bf16 = unsigned short;
using bf16x8 = __attribute__((ext_vector_type(8))) short;
using s16x4 = __attribute__((ext_vector_type(4))) short;
using f32x16 = __attribute__((ext_vector_type(16))) float;
using u32x4 = __attribute__((ext_vector_type(4))) unsigned;
constexpr int LDS_K = 0, KSLOT_MAX = 12288, LDS_V = 2 * KSLOT_MAX, LDS_WS = LDS_V + 2 * 8192, LDS_BIAS = LDS_WS + 2048, LDS_OST = LDS_BIAS + 2048, LDS_BYTES = LDS_OST + 8 * 4096;
__device__ __forceinline__ int crow(int r, int hi) { return (r & 3) + 8 * (r >> 2) + 4 * hi; }
__device__ __forceinline__ void glds16(const void* gsrc, unsigned lds_dst) { unsigned keep;
    asm volatile("s_mov_b32 %0, m0\n\ts_mov_b32 m0, %2\n\ts_nop 0\n\tglobal_load_lds_dwordx4 %1, off\n\ts_mov_b32 m0, %0" : "=&s"(keep) : "v"(gsrc), "s"(lds_dst) : "memory"); }
typedef float f32x2_t __attribute__((ext_vector_type(2))); typedef __bf16 bf16x2_t __attribute__((ext_vector_type(2)));
__device__ __forceinline__ unsigned cvtpk_s(float lo, float hi) { f32x2_t v = {lo, hi}; bf16x2_t b = __builtin_convertvector(v, bf16x2_t); return __builtin_bit_cast(unsigned, b); }
typedef __attribute__((address_space(3))) char* ATT_LAS_T;
__device__ __forceinline__ float max3f(float a, float b, float c) { float r; asm("v_max3_f32 %0, %1, %2, %3" : "=v"(r) : "v"(a), "v"(b), "v"(c)); return r; }
__device__ __forceinline__ float max2f(float a, float b) { float r; asm("v_max_f32_e32 %0, %1, %2" : "=v"(r) : "v"(a), "v"(b)); return r; }
struct Desc { const bf16* Q; int ldq; const bf16* K0; int ldk0; const bf16* K1; int ldk1; const bf16* V; int ldv; bf16* O; int ldo; };

__device__ __forceinline__ void pv(f32x16* o, int vb, bf16x8 pa0, bf16x8 pa1, bf16x8 pa2, bf16x8 pa3) {
#pragma unroll
    for (int d0 = 0; d0 < 2; ++d0) { s16x4 lo[4], hi[4];
#pragma unroll
        for (int ks = 0; ks < 4; ++ks) {
            asm volatile("ds_read_b64_tr_b16 %0,%1 offset:%c2" : "=&v"(lo[ks]) : "v"(vb), "i"(d0 * 4096 + ks * 1024) : "memory");
            asm volatile("ds_read_b64_tr_b16 %0,%1 offset:%c2" : "=&v"(hi[ks]) : "v"(vb), "i"(d0 * 4096 + ks * 1024 + 512) : "memory"); }
        asm volatile("s_waitcnt lgkmcnt(0)" ::: "memory"); __builtin_amdgcn_sched_barrier(0);
#define ATT_PK(k) (bf16x8){lo[k][0], lo[k][1], lo[k][2], lo[k][3], hi[k][0], hi[k][1], hi[k][2], hi[k][3]}
        o[d0] = __builtin_amdgcn_mfma_f32_32x32x16_bf16(pa0, ATT_PK(0), o[d0], 0, 0, 0);
        o[d0] = __builtin_amdgcn_mfma_f32_32x32x16_bf16(pa1, ATT_PK(1), o[d0], 0, 0, 0);
        o[d0] = __builtin_amdgcn_mfma_f32_32x32x16_bf16(pa2, ATT_PK(2), o[d0], 0, 0, 0);
        o[d0] = __builtin_amdgcn_mfma_f32_32x32x16_bf16(pa3, ATT_PK(3), o[d0], 0, 0, 0);
#undef ATT_PK
    }
}
#define ATT_LAS __attribute__((address_space(3)))
template <int DQK, int MODE> __device__ __forceinline__ void unit(const Desc& d, int q0, ATT_LAS char* shm, const float* biasg, float sinkl2) {
    constexpr int NCH = DQK / 8, KSLOT = DQK * 128, ND0 = DQK / 16; constexpr float THR = 8.0f, NEGBIG = -1e30f;
    const int tid = lautid(), lane = tid & 63, r32 = lane & 31, hi = lane >> 5; const int wid = __builtin_amdgcn_readfirstlane(tid >> 6);
    const unsigned lds0 = (unsigned)(uintptr_t)shm;
    ATT_LAS float* wsf = (ATT_LAS float*)(shm + LDS_WS) + wid * 64;
    ATT_LAS float* bias_l = (ATT_LAS float*)(shm + LDS_BIAS);
    const int qw = q0 + wid * 32;
    int t0 = 0, t1 = 32, wt0 = 0, wt1 = 32;
    if (MODE == 1) { t0 = q0 >= 128 ? (q0 - 128) >> 6 : 0; t1 = ((q0 + 383) >> 6) + 1; if (t1 > 32) t1 = 32;
                     wt0 = qw >= 128 ? (qw - 128) >> 6 : 0; wt1 = ((qw + 159) >> 6) + 1; if (wt1 > 32) wt1 = 32; }
#define ATT_DMA(t, bsel) do { \
        _Pragma("unroll") for (int c_ = 0; c_ < 2; ++c_) { const int ch_ = wid + 8 * c_; if (ch_ < NCH) { \
            const bf16* s_ = (ch_ < 8) ? d.K0 + (size_t)((t) * 64 + lane) * d.ldk0 + ch_ * 8 : d.K1 + (size_t)((t) * 64 + lane) * d.ldk1 + (ch_ - 8) * 8; \
            glds16(s_, (unsigned)__builtin_amdgcn_readfirstlane(lds0 + LDS_K + (bsel) * KSLOT + ch_ * 1024)); } } \
        { const bf16* v_ = d.V + (size_t)((t) * 64 + 16 * (wid & 3) + (lane >> 2)) * d.ldv + (wid >> 2) * 32 + (lane & 3) * 8; \
          glds16(v_, (unsigned)__builtin_amdgcn_readfirstlane(lds0 + LDS_V + (bsel) * 8192 + wid * 1024)); } } while (0)
    if (MODE == 1) { const int idx = tid - 128; bias_l[tid] = (idx >= 0 && idx <= 256) ? biasg[idx] : NEGBIG; }
    ATT_DMA(t0, 0);
    bf16x8 qr[ND0];
    { const bf16* Qw = d.Q + (size_t)(qw + r32) * d.ldq + hi * 8;
#pragma unroll
      for (int d0 = 0; d0 < ND0; ++d0) qr[d0] = GL(bf16x8, Qw + d0 * 16); }
    float mhat = 0.f, l_reg = 0.f; f32x16 o[2]; o[0] = f32x16{}; o[1] = f32x16{}; f32x16 negm = f32x16{};
    constexpr bool MSUM = true;
    f32x16 lacc = f32x16{}; const bf16x8 ones8 = (bf16x8){0x3f80, 0x3f80, 0x3f80, 0x3f80, 0x3f80, 0x3f80, 0x3f80, 0x3f80};
    const int vb0 = (int)(lds0 + LDS_V) + ((lane >> 4) & 1) * 32 + (lane & 3) * 8 + (4 * hi + ((lane & 15) >> 2)) * 64;
    int buf = 0;
    for (int t = t0; t < t1; ++t) {
        asm volatile("s_waitcnt vmcnt(0) lgkmcnt(0)\n\ts_barrier" ::: "memory");
        if (t + 1 < t1) ATT_DMA(t + 1, buf ^ 1);
        const bool active = (MODE == 0) || (t >= wt0 && t < wt1);
        if (active) {
            f32x16 p0, p1;
            { const ATT_LAS char* kb = shm + LDS_K + buf * KSLOT + hi * 1024 + r32 * 16;
#pragma unroll
              for (int d0 = 0; d0 < ND0; ++d0) {
                  const bf16x8 b0 = *(const ATT_LAS bf16x8*)(kb + d0 * 2048);
                  const bf16x8 b1 = *(const ATT_LAS bf16x8*)(kb + d0 * 2048 + 512);
                  if (d0 == 0) { p0 = __builtin_amdgcn_mfma_f32_32x32x16_bf16(b0, qr[0], negm, 0, 0, 0); p1 = __builtin_amdgcn_mfma_f32_32x32x16_bf16(b1, qr[0], negm, 0, 0, 0); }
                  else { p0 = __builtin_amdgcn_mfma_f32_32x32x16_bf16(b0, qr[d0], p0, 0, 0, 0); p1 = __builtin_amdgcn_mfma_f32_32x32x16_bf16(b1, qr[d0], p1, 0, 0, 0); } } }
            if (MODE == 1) {
                const ATT_LAS float* bp = bias_l + (64 * t - (qw + r32) + 256 + 4 * hi);
#pragma unroll
                for (int r = 0; r < 16; ++r) { p0[r] += bp[(r & 3) + 8 * (r >> 2)]; p1[r] += bp[(r & 3) + 8 * (r >> 2) + 32]; }
            }
            asm volatile("s_nop 15\n\ts_nop 7" : "+v"(p0), "+v"(p1));
            float rm, rmb;
            rm = max3f(p0[0], p0[1], p1[0]); rmb = max3f(p0[2], p0[3], p1[1]); rm = max3f(rm, p1[2], p1[3]);
#pragma unroll
            for (int r = 4; r < 16; r += 4) { rm = max3f(rm, p0[r], p0[r + 1]); rmb = max3f(rmb, p0[r + 2], p0[r + 3]); rm = max3f(rm, p1[r], p1[r + 1]); rmb = max3f(rmb, p1[r + 2], p1[r + 3]); }
            rm = max2f(rm, rmb);
            { auto rr = __builtin_amdgcn_permlane32_swap(__float_as_uint(rm), __float_as_uint(rm), false, false); rm = max2f(__uint_as_float(rr[0]), __uint_as_float(rr[1])); }
            const bool first = (t == wt0);
            if (first) {
                mhat = rm;
#pragma unroll
                for (int r = 0; r < 16; ++r) { p0[r] -= rm; p1[r] -= rm; }
#pragma unroll
                for (int r = 0; r < 16; ++r) negm[r] = -mhat;
            } else if (__any(rm > THR)) {
                const float dl = fmaxf(rm, 0.f); mhat += dl;
#pragma unroll
                for (int r = 0; r < 16; ++r) { p0[r] -= dl; p1[r] -= dl; }
#pragma unroll
                for (int r = 0; r < 16; ++r) negm[r] = -mhat;
                const float f = __builtin_amdgcn_exp2f(-dl); l_reg *= f; if (hi == 0) wsf[r32] = f;
                asm volatile("s_waitcnt lgkmcnt(0)" ::: "memory");
#pragma unroll
                for (int d_ = 0; d_ < 2; ++d_)
#pragma unroll
                    for (int r = 0; r < 16; ++r) o[d_][r] *= wsf[crow(r, hi)];
                if (MSUM) {
#pragma unroll
                    for (int r = 0; r < 16; ++r) lacc[r] *= wsf[crow(r, hi)];
                }
                asm volatile("s_waitcnt lgkmcnt(0)" ::: "memory");
            }
            if (MSUM) {
#pragma unroll
                for (int r = 0; r < 16; ++r) { p0[r] = __builtin_amdgcn_exp2f(p0[r]); p1[r] = __builtin_amdgcn_exp2f(p1[r]); }
            } else {
                float sacc = 0.f;
#pragma unroll
                for (int r = 0; r < 16; ++r) { p0[r] = __builtin_amdgcn_exp2f(p0[r]); p1[r] = __builtin_amdgcn_exp2f(p1[r]); sacc += p0[r] + p1[r]; }
                l_reg += sacc;
            }
            u32x4 pw0, pw1, pw2, pw3;
            pw0 = (u32x4){cvtpk_s(p0[0], p0[1]), cvtpk_s(p0[2], p0[3]), cvtpk_s(p0[4], p0[5]), cvtpk_s(p0[6], p0[7])};
            pw1 = (u32x4){cvtpk_s(p0[8], p0[9]), cvtpk_s(p0[10], p0[11]), cvtpk_s(p0[12], p0[13]), cvtpk_s(p0[14], p0[15])};
            pw2 = (u32x4){cvtpk_s(p1[0], p1[1]), cvtpk_s(p1[2], p1[3]), cvtpk_s(p1[4], p1[5]), cvtpk_s(p1[6], p1[7])};
            pw3 = (u32x4){cvtpk_s(p1[8], p1[9]), cvtpk_s(p1[10], p1[11]), cvtpk_s(p1[12], p1[13]), cvtpk_s(p1[14], p1[15])};
            pv(o, vb0 + buf * 8192, __builtin_bit_cast(bf16x8, pw0), __builtin_bit_cast(bf16x8, pw1), __builtin_bit_cast(bf16x8, pw2), __builtin_bit_cast(bf16x8, pw3));
            if (MSUM) {
                lacc = __builtin_amdgcn_mfma_f32_32x32x16_bf16(__builtin_bit_cast(bf16x8, pw0), ones8, lacc, 0, 0, 0);
                lacc = __builtin_amdgcn_mfma_f32_32x32x16_bf16(__builtin_bit_cast(bf16x8, pw1), ones8, lacc, 0, 0, 0);
                lacc = __builtin_amdgcn_mfma_f32_32x32x16_bf16(__builtin_bit_cast(bf16x8, pw2), ones8, lacc, 0, 0, 0);
                lacc = __builtin_amdgcn_mfma_f32_32x32x16_bf16(__builtin_bit_cast(bf16x8, pw3), ones8, lacc, 0, 0, 0);
            }
        }
        buf ^= 1;
    }
    float rli[16];
    if (MSUM) {
        if (MODE == 1) { if (hi == 0) wsf[32 + r32] = __builtin_amdgcn_exp2f(sinkl2 - mhat); asm volatile("s_waitcnt lgkmcnt(0)" ::: "memory"); }
#pragma unroll
        for (int r = 0; r < 16; ++r) rli[r] = __builtin_amdgcn_rcpf(lacc[r] + (MODE == 1 ? wsf[32 + crow(r, hi)] : 0.f));
    } else {
        { auto rr = __builtin_amdgcn_permlane32_swap(__float_as_uint(l_reg), __float_as_uint(l_reg), false, false); l_reg = __uint_as_float(rr[0]) + __uint_as_float(rr[1]); }
        if (MODE == 1) l_reg += __builtin_amdgcn_exp2f(sinkl2 - mhat);
        if (hi == 0) wsf[32 + r32] = l_reg; asm volatile("s_waitcnt lgkmcnt(0)" ::: "memory");
#pragma unroll
        for (int r = 0; r < 16; ++r) rli[r] = __builtin_amdgcn_rcpf(wsf[32 + crow(r, hi)]);
    }
    bf16* Ow = d.O + (size_t)qw * d.ldo;
    { ATT_LAS bf16* stg = (ATT_LAS bf16*)(shm + LDS_OST) + wid * 2048;
#pragma unroll
      for (int r = 0; r < 16; ++r) { const int orow = crow(r, hi);
#pragma unroll
          for (int d0 = 0; d0 < 2; ++d0) { const unsigned w = cvtpk_s(o[d0][r] * rli[r], 0.f); stg[orow * 64 + d0 * 32 + r32] = (bf16)(w & 0xffffu); } }
      asm volatile("s_waitcnt lgkmcnt(0)" ::: "memory");
#pragma unroll
      for (int i = 0; i < 4; ++i) { const int row = i * 8 + (lane >> 3), ch = lane & 7; const u32x4 v = *(const ATT_LAS u32x4*)(stg + row * 64 + ch * 8); GS(u32x4, Ow + (size_t)row * d.ldo + ch * 8) = v; } }
    asm volatile("s_waitcnt lgkmcnt(0)\n\ts_barrier" ::: "memory");
#undef ATT_DMA
}
}
#define GAS __attribute__((address_space(1)))
#define LAS __attribute__((address_space(3)))
typedef unsigned short bf16;
typedef unsigned v4u __attribute__((ext_vector_type(4)));
typedef float f32x4 __attribute__((ext_vector_type(4)));
typedef float f32x16 __attribute__((ext_vector_type(16)));
constexpr int NWAVES = 8;
constexpr int LDS_BYTES = 155648;
constexpr size_t MiB = 1u << 20;
constexpr size_t WS_MODS = 0;
constexpr size_t WS_SHW = 3 * MiB;
constexpr size_t SHW_L = (size_t)32 * (NGU + NIN + NGU) * 4;
constexpr size_t WS_ROWSS = 8 * MiB;
constexpr size_t WS_RSTD = 13 * MiB;
constexpr size_t WS_CS = 12 * MiB, WS_SN = WS_CS + 131072;
constexpr size_t WS_BIAS = WS_SN + 131072;
constexpr size_t WS_CTL = 15 * MiB, CTL_BYTES = 16384;
constexpr size_t WS_W = 16 * MiB, W_LAYER = 48 * MiB;
constexpr size_t W_GU1 = 0, W_DN1 = 11 * MiB, W_GU2 = W_DN1 + 5632 * 1024, W_DN2 = W_GU2 + 11 * MiB, W_IN = 33 * MiB, W_QUP = W_IN + (size_t)NIN * 1024 * 2, W_KVUP = W_QUP + 262144, W_BR = 43 * MiB, W_OUT = 45 * MiB;
constexpr size_t WS_AP = 112 * MiB;
constexpr size_t WS_YS = 240 * MiB;
constexpr size_t WS_QC = 464 * MiB;
constexpr size_t WS_KVC = 512 * MiB;
constexpr size_t WS_YG = 576 * MiB;
constexpr size_t WS_H = 240 * MiB;
constexpr size_t WS_MG = 240 * MiB;
constexpr size_t WS_END = 960 * MiB;
static_assert(W_DN2 + 5632 * 1024 <= W_IN && W_KVUP + 131072 <= W_BR && W_OUT + 2 * MiB <= W_LAYER && WS_W + 2 * W_LAYER <= WS_AP, "weight map");
static_assert(WS_H + (size_t)MTOK * FF * 2 <= WS_YG + 3 * (size_t)MTOK * DM * 2 && WS_MG + (size_t)MTOK * DM * 4 <= WS_KVC && WS_SHW + 2 * SHW_L <= WS_ROWSS, "ws map");

struct Args { const float* in[25]; float* out; unsigned char* ws; };
__device__ __forceinline__ int lauint(int k) { asm volatile("" : "+s"(k)); return k; }
__device__ __forceinline__ unsigned char* lau(unsigned char* p) { asm volatile("" : "+s"(p)); return p; }

__device__ __forceinline__ unsigned f2bf(float f) { unsigned u = __builtin_bit_cast(unsigned, f); return (u + 0x7fffu + ((u >> 16) & 1u)) >> 16; }
__device__ __forceinline__ unsigned pk2(float lo, float hi) { return f2bf(lo) | (f2bf(hi) << 16); }
__device__ __forceinline__ float bflo(unsigned w) { return __uint_as_float(w << 16); }
__device__ __forceinline__ float bfhi(unsigned w) { return __uint_as_float(w & 0xffff0000u); }
__device__ __forceinline__ float wave_sum(float v) {
#pragma unroll
    for (int o = 1; o < 64; o <<= 1) v += __shfl_xor(v, o);
    return v;
}
__device__ __forceinline__ void tr_item(const float* W, int N, int k0, int n0, bf16* WT, int ldk, int drow0, int dk0, const float* kscale, LAS float* scr, int lane) {
#pragma unroll
    for (int i = 0; i < 32; ++i) { const int kk = 2 * i + (lane >> 5); float v = W[(size_t)(k0 + kk) * N + n0 + (lane & 31)]; if (kscale) v *= kscale[k0 + kk]; scr[kk * 33 + (lane & 31)] = v; }
    asm volatile("s_waitcnt lgkmcnt(0)" ::: "memory");
    const int c = lane & 7;
#pragma unroll
    for (int j = 0; j < 4; ++j) { const int n = (lane >> 3) + 8 * j; const LAS float* s = scr + (8 * c) * 33 + n;
        v4u o; o.x = pk2(s[0 * 33], s[1 * 33]); o.y = pk2(s[2 * 33], s[3 * 33]); o.z = pk2(s[4 * 33], s[5 * 33]); o.w = pk2(s[6 * 33], s[7 * 33]);
        GS(v4u, WT + (size_t)(drow0 + n) * ldk + dk0 + k0 + 8 * c) = o; }
    asm volatile("s_waitcnt lgkmcnt(0)" ::: "memory");
}
__device__ __forceinline__ void tr_matrix(const float* W, int K, int N, bf16* WT, int ldk, int dk0, int remap, const float* kscale, LAS float* scr, int lane, int gw, int NGW) {
    const int nblk = N / 32, items = (K / 64) * nblk;
    for (int it = gw; it < items; it += NGW) {
        const int kb = it / nblk, nb = it - kb * nblk, n0 = nb * 32;
        int dr = n0;
        if (remap == 1) dr = (n0 < FF) ? (n0 / 128) * 256 + (n0 % 128) : ((n0 - FF) / 128) * 256 + 128 + ((n0 - FF) % 128);
        else if (remap == 2) { dr = (n0 < 1696) ? n0 : n0 + 96; const int c = dr & 255; dr = (dr & ~255) + 128 * ((c & 63) >> 5) + 32 * (c >> 6); }
        tr_item(W, N, kb * 64, n0, WT, ldk, dr, dk0, kscale, scr, lane);
    }
}
__device__ __forceinline__ void sg_item(const float* in, int in_stride, bool do_silu, const float* W, int N, int n0, float* out, int out_stride, int dcol0, const float* bias, int lane) {
    const int i = lane & 31, hi = lane >> 5;
    f32x16 acc = f32x16{};
    const float* ip = in + (size_t)i * in_stride + 4 * hi;
    const float* wp = W + (size_t)(4 * hi) * N + n0 + i;
#pragma unroll 4
    for (int k0 = 0; k0 < 1024; k0 += 8) {
        f32x4 a = GL(f32x4, ip + k0);
        if (do_silu) { a[0] = a[0] / (1.0f + __expf(-a[0])); a[1] = a[1] / (1.0f + __expf(-a[1])); a[2] = a[2] / (1.0f + __expf(-a[2])); a[3] = a[3] / (1.0f + __expf(-a[3])); }
        const float b0 = wp[(size_t)(k0 + 0) * N], b1 = wp[(size_t)(k0 + 1) * N], b2 = wp[(size_t)(k0 + 2) * N], b3 = wp[(size_t)(k0 + 3) * N];
        acc = __builtin_amdgcn_mfma_f32_32x32x2f32(a[0], b0, acc, 0, 0, 0);
        acc = __builtin_amdgcn_mfma_f32_32x32x2f32(a[1], b1, acc, 0, 0, 0);
        acc = __builtin_amdgcn_mfma_f32_32x32x2f32(a[2], b2, acc, 0, 0, 0);
        acc = __builtin_amdgcn_mfma_f32_32x32x2f32(a[3], b3, acc, 0, 0, 0);
    }
    const float bv = bias ? bias[n0 + i] : 0.f;
#pragma unroll
    for (int r = 0; r < 16; ++r) { const int b = (r & 3) + 8 * (r >> 2) + 4 * hi; out[(size_t)b * out_stride + dcol0 + i] = acc[r] + bv; }
}
__device__ __forceinline__ void sincos_d(float af, float& sv, float& cv) {
    const double a = (double)af; const double kq = rint(a * 0.63661977236758134308); const double r = (a - kq * 1.57079632679489655800) - kq * 6.123233995736766e-17;
    const double r2 = r * r;
    const double s = r * (1.0 - r2 * (1.0 / 6.0 - r2 * (1.0 / 120.0 - r2 * (1.0 / 5040.0 - r2 * (1.0 / 362880.0 - r2 * (1.0 / 39916800.0 - r2 * (1.0 / 6227020800.0 - r2 * (1.0 / 1307674368000.0))))))));
    const double c = 1.0 - r2 * (0.5 - r2 * (1.0 / 24.0 - r2 * (1.0 / 720.0 - r2 * (1.0 / 40320.0 - r2 * (1.0 / 3628800.0 - r2 * (1.0 / 479001600.0 - r2 * (1.0 / 87178291200.0 - r2 * (1.0 / 20922789888000.0))))))));
    const int q = ((int)kq) & 3;
    const double ss = (q == 0) ? s : (q == 1) ? c : (q == 2) ? -s : -c;
    const double cc = (q == 0) ? c : (q == 1) ? -s : (q == 2) ? -c : s;
    sv = (float)ss; cv = (float)cc;
}
#define XB_TMO      128
#define XB_XCNT(j)  (256  + 64 * (j))
#define XB_XSUB(j)  (1280 + 64 * (j))
#define XB_XGEN(j)  (2304 + 64 * (j))
#define XB_TOP      3328
#define XB_TOPGEN   3392
#define XCD_BAR_WORDS 3456
#define XB_SPIN_CAP (1u << 18)

__device__ __forceinline__ unsigned xb_ld(unsigned* p)              { return __hip_atomic_load(p, __ATOMIC_RELAXED, __HIP_MEMORY_SCOPE_AGENT); }
__device__ __forceinline__ unsigned xb_add(unsigned* p, unsigned v) { return __hip_atomic_fetch_add(p, v, __ATOMIC_RELAXED, __HIP_MEMORY_SCOPE_AGENT); }
__device__ __forceinline__ unsigned xb_xcc_id() { return (unsigned)__builtin_amdgcn_s_getreg((3 << 11) | 20) & 0xFu; }
#define XB_SPIN(cond, bar) do { unsigned _sp = 0; while (cond) { __builtin_amdgcn_s_sleep(1); \
    if ((++_sp & 255u) == 0u) { if (xb_ld(&(bar)[XB_TMO])) break; if (_sp > XB_SPIN_CAP) { atomicAdd(&(bar)[XB_TMO], 1u); break; } } } } while (0)

struct XcdBarrier {
    unsigned* bar; unsigned x;
    volatile LAS unsigned* st;
};

__device__ __forceinline__ XcdBarrier xcd_barrier_post(unsigned* bar, volatile LAS unsigned* st) {
    XcdBarrier b; b.bar = bar; b.x = (unsigned)__builtin_amdgcn_readfirstlane((int)xb_xcc_id()); b.st = st;
    if (threadIdx.x == 0) (void)xb_add(&bar[XB_XCNT(b.x)], 1u);
    return b;
}
__device__ __forceinline__ void xcd_barrier_complete(unsigned* bar, unsigned x, unsigned& nloc, unsigned& nx) {
    const unsigned G = gridDim.x * gridDim.y * gridDim.z;
    unsigned sum, cnt, mine, sp = 0u;
    for (;;) {
        sum = 0u; cnt = 0u; mine = 0u;
#pragma unroll
        for (unsigned j = 0; j < 16; ++j) { const unsigned c = xb_ld(&bar[XB_XCNT(j)]); sum += c; cnt += (c > 0u) ? 1u : 0u; mine = (j == x) ? c : mine; }
        if (sum == G) break;
        __builtin_amdgcn_s_sleep(1);
        if ((++sp & 255u) == 0u) { if (xb_ld(&bar[XB_TMO])) break; if (sp > XB_SPIN_CAP) { atomicAdd(&bar[XB_TMO], 1u); break; } }
    }
    nloc = mine > 0u ? mine : 1u; nx = cnt > 0u ? cnt : 1u;
}

__device__ __forceinline__ void xcd_barrier(const XcdBarrier& b) {
    asm volatile("s_waitcnt vmcnt(0)" ::: "memory");
    __syncthreads();
    if (threadIdx.x == 0) {
        unsigned* bar = b.bar;
        __builtin_amdgcn_s_waitcnt(0);
        unsigned nloc = b.st[0], nx = b.st[1];
        if (nloc == 0u) { xcd_barrier_complete(bar, b.x, nloc, nx); b.st[0] = nloc; b.st[1] = nx; }
        const unsigned old = xb_add(&bar[XB_XSUB(b.x)], 1u);
        const unsigned gen = old / nloc;
        if (old + 1u == (gen + 1u) * nloc) {
            __builtin_amdgcn_fence(__ATOMIC_RELEASE, "agent");
            asm volatile("s_waitcnt vmcnt(0)" ::: "memory");
            const unsigned og = xb_add(&bar[XB_TOP], 1u);
            const unsigned tg = og / nx;
            if (og + 1u == (tg + 1u) * nx) xb_add(&bar[XB_TOPGEN], 1u);
            else XB_SPIN(xb_ld(&bar[XB_TOPGEN]) == tg, bar);
            __builtin_amdgcn_fence(__ATOMIC_ACQUIRE, "agent");
            xb_add(&bar[XB_XGEN(b.x)], 1u);
            asm volatile("s_waitcnt vmcnt(0)" ::: "memory");
        } else {
            XB_SPIN(xb_ld(&bar[XB_XGEN(b.x)]) == gen, bar);
            __builtin_amdgcn_fence(__ATOMIC_ACQUIRE, "agent");
            asm volatile("s_waitcnt vmcnt(0)" ::: "memory");
        }
    }
    __syncthreads();
}

#ifndef PHMASK
#define PHMASK 0x1FFF
#endif
#define PH_ON(k) (((PHMASK) >> (k)) & 1)
#define INP(k) (args.in[lauint(k)])
__global__ void __launch_bounds__(NWAVES * 64, 2) mega_fwd(Args args) {
    extern __shared__ __attribute__((aligned(16))) unsigned char lds[];
    cg::grid_group grid = cg::this_grid();
    const int G = gridDim.x, bx = blockIdx.x;
    const int vcu = (G % 8 == 0) ? (bx % 8) * (G / 8) + bx / 8 : bx;
    const int NGW = G * NWAVES;
    volatile LAS unsigned* MISC = (volatile LAS unsigned*)((LAS unsigned char*)lds + 131072 + 320);
    if (threadIdx.x < 32) MISC[threadIdx.x] = 0u;
    __syncthreads();
    XcdBarrier xbar = xcd_barrier_post((unsigned*)(args.ws + WS_CTL), MISC + 8);
#define GRID_BAR() do { XcdBarrier bb_ = xbar; bb_.bar = (unsigned*)lau((unsigned char*)bb_.bar); bb_.x = (unsigned)lauint((int)bb_.x); xcd_barrier(bb_); } while (0)
#define PTRS const int tid = lautid(), lane = tid & 63, wave = __builtin_amdgcn_readfirstlane(tid >> 6), gw = vcu * NWAVES + wave; (void)lane; (void)gw; unsigned char* ws = lau(args.ws); float* X = (float*)lau((unsigned char*)args.out); (void)X; \
    float* mods = (float*)(ws + WS_MODS); float* rowss = (float*)(ws + WS_ROWSS); float* rstdv = (float*)(ws + WS_RSTD); (void)rstdv; float* cs = (float*)(ws + WS_CS); float* sn = (float*)(ws + WS_SN); float* biasT = (float*)(ws + WS_BIAS); \
    bf16* AP = (bf16*)(ws + WS_AP); bf16* YS = (bf16*)(ws + WS_YS); bf16* QC = (bf16*)(ws + WS_QC); bf16* KVC = (bf16*)(ws + WS_KVC); bf16* YG = (bf16*)(ws + WS_YG); bf16* HB = (bf16*)(ws + WS_H); float* MG = (float*)(ws + WS_MG); \
    (void)mods; (void)rowss; (void)cs; (void)sn; (void)biasT; (void)AP; (void)YS; (void)QC; (void)KVC; (void)YG; (void)HB; (void)MG; \
    unsigned char* wl = ws + WS_W + (size_t)l * W_LAYER; const float* ml = mods + (size_t)l * NB * NMOD; const float* shw = (const float*)(ws + WS_SHW + (size_t)l * SHW_L); (void)wl; (void)ml; (void)shw;
    LAS unsigned char* ldsl = (LAS unsigned char*)lds;

    if (PH_ON(0)) {
        const int l = 0; PTRS
        for (int it = wave * G + vcu; it < 2 * (NMOD / 32); it += NGW) { const int l = it / (NMOD / 32), n0 = (it % (NMOD / 32)) * 32;
            sg_item(INP(1), DM, true, INP(2) + (size_t)l * DM * NMOD, NMOD, n0, mods + (size_t)l * NB * NMOD, NMOD, n0, INP(3) + (size_t)l * NMOD, lane); }
        for (int e = bx * 512 + tid; e < 2048 * 16; e += G * 512) { const int p = e >> 4, i = e & 15; const float inv = powf(10000.0f, -(float)(2 * i) / 32.0f); const float ang = (float)p * inv; float s, c; sincos_d(ang, s, c); cs[e] = c; sn[e] = s; }
        for (int e = bx * 512 + tid; e < 6 * 257; e += G * 512) { const int h = e / 257, idx = e % 257, rel = idx - 128, n = rel < 0 ? -rel : rel;
            int bk = rel > 0 ? 16 : 0; if (n < 8) bk += n; else { int lg = 31 - __clz(n * n); int large = 2 + lg; if (large > 15) large = 15; bk += large; }
            biasT[h * 260 + idx] = INP(12)[bk * 6 + h] * LOG2E; }
        LAS float* scr = (LAS float*)(ldsl + wave * 16384);
#pragma unroll 1
        for (int l2 = 0; l2 < 2; ++l2) { const int l = l2;
            unsigned char* wl = ws + WS_W + (size_t)l * W_LAYER;
            tr_matrix(INP(5) + (size_t)l * DM * NGU, DM, NGU, (bf16*)(wl + W_GU1), DM, 0, 1, nullptr, scr, lane, gw, NGW);
            tr_matrix(INP(6) + (size_t)l * FF * DM, FF, DM, (bf16*)(wl + W_DN1), FF, 0, 0, nullptr, scr, lane, gw, NGW);
            tr_matrix(INP(22) + (size_t)l * DM * NGU, DM, NGU, (bf16*)(wl + W_GU2), DM, 0, 1, nullptr, scr, lane, gw, NGW);
            tr_matrix(INP(23) + (size_t)l * FF * DM, FF, DM, (bf16*)(wl + W_DN2), FF, 0, 0, nullptr, scr, lane, gw, NGW);
            tr_matrix(INP(8) + (size_t)l * DM * 4768, DM, 4768, (bf16*)(wl + W_IN), DM, 0, 2, nullptr, scr, lane, gw, NGW);
            tr_matrix(INP(14) + (size_t)l * 256 * 384, 256, 384, (bf16*)(wl + W_QUP), 256, 0, 0, INP(13) + l * 256, scr, lane, gw, NGW);
            tr_matrix(INP(16) + (size_t)l * 128 * 512, 128, 512, (bf16*)(wl + W_KVUP), 128, 0, 0, INP(15) + l * 128, scr, lane, gw, NGW);
            tr_matrix(INP(17) + (size_t)l * 384 * DM, 384, DM, (bf16*)(wl + W_BR), DM, 0, 0, nullptr, scr, lane, gw, NGW);
            tr_matrix(INP(18) + (size_t)l * 384 * DM, 384, DM, (bf16*)(wl + W_BR), DM, 384, 0, nullptr, scr, lane, gw, NGW);
            tr_matrix(INP(19) + (size_t)l * 256 * DM, 256, DM, (bf16*)(wl + W_BR), DM, 768, 0, nullptr, scr, lane, gw, NGW);
            tr_matrix(INP(20) + (size_t)l * DM * DM, DM, DM, (bf16*)(wl + W_OUT), DM, 0, 0, nullptr, scr, lane, gw, NGW);
            for (int e = bx * 512 + tid; e < 96 * 1024 / 8; e += G * 512) { const int rr = e >> 7, r2 = rr < 32 ? 1536 + 96 + rr : 1536 + 192 + (rr - 32); ((v4u*)(wl + W_IN + (size_t)r2 * 1024 * 2))[e & 127] = (v4u){0u, 0u, 0u, 0u}; }
            for (int e = bx * 512 + tid; e < 128 * 256 / 8; e += G * 512) ((v4u*)(wl + W_QUP + (size_t)384 * 256 * 2))[e] = (v4u){0u, 0u, 0u, 0u};
        }
    }
    grid.sync();
    if (PH_ON(1)) {
        const int l = 0; PTRS
#pragma unroll 1
        for (int l2 = 0; l2 < 2; ++l2) { const int l = l2;
            float* shw = (float*)(ws + WS_SHW + (size_t)l * SHW_L); const float* ml = mods + (size_t)l * NB * NMOD;
            for (int it = wave * G + vcu; it < (NGU + 4768 + NGU) / 32; it += NGW) {
                int n0 = it * 32;
                if (n0 < NGU) { const int dr = (n0 < FF) ? (n0 / 128) * 256 + (n0 % 128) : ((n0 - FF) / 128) * 256 + 128 + ((n0 - FF) % 128);
                    sg_item(ml + 0 * DM, NMOD, false, INP(5) + (size_t)l * DM * NGU, NGU, n0, shw, NGU, dr, nullptr, lane); continue; }
                n0 -= NGU;
                if (n0 < 4768) { const int dr = (n0 < 1696) ? n0 : n0 + 96;
                    sg_item(ml + 3 * DM, NMOD, false, INP(8) + (size_t)l * DM * 4768, 4768, n0, shw + 32 * NGU, NIN, dr, nullptr, lane); continue; }
                n0 -= 4768;
                { const int dr = (n0 < FF) ? (n0 / 128) * 256 + (n0 % 128) : ((n0 - FF) / 128) * 256 + 128 + ((n0 - FF) % 128);
                    sg_item(ml + 6 * DM, NMOD, false, INP(22) + (size_t)l * DM * NGU, NGU, n0, shw + 32 * NGU + 32 * NIN, NGU, dr, nullptr, lane); }
            }
        }
        const float* gain = INP(4);
#pragma unroll 2
        for (int m = gw; m < MTOK; m += NGW) {
            const int b = m >> 11; const f32x4* xr = (const f32x4*)(INP(0) + (size_t)m * DM) + lane; const float* scp = mods + (size_t)b * NMOD + 1 * DM;
            f32x4 v[4]; float s = 0.f;
#pragma unroll
            for (int j = 0; j < 4; ++j) { v[j] = xr[64 * j]; s += (v[j][0] * v[j][0] + v[j][1] * v[j][1]) + (v[j][2] * v[j][2] + v[j][3] * v[j][3]); }
            s = wave_sum(s);
            if (lane < 16) rowss[(size_t)m * 16 + lane] = lane == 0 ? s : 0.f;
            unsigned long long* o8 = (unsigned long long*)(AP + (size_t)m * DM) + lane;
#pragma unroll
            for (int j = 0; j < 4; ++j) { const int col = 4 * lane + 256 * j; const f32x4 g = GL(f32x4, gain + col), sc = GL(f32x4, scp + col); const f32x4 y = v[j] * g * (sc + 1.0f);
                o8[64 * j] = (unsigned long long)pk2(y[0], y[1]) | ((unsigned long long)pk2(y[2], y[3]) << 32); }
        }
    }
    GRID_BAR();

#pragma unroll 1
    for (int ph = 0; ph < 26; ++ph) {
        const int l = ph >= 13 ? 1 : 0, k = ph - 13 * l, f = k >= 10 ? 1 : 0;
        if ((k == 0 || k == 3 || k == 10) && PH_ON(12)) { PTRS  for (int row = bx * 512 + tid; row < MTOK; row += G * 512) { const f32x4 a = GL(f32x4, rowss + (size_t)row * 16), b = GL(f32x4, rowss + (size_t)row * 16 + 4), c = GL(f32x4, rowss + (size_t)row * 16 + 8), d = GL(f32x4, rowss + (size_t)row * 16 + 12); const float sq = ((a[0] + a[1]) + (a[2] + a[3])) + ((b[0] + b[1]) + (b[2] + b[3])) + ((c[0] + c[1]) + (c[2] + c[3])) + ((d[0] + d[1]) + (d[2] + d[3])); rstdv[row] = 1.0f / sqrtf(sq * (1.0f / 1024.0f) + EPS); } }
        {
            {
                if (k == 4 && PH_ON(2)) { PTRS   pg8::Gemm g{AP, (const bf16*)(wl + W_IN), DM, DM}; pg8::Order S; S.init(MTOK, NIN, G, bx, DM / 64, 0);
                  pg8::EpiIn E{YS, YG, rstdv, shw + 32 * NGU, ldsl + 131072 + 1024};
                  pg8::gemm_phase<pg8::EpiIn, pg8::Order, true, true>(ldsl, g, S, E); }
                if (k == 5 && PH_ON(3)) { PTRS
                    const float* gq = INP(9) + l * 64; const float* gk = INP(10) + l * 64;
#pragma unroll 2
                    for (int m = gw; m < MTOK; m += NGW) {
                        const int t = m & (SEQ - 1), rp = t >> 6, cp = t & 63;
                        bf16* yr = YS + (size_t)m * NYS;
                        const v4u w1 = GL(v4u, yr + lane * 8), w2 = GL(v4u, yr + 1280 + lane * 8);
                        { float v[8] = {bflo(w1.x), bfhi(w1.x), bflo(w1.y), bfhi(w1.y), bflo(w1.z), bfhi(w1.z), bflo(w1.w), bfhi(w1.w)};
                          const int hh = lane >> 3, j = lane & 7;
                          float ss = 0.f;
#pragma unroll
                          for (int e = 0; e < 8; ++e) ss += v[e] * v[e];
                          ss += __shfl_xor(ss, 1); ss += __shfl_xor(ss, 2); ss += __shfl_xor(ss, 4);
                          const float rstd = 1.0f / sqrtf(ss * (1.0f / 64.0f) + EPS);
                          const float* gp = (hh < 6 ? gq : gk) + j * 8;
                          const int pos = (j < 4) ? rp : cp; const float* cp_ = cs + pos * 16 + (j & 1) * 8; const float* sp_ = sn + pos * 16 + (j & 1) * 8;
                          const float osc = hh < 6 ? C2A : 1.0f; float o[8];
#pragma unroll
                          for (int e = 0; e < 8; ++e) { const float a = v[e] * rstd * gp[e]; const float pa = __shfl_xor(a, 2); const float c = cp_[e], s = sp_[e];
                              o[e] = ((j & 2) == 0 ? a * c - pa * s : pa * s + a * c) * osc; }
                          v4u ow; ow.x = pk2(o[0], o[1]); ow.y = pk2(o[2], o[3]); ow.z = pk2(o[4], o[5]); ow.w = pk2(o[6], o[7]);
                          GS(v4u, yr + lane * 8) = ow; }
                        { float v[8] = {bflo(w2.x), bfhi(w2.x), bflo(w2.y), bfhi(w2.y), bflo(w2.z), bfhi(w2.z), bflo(w2.w), bfhi(w2.w)};
                          float ss = 0.f;
#pragma unroll
                          for (int e = 0; e < 8; ++e) ss += v[e] * v[e];
                          ss += __shfl_xor(ss, 1); ss += __shfl_xor(ss, 2); ss += __shfl_xor(ss, 4); ss += __shfl_xor(ss, 8);
                          const float s32 = ss + __shfl_xor(ss, 16);
                          const float rstd = lane < 32 ? 1.0f / sqrtf(s32 * (1.0f / 256.0f) + EPS) : 1.0f / sqrtf(ss * (1.0f / 128.0f) + EPS);
                          const int j = lane & 3; const float* cp_ = cs + t * 16 + (j & 1) * 8; const float* sp_ = sn + t * 16 + (j & 1) * 8;
                          float o[8];
#pragma unroll
                          for (int e = 0; e < 8; ++e) { const float pa = __shfl_xor(v[e], 2); const float c = cp_[e], s = sp_[e];
                              o[e] = lane < 48 ? v[e] * rstd : ((j & 2) == 0 ? v[e] * c - pa * s : pa * s + v[e] * c); }
                          v4u ow; ow.x = pk2(o[0], o[1]); ow.y = pk2(o[2], o[3]); ow.z = pk2(o[4], o[5]); ow.w = pk2(o[6], o[7]);
                          if (lane < 52) GS(v4u, yr + 1280 + lane * 8) = ow; }
                    }
                }
                if (k == 6 && PH_ON(4)) { PTRS  pg8::Gemm g{YS + 1280, (const bf16*)(wl + W_QUP), NYS, 256}; pg8::Order S; S.init(MTOK, 512, G, bx, 4, 0);
                  pg8::EpiQup E{QC, cs, sn};
                  pg8::gemm_phase<pg8::EpiQup, pg8::Order, true, true>(ldsl, g, S, E); }
                if (k == 6 && PH_ON(5)) { PTRS  pg8::Gemm g{YS + 1536, (const bf16*)(wl + W_KVUP), NYS, 128}; pg8::Order S; S.init(MTOK, 512, G, bx, 2, 0);
                  pg8::EpiPlain E{KVC, 512};
                  pg8::gemm_phase<pg8::EpiPlain, pg8::Order, true, true>(ldsl, g, S, E); }
#ifndef ATT_REP
#define ATT_REP 1
#endif
                for (int rep = 0; rep < ATT_REP; ++rep) if (k == 7 && PH_ON(6)) { PTRS
                    const int b = vcu >> 3, jj = vcu & 7; const size_t r0 = (size_t)b * SEQ;
#pragma unroll 1
                    for (int i = 0; i < 6; ++i) { const int e = (jj & 3) * 6 + i, h = (jj >> 2) * 3 + (e >> 3), qb = e & 7, kvh = jj >> 2;
                        att::Desc d{YS + r0 * NYS + h * 64, NYS, YS + r0 * NYS + 384 + kvh * 64, NYS, nullptr, 0, YS + r0 * NYS + 512 + kvh * 64, NYS, AP + r0 * DM + h * 64, DM};
                        att::unit<64, 0>(d, qb * 256, (att::ATT_LAS_T)lds, nullptr, 0.f); }
#pragma unroll 1
                    for (int i = 0; i < 4; ++i) { const int e = jj * 4 + i, h = e >> 3, qb = e & 7;
                        att::Desc d{QC + r0 * 384 + h * 96, 384, KVC + r0 * 512 + h * 128, 512, YS + r0 * NYS + 1664, NYS, KVC + r0 * 512 + h * 128 + 64, 512, AP + r0 * DM + 768 + h * 64, DM};
                        att::unit<96, 0>(d, qb * 256, (att::ATT_LAS_T)lds, nullptr, 0.f); }
#pragma unroll 1
                    for (int i = 0; i < 6; ++i) { const int e = (jj & 3) * 6 + i, h = (jj >> 2) * 3 + (e >> 3), qb = e & 7, kvh = jj >> 2;
                        att::Desc d{YS + r0 * NYS + 640 + h * 64, NYS, YS + r0 * NYS + 1024 + kvh * 64, NYS, nullptr, 0, YS + r0 * NYS + 1152 + kvh * 64, NYS, AP + r0 * DM + 384 + h * 64, DM};
                        att::unit<64, 1>(d, qb * 256, (att::ATT_LAS_T)lds, biasT + h * 260, INP(11)[l * 6 + h] * LOG2E); }
                }
                if (k == 8 && PH_ON(7)) { PTRS  pg8::Gemm g{AP, (const bf16*)(wl + W_BR), DM, DM}; pg8::Order S; S.init(MTOK, DM, G, bx, 0, 1);
                  pg8::EpiBr E{YG, MG};
                  pg8::gemm_phase<pg8::EpiBr, pg8::Order, true, true>(ldsl, g, S, E); }
                if (k == 9 && PH_ON(8)) { PTRS  pg8::Gemm g{YG, (const bf16*)(wl + W_OUT), DM, DM}; pg8::Order S; S.init(MTOK, DM, G, bx, DM / 64, 0);
                  pg8::EpiRes E{X, X, ml + 5 * DM, AP, INP(21) + l * DM, ml + 7 * DM, rowss, ldsl + 131072 + 1024, 1.0f, 0};
                  pg8::gemm_phase<pg8::EpiRes, pg8::Order, true, true>(ldsl, g, S, E); }
            }
            if ((k == 1 || k == 11) && PH_ON(9)) { PTRS   pg8::Gemm g{AP, (const bf16*)(wl + (f ? W_GU2 : W_GU1)), DM, DM}; pg8::Order S; S.init(MTOK, NGU, G, bx, DM / 64, 0);
              pg8::EpiGU E{HB, rstdv, shw + (f ? 32 * NGU + 32 * NIN : 0)};
              pg8::gemm_phase<pg8::EpiGU, pg8::Order, true, true>(ldsl, g, S, E); }
            if ((k == 2 || k == 12) && PH_ON(10)) { PTRS  pg8::Gemm g{HB, (const bf16*)(wl + (f ? W_DN2 : W_DN1)), FF, FF}; pg8::Order S; S.init(MTOK, DM, G, bx, FF / 64, 0);
              const float* base = (l == 0 && f == 0) ? INP(0) : X;
              const bool has_next = !(l == 1 && f == 1);
              const float* ngain = f == 0 ? INP(7) + l * DM : INP(4) + (l + 1) * DM;
              const float* nsc = f == 0 ? ml + 4 * DM : ml + (size_t)NB * NMOD + 1 * DM;
              pg8::EpiRes E{base, X, ml + (f ? 8 : 2) * DM, has_next ? AP : nullptr, ngain, nsc, rowss, ldsl + 131072 + 1024, 0.5f, 0};
              pg8::gemm_phase<pg8::EpiRes, pg8::Order, true, true>(ldsl, g, S, E); }
        }
        GRID_BAR();
    }
    if (PH_ON(11)) {
        const int l = 0; PTRS
        const float* gain = INP(24);
        for (int m = gw; m < MTOK; m += 2 * NGW) {
            f32x4* xr0 = (f32x4*)(X + (size_t)m * DM) + lane; f32x4* xr1 = (f32x4*)(X + (size_t)(m + NGW) * DM) + lane; f32x4 v[2][4]; float s0 = 0.f, s1 = 0.f;
#pragma unroll
            for (int j = 0; j < 4; ++j) { v[0][j] = GL(f32x4, xr0 + 64 * j); v[1][j] = GL(f32x4, xr1 + 64 * j); }
#pragma unroll
            for (int j = 0; j < 4; ++j) { s0 += (v[0][j][0] * v[0][j][0] + v[0][j][1] * v[0][j][1]) + (v[0][j][2] * v[0][j][2] + v[0][j][3] * v[0][j][3]); s1 += (v[1][j][0] * v[1][j][0] + v[1][j][1] * v[1][j][1]) + (v[1][j][2] * v[1][j][2] + v[1][j][3] * v[1][j][3]); }
            const float r0 = 1.0f / sqrtf(wave_sum(s0) * (1.0f / 1024.0f) + EPS), r1 = 1.0f / sqrtf(wave_sum(s1) * (1.0f / 1024.0f) + EPS);
#pragma unroll
            for (int j = 0; j < 4; ++j) { const f32x4 g = GL(f32x4, gain + 4 * lane + 256 * j); GS(f32x4, xr0 + 64 * j) = v[0][j] * r0 * g; GS(f32x4, xr1 + 64 * j) = v[1][j] * r1 * g; }
        }
    }
}

extern "C" void kernel_launch(void* const* d_in, const int* in_sizes, int n_in, void* d_out, int out_size, void* d_ws, size_t ws_size, hipStream_t stream) {
    static int grid = 0;
    if (grid == 0) {
        if (n_in != 25 || out_size != MTOK * DM || ws_size < WS_END) { fprintf(stderr, "kernel_launch: unexpected shapes (n_in %d, out %d, ws %zu)\n", n_in, out_size, ws_size); grid = -1; return; }
        int dev = 0, cus = 0, per_cu = 0;
        hipGetDevice(&dev); hipDeviceGetAttribute(&cus, hipDeviceAttributeMultiprocessorCount, dev);
        if (hipFuncSetAttribute((const void*)mega_fwd, hipFuncAttributeMaxDynamicSharedMemorySize, LDS_BYTES) != hipSuccess) { fprintf(stderr, "kernel_launch: hipFuncSetAttribute failed\n"); grid = -1; return; }
        if (hipOccupancyMaxActiveBlocksPerMultiprocessor(&per_cu, (const void*)mega_fwd, NWAVES * 64, LDS_BYTES) != hipSuccess || per_cu < 1) { fprintf(stderr, "kernel_launch: occupancy query failed (%d)\n", per_cu); per_cu = 1; }
        (void)hipGetLastError();
        grid = cus * (per_cu > 1 ? 1 : per_cu);
        fprintf(stderr, "kernel_launch: grid %d (cus %d, per_cu %d)\n", grid, cus, per_cu);
    }
    if (grid < 0) return;
    if (hipMemsetAsync((char*)d_ws + WS_CTL, 0, CTL_BYTES, stream) != hipSuccess) { fprintf(stderr, "kernel_launch: memset failed\n"); return; }
    Args a{};
    for (int i = 0; i < 25; ++i) a.in[i] = (const float*)d_in[i];
    a.out = (float*)d_out; a.ws = (unsigned char*)d_ws;
    void* kargs[] = {&a};
    hipError_t e = hipLaunchCooperativeKernel((const void*)mega_fwd, dim3(grid), dim3(NWAVES * 64), kargs, LDS_BYTES, stream);
    if (e != hipSuccess) fprintf(stderr, "kernel_launch: cooperative launch failed: %s (grid %d)\n", hipGetErrorString(e), grid);
}
```

```cpp
#include <hip/hip_runtime.h>
#include <hip/hip_cooperative_groups.h>
#include <hip/hip_bf16.h>
#include <cstdio>
#include <cstdint>
#include <cmath>
namespace cg = cooperative_groups;
#define GL(T, p) (*(const __attribute__((address_space(1))) T*)(p))
#define GS(T, p) (*(__attribute__((address_space(1))) T*)(p))
#define GLB(T, base, boff) (*(const __attribute__((address_space(1))) T*)((const __attribute__((address_space(1))) char*)(base) + (unsigned)(boff)))
#define GSB(T, base, boff) (*(__attribute__((address_space(1))) T*)((__attribute__((address_space(1))) char*)(base) + (unsigned)(boff)))
__device__ __forceinline__ int lautid() { int t = threadIdx.x; asm volatile("" : "+v"(t)); return t; }
namespace pg8 {
#define PG8_LAS __attribute__((address_space(3)))
typedef unsigned short bf16_t;
typedef short bf16x8 __attribute__((ext_vector_type(8)));
typedef float f32x4 __attribute__((ext_vector_type(4)));
typedef unsigned u32x4 __attribute__((ext_vector_type(4)));
constexpr int BM = 256, BK = 64, HALF = 128, HTB = HALF * BK * 2  , STAGE_BYTES = 8 * HTB, NXCD = 8, WGM = 8;

__host__ __device__ __forceinline__ int lds_byte(int r, int c) { const int st = (r >> 4) * 2 + (c >> 5), rr = r & 15, cc = c & 31, ob = rr * 64 + cc * 2; return st * 1024 + (ob ^ (((ob >> 9) & 1) << 5)); }
__host__ __device__ __forceinline__ void stage_rc(int b, int& R, int& C) { const int st = b / 1024, sb = b % 1024, swz = sb ^ (((sb >> 9) & 1) << 5); R = (st >> 1) * 16 + swz / 64; C = (st & 1) * 32 + (swz % 64) / 2; }
__host__ __device__ __forceinline__ int perm32(int rho) { const int n = rho >> 4, i = rho & 15; return 8 * (i >> 2) + 4 * n + (i & 3); }

struct Unit { int pm, pn, k0, nt, br; };
struct Gemm { const bf16_t* A; const bf16_t* Bt; int lda, ldb; };

struct Order {
    int nM, nN, nwg, G, c, nt, mode;
    __device__ __forceinline__ void init(int M, int N, int G_, int c_, int nt_, int mode_) { nM = M / BM; nN = N / BM; nwg = nM * nN; G = G_; c = c_; nt = nt_; mode = mode_; asm volatile("" : "+s"(nt)); }
    __device__ __forceinline__ bool next(int i, Unit& u) const {
        const int ii = mode ? i / 3 : i;
        const int L = ii * G + c; if (L >= nwg) return false;
        int wgid = L; { const int q = nwg / NXCD, r = nwg % NXCD, xcd = wgid % NXCD, off = wgid / NXCD; wgid = (xcd < r ? xcd * (q + 1) : r * (q + 1) + (xcd - r) * q) + off; }
        const int nig = WGM * nN, gid = wgid / nig, fm = gid * WGM, gsz = (nM - fm) < WGM ? (nM - fm) : WGM;
        u.pm = fm + ((wgid % nig) % gsz); u.pn = (wgid % nig) / gsz;
        if (mode) { const int br = i - ii * 3; u.br = br; u.k0 = br * 384; u.nt = (br == 2) ? 4 : 6; } else { u.br = 0; u.k0 = 0; u.nt = nt; }
        return true;
    }
    __device__ __forceinline__ void a_ready(const Unit&) const {}
    __device__ __forceinline__ void done(const Unit&) const {}
};
typedef float f32x2_cv __attribute__((ext_vector_type(2))); typedef __bf16 bf16x2_cv __attribute__((ext_vector_type(2)));
__device__ __forceinline__ unsigned cvt_pk_bf16(float lo, float hi) { f32x2_cv v = {lo, hi}; bf16x2_cv b = __builtin_convertvector(v, bf16x2_cv); return __builtin_bit_cast(unsigned, b); }
template <class Epi, class Sched, bool ALIGN_EPI = false, bool SP2 = false>
__device__ __forceinline__ void gemm_phase(PG8_LAS unsigned char* lds, const Gemm g, const Sched& S, const Epi& E) {
    const int tid = lautid(), wid = __builtin_amdgcn_readfirstlane(tid >> 6), lane = tid & 63, wr = wid >> 2, wc = wid & 3, fr = lane & 15, fq = lane >> 4;
    int nt;
    unsigned voffA[2], voffB[2];
#pragma unroll
    for (int i = 0; i < 2; ++i) { int R, C; stage_rc(tid * 16 + i * 8192, R, C); const int Rb = Epi::PERM ? ((R & ~31) + perm32(R & 31)) : R;
        voffA[i] = (unsigned)(R * g.lda + C) * 2u; voffB[i] = (unsigned)(Rb * g.ldb + C) * 2u; }
    const size_t kstep = (size_t)(BK * 2);
    const size_t hstepA = (size_t)HALF * g.lda * 2, hstepB = (size_t)HALF * g.ldb * 2;
    const size_t tstepA = 2 * hstepA, tstepB = 2 * hstepB;
    const unsigned ldsw = (unsigned)wid * 1024u;
    const int aoff = lds_byte(wr * 64 + fr, fq * 8), boff = lds_byte(wc * 32 + fr, fq * 8);
#define PG8_SA(b, h) (((b) * 2 + (h)) * HTB)
#define PG8_SB(b, h) ((4 + (b) * 2 + (h)) * HTB)
#define PG8_STAGE(bufoff, gbase, voff) do { _Pragma("unroll") for (int _i = 0; _i < 2; ++_i) \
        __builtin_amdgcn_global_load_lds((const unsigned*)((const char*)(gbase) + (voff)[_i]), (PG8_LAS unsigned*)(lds + (bufoff) + ldsw + _i * 8192), 16, 0, 0); } while (0)
#define PG8_LDA(dst, b, h) do { _Pragma("unroll") for (int m = 0; m < 4; ++m) _Pragma("unroll") for (int k = 0; k < 2; ++k) dst[m][k] = *(const PG8_LAS bf16x8*)(lds + PG8_SA(b, h) + aoff + m * 2048 + k * 1024); } while (0)
#define PG8_LDB(dst, b, h) do { _Pragma("unroll") for (int n = 0; n < 2; ++n) _Pragma("unroll") for (int k = 0; k < 2; ++k) dst[n][k] = *(const PG8_LAS bf16x8*)(lds + PG8_SB(b, h) + boff + n * 2048 + k * 1024); } while (0)
#define PG8_MMA(ai, bj, At, Bt) do { __builtin_amdgcn_s_setprio(1); _Pragma("unroll") for (int m = 0; m < 4; ++m) _Pragma("unroll") for (int n = 0; n < 2; ++n) _Pragma("unroll") for (int k = 0; k < 2; ++k) \
        acc[ai][bj][m][n] = __builtin_amdgcn_mfma_f32_16x16x32_bf16(Bt[n][k], At[m][k], acc[ai][bj][m][n], 0, 0, 0); __builtin_amdgcn_s_setprio(0); } while (0)
#define PG8_WAIT_V(n) asm volatile("s_waitcnt vmcnt(" #n ")" ::: "memory")
#define PG8_WAIT_L(n) asm volatile("s_waitcnt lgkmcnt(" #n ")" ::: "memory")
#define PG8_BAR __builtin_amdgcn_s_barrier()
#define PG8_SCHED __builtin_amdgcn_sched_barrier(0)
    Unit cur, nxt; int ui = 0;
    if (!S.next(0, cur)) return;
    f32x4 acc[2][2][4][2];
#pragma unroll
    for (int a = 0; a < 2; ++a)
#pragma unroll
        for (int b = 0; b < 2; ++b)
#pragma unroll
            for (int m = 0; m < 4; ++m)
#pragma unroll
                for (int n = 0; n < 2; ++n) acc[a][b][m][n] = (f32x4){0.f, 0.f, 0.f, 0.f};
    bf16x8 At[4][2], B0[2][2], B1[2][2];
    const char* cA = (const char*)g.A + (size_t)cur.pm * tstepA + (size_t)cur.k0 * 2; const char* cB = (const char*)g.Bt + (size_t)cur.pn * tstepB + (size_t)cur.k0 * 2; nt = cur.nt;
    S.a_ready(cur);
    if constexpr (SP2) {
        PG8_STAGE(PG8_SB(0, 0), cB, voffB); PG8_STAGE(PG8_SB(0, 1), cB + hstepB, voffB); PG8_STAGE(PG8_SA(0, 0), cA, voffA); PG8_STAGE(PG8_SA(0, 1), cA + hstepA, voffA);
        if (wr == 1) PG8_BAR;
        PG8_WAIT_V(2); PG8_BAR;
        PG8_STAGE(PG8_SB(1, 0), cB + kstep, voffB); PG8_STAGE(PG8_SA(1, 0), cA + kstep, voffA); PG8_STAGE(PG8_SB(1, 1), cB + hstepB + kstep, voffB);
        PG8_WAIT_V(6); PG8_BAR;
    } else {
        PG8_STAGE(PG8_SB(0, 0), cB, voffB); PG8_STAGE(PG8_SA(0, 0), cA, voffA); PG8_STAGE(PG8_SB(0, 1), cB + hstepB, voffB); PG8_STAGE(PG8_SA(0, 1), cA + hstepA, voffA);
        if (wr == 1) PG8_BAR;
        PG8_WAIT_V(4); PG8_BAR;
        PG8_STAGE(PG8_SB(1, 0), cB + kstep, voffB); PG8_STAGE(PG8_SA(1, 0), cA + kstep, voffA); PG8_STAGE(PG8_SB(1, 1), cB + hstepB + kstep, voffB);
        PG8_WAIT_V(6); PG8_BAR;
    }
    for (;;) {
        const bool has_next = S.next(ui + 1, nxt);
        const char* nA = has_next ? (const char*)g.A + (size_t)nxt.pm * tstepA + (size_t)nxt.k0 * 2 : cA; const char* nB = has_next ? (const char*)g.Bt + (size_t)nxt.pn * tstepB + (size_t)nxt.k0 * 2 : cB;
        for (int t = 0; t < nt; t += 2) {
            const bool last = (t == nt - 2);
            const char* a1 = cA + (size_t)(t + 1) * kstep;
            const char* a2 = last ? nA : cA + (size_t)(t + 2) * kstep; const char* b2 = last ? nB : cB + (size_t)(t + 2) * kstep;
            const char* a3 = a2 + kstep; const char* b3 = b2 + kstep;
            if (last && has_next) S.a_ready(nxt);
            if constexpr (SP2) {
            PG8_LDB(B0, 0, 0); PG8_LDB(B1, 0, 1); PG8_SCHED; PG8_LDA(At, 0, 0); PG8_STAGE(PG8_SA(1, 1), a1 + hstepA, voffA);
            PG8_WAIT_V(8); PG8_WAIT_L(0); PG8_BAR; PG8_MMA(0, 0, At, B0); PG8_MMA(0, 1, At, B1); PG8_BAR; PG8_SCHED;
            PG8_LDA(At, 0, 1); PG8_STAGE(PG8_SB(0, 0), b2, voffB); PG8_STAGE(PG8_SB(0, 1), b2 + hstepB, voffB); PG8_STAGE(PG8_SA(0, 0), a2, voffA);
            PG8_WAIT_V(8); PG8_WAIT_L(0); PG8_BAR; PG8_MMA(1, 0, At, B0); PG8_MMA(1, 1, At, B1); PG8_BAR; PG8_SCHED;
            PG8_LDB(B0, 1, 0); PG8_LDB(B1, 1, 1); PG8_SCHED; PG8_LDA(At, 1, 0); PG8_STAGE(PG8_SA(0, 1), a2 + hstepA, voffA);
            PG8_WAIT_V(8); PG8_WAIT_L(0); PG8_BAR; PG8_MMA(0, 0, At, B0); PG8_MMA(0, 1, At, B1); PG8_BAR; PG8_SCHED;
            PG8_LDA(At, 1, 1); PG8_STAGE(PG8_SB(1, 0), b3, voffB); PG8_STAGE(PG8_SB(1, 1), b3 + hstepB, voffB); PG8_STAGE(PG8_SA(1, 0), a3, voffA);
            PG8_WAIT_V(8); PG8_WAIT_L(0); PG8_BAR; PG8_MMA(1, 0, At, B0); PG8_MMA(1, 1, At, B1); PG8_BAR; PG8_SCHED;
            } else {
            PG8_LDB(B0, 0, 0); PG8_SCHED; PG8_LDA(At, 0, 0); PG8_STAGE(PG8_SA(1, 1), a1 + hstepA, voffA);
            PG8_WAIT_L(8); PG8_BAR; PG8_WAIT_L(0); PG8_MMA(0, 0, At, B0); PG8_BAR; PG8_SCHED;
            PG8_LDB(B1, 0, 1); PG8_STAGE(PG8_SB(0, 0), b2, voffB);
            PG8_BAR; PG8_WAIT_L(0); PG8_MMA(0, 1, At, B1); PG8_BAR;
            PG8_LDA(At, 0, 1); PG8_STAGE(PG8_SA(0, 0), a2, voffA);
            PG8_BAR; PG8_WAIT_L(0); PG8_MMA(1, 0, At, B0); PG8_BAR; PG8_SCHED;
            PG8_STAGE(PG8_SB(0, 1), b2 + hstepB, voffB);
            PG8_WAIT_V(6); PG8_BAR; PG8_MMA(1, 1, At, B1); PG8_BAR;
            PG8_LDB(B0, 1, 0); PG8_SCHED; PG8_LDA(At, 1, 0); PG8_STAGE(PG8_SA(0, 1), a2 + hstepA, voffA);
            PG8_WAIT_L(8); PG8_BAR; PG8_WAIT_L(0); PG8_MMA(0, 0, At, B0); PG8_BAR; PG8_SCHED;
            PG8_LDB(B1, 1, 1); PG8_STAGE(PG8_SB(1, 0), b3, voffB);
            PG8_BAR; PG8_WAIT_L(0); PG8_MMA(0, 1, At, B1); PG8_BAR;
            PG8_LDA(At, 1, 1); PG8_STAGE(PG8_SA(1, 0), a3, voffA);
            PG8_BAR; PG8_WAIT_L(0); PG8_MMA(1, 0, At, B0); PG8_BAR; PG8_SCHED;
            PG8_STAGE(PG8_SB(1, 1), b3 + hstepB, voffB);
            PG8_WAIT_V(6); PG8_BAR; PG8_MMA(1, 1, At, B1); PG8_BAR;
            }
        }
        if constexpr (ALIGN_EPI) { if (wr == 0) PG8_BAR; }
        if constexpr (!Epi::AFTER_DRAIN) { E(acc, cur, wr, wc, fr, fq); S.done(cur); }
        if (!has_next) break;
#pragma unroll
        for (int a = 0; a < 2; ++a)
#pragma unroll
            for (int b = 0; b < 2; ++b)
#pragma unroll
                for (int m = 0; m < 4; ++m)
#pragma unroll
                    for (int n = 0; n < 2; ++n) acc[a][b][m][n] = (f32x4){0.f, 0.f, 0.f, 0.f};
        cur = nxt; cA = nA; cB = nB; ++ui; nt = cur.nt;
        if constexpr (ALIGN_EPI) { if (wr == 1) PG8_BAR; }
    }
    PG8_WAIT_V(0);
    if constexpr (!ALIGN_EPI) { if (wr == 0) PG8_BAR; }
    PG8_BAR;
    if constexpr (Epi::AFTER_DRAIN) { E.fused(acc, cur, wr, wc, fr, fq, lds, wid, lane); S.done(cur); }
#undef PG8_SA
#undef PG8_SB
#undef PG8_STAGE
#undef PG8_LDA
#undef PG8_LDB
#undef PG8_MMA
#undef PG8_WAIT_V
#undef PG8_WAIT_L
#undef PG8_BAR
#undef PG8_SCHED
}
}
constexpr int MTOK = 65536, DM = 1024, SEQ = 2048, NB = 32, FF = 2816, NGU = 5632, NIN = 4864, NYS = 1792, NMOD = 9216;
constexpr float EPS = 1e-6f, LOG2E = 1.4426950408889634f;
constexpr float C2A = 0.125f * LOG2E;
constexpr float C2C = 0.10206207261596575f * LOG2E;

namespace pg8 {
__device__ __forceinline__ float fsigmoid(float x) { return __builtin_amdgcn_rcpf(1.0f + __builtin_amdgcn_exp2f(-x * LOG2E)); }
__device__ __forceinline__ void load_rstd(const float* rstdv, int row0, float (&rs)[2][4]) {
#pragma unroll
    for (int ai = 0; ai < 2; ++ai)
#pragma unroll
        for (int m = 0; m < 4; ++m) rs[ai][m] = GL(float, rstdv + row0 + ai * HALF + m * 16);
}
struct EpiGU {
    static constexpr bool PERM = true, AFTER_DRAIN = false;
    bf16_t* H; const float* rowss; const float* shW;
    __device__ __forceinline__ void operator()(const f32x4 (&acc)[2][2][4][2], const Unit& u, int wr, int wc, int fr, int fq) const {
        const int row0 = u.pm * BM + wr * 64 + fr, b = u.pm >> 3;
        const int cg0 = u.pn * BM + wc * 32 + 8 * fq, hc = u.pn * HALF + wc * 32 + 8 * fq;
        f32x4 sg[2], su[2];
#pragma unroll
        for (int n = 0; n < 2; ++n) { sg[n] = GL(f32x4, shW + (size_t)b * NGU + cg0 + 4 * n); su[n] = GL(f32x4, shW + (size_t)b * NGU + cg0 + HALF + 4 * n); }
        float rs[2][4]; load_rstd(rowss, row0, rs);
#pragma unroll
        for (int ai = 0; ai < 2; ++ai)
#pragma unroll
            for (int m = 0; m < 4; ++m) {
                const float r = rs[ai][m]; float h[8];
#pragma unroll
                for (int n = 0; n < 2; ++n) { const f32x4 g = acc[ai][0][m][n] * r + sg[n], up = acc[ai][1][m][n] * r + su[n];
#pragma unroll
                    for (int j = 0; j < 4; ++j) h[4 * n + j] = g[j] * fsigmoid(g[j]) * up[j]; }
                u32x4 w; w.x = cvt_pk_bf16(h[0], h[1]); w.y = cvt_pk_bf16(h[2], h[3]); w.z = cvt_pk_bf16(h[4], h[5]); w.w = cvt_pk_bf16(h[6], h[7]);
                GS(u32x4, H + (size_t)(row0 + ai * HALF + m * 16) * FF + hc) = w;
            }
    }
};
struct EpiRes {
    static constexpr bool PERM = false, AFTER_DRAIN = false;
    const float* base; float* out; const float* gate; bf16_t* AP; const float* gain; const float* sc; float* rowss; PG8_LAS unsigned char* stg; float gscale; int pad;
    __device__ __forceinline__ void operator()(const f32x4 (&acc)[2][2][4][2], const Unit& u, int wr, int wc, int fr, int fq) const {
        typedef unsigned u32x2 __attribute__((ext_vector_type(2)));
        const unsigned row0 = u.pm * BM + wr * 64 + fr, b = u.pm >> 3, col0 = u.pn * BM + wc * 32 + 4 * fq;
        const int lane = fq * 16 + fr, r8 = lane >> 3, c8 = lane & 7;
        PG8_LAS float* st = (PG8_LAS float*)(stg + (wr * 4 + wc) * 2304);
        f32x4 gv[2][2], mu2[2];
#pragma unroll
        for (int bj = 0; bj < 2; ++bj) {
#pragma unroll
            for (int n = 0; n < 2; ++n) gv[bj][n] = GLB(f32x4, gate, (b * NMOD + col0 + bj * HALF + n * 16) * 4u) * gscale;
            const unsigned cb2 = u.pn * BM + bj * HALF + wc * 32 + 4 * c8;
            if (AP) mu2[bj] = GLB(f32x4, gain, cb2 * 4u) * (GLB(f32x4, sc, (b * NMOD + cb2) * 4u) + 1.0f); else mu2[bj] = (f32x4){0.f, 0.f, 0.f, 0.f};
        }
#pragma unroll
        for (int ai = 0; ai < 2; ++ai) {
            f32x4 xb[4][2][2];
#pragma unroll
            for (int m = 0; m < 4; ++m)
#pragma unroll
                for (int bj = 0; bj < 2; ++bj)
#pragma unroll
                    for (int n = 0; n < 2; ++n) xb[m][bj][n] = GLB(f32x4, base, ((row0 + ai * HALF + m * 16) * DM + col0 + bj * HALF + n * 16) * 4u);
#pragma unroll
            for (int m = 0; m < 4; ++m) {
                const unsigned row = row0 + ai * HALF + m * 16, rowb = u.pm * BM + wr * 64 + ai * HALF + m * 16; float ss = 0.f;
#pragma unroll
                for (int bj = 0; bj < 2; ++bj) {
#pragma unroll
                    for (int n = 0; n < 2; ++n) { const f32x4 x = xb[m][bj][n] + gv[bj][n] * acc[ai][bj][m][n];
                        ss += (x[0] * x[0] + x[1] * x[1]) + (x[2] * x[2] + x[3] * x[3]);
                        *(PG8_LAS f32x4*)(st + fr * 36 + n * 16 + fq * 4) = x; }
                    asm volatile("s_waitcnt lgkmcnt(0)" ::: "memory");
#pragma unroll
                    for (int h = 0; h < 2; ++h) { const f32x4 v = *(const PG8_LAS f32x4*)(st + (h * 8 + r8) * 36 + c8 * 4);
                        const unsigned off = (rowb + h * 8 + r8) * DM + u.pn * BM + bj * HALF + wc * 32 + 4 * c8;
                        GSB(f32x4, out, off * 4u) = v;
                        if (AP) { const f32x4 y = v * mu2[bj]; u32x2 w; w.x = cvt_pk_bf16(y[0], y[1]); w.y = cvt_pk_bf16(y[2], y[3]); GSB(u32x2, AP, off * 2u) = w; } }
                    asm volatile("s_waitcnt lgkmcnt(0)" ::: "memory");
                }
                ss += __shfl_xor(ss, 16); ss += __shfl_xor(ss, 32);
                if (fq == 0) GSB(float, rowss, (row * 16 + u.pn * 4 + wc) * 4u) = ss;
            }
        }
    }
};
struct EpiIn {
    static constexpr bool PERM = true, AFTER_DRAIN = false;
    bf16_t* YS; bf16_t* YG; const float* rowss; const float* shW; PG8_LAS unsigned char* stg;
    __device__ __forceinline__ void operator()(const f32x4 (&acc)[2][2][4][2], const Unit& u, int wr, int wc, int fr, int fq) const {
        const int row0 = u.pm * BM + wr * 64 + fr, b = u.pm >> 3;
        const int lane = fq * 16 + fr, r8 = lane >> 3, c8 = lane & 7;
        PG8_LAS unsigned char* st = stg + (wr * 4 + wc) * 2304;
        float rs[2][4]; load_rstd(rowss, row0, rs);
        const bool gates = u.pn >= 7;
        f32x4 sh[2][2]; float scale[2];
#pragma unroll
        for (int bj = 0; bj < 2; ++bj) { const int cg = u.pn * BM + 64 * wc + 32 * bj;
            scale[bj] = (!gates && cg >= 640 && cg < 1024) ? C2A : 1.0f;
#pragma unroll
            for (int n = 0; n < 2; ++n) sh[bj][n] = GL(f32x4, shW + (size_t)b * NIN + cg + 8 * fq + 4 * n); }
        bf16_t* dst; unsigned ld;
        if (gates) { dst = YG + (size_t)((u.pn - 7) >> 2) * ((size_t)MTOK * DM) + ((u.pn - 7) & 3) * BM + 64 * wc + 8 * c8; ld = DM; }
        else { dst = YS + u.pn * BM + 64 * wc + 8 * c8; ld = NYS; }
        const unsigned rowa = u.pm * BM + wr * 64;
        if (gates) body<true>(acc, rs, sh, scale, st, dst, ld, rowa, fr, fq, r8, c8); else body<false>(acc, rs, sh, scale, st, dst, ld, rowa, fr, fq, r8, c8);
    }
    template <bool GATES> __device__ __forceinline__ void body(const f32x4 (&acc)[2][2][4][2], const float (&rs)[2][4], const f32x4 (&sh)[2][2], const float (&scale)[2], PG8_LAS unsigned char* st,
                                                                bf16_t* dst, unsigned ld, unsigned rowa, int fr, int fq, int r8, int c8) const {
#pragma unroll
        for (int ai = 0; ai < 2; ++ai)
#pragma unroll
            for (int m = 0; m < 4; ++m) {
                const float r = rs[ai][m];
#pragma unroll
                for (int bj = 0; bj < 2; ++bj) { float h[8];
#pragma unroll
                    for (int n = 0; n < 2; ++n) { const f32x4 v = acc[ai][bj][m][n] * r + sh[bj][n];
#pragma unroll
                        for (int j = 0; j < 4; ++j) h[4 * n + j] = GATES ? fsigmoid(v[j]) : v[j] * scale[bj]; }
                    u32x4 w; w.x = cvt_pk_bf16(h[0], h[1]); w.y = cvt_pk_bf16(h[2], h[3]); w.z = cvt_pk_bf16(h[4], h[5]); w.w = cvt_pk_bf16(h[6], h[7]);
                    *(PG8_LAS u32x4*)(st + fr * 144 + bj * 64 + fq * 16) = w; }
                asm volatile("s_waitcnt lgkmcnt(0)" ::: "memory");
#pragma unroll
                for (int h2 = 0; h2 < 2; ++h2) { const u32x4 w = *(const PG8_LAS u32x4*)(st + (h2 * 8 + r8) * 144 + c8 * 16);
                    GS(u32x4, dst + (size_t)(rowa + ai * HALF + m * 16 + h2 * 8 + r8) * ld) = w; }
                asm volatile("s_waitcnt lgkmcnt(0)" ::: "memory");
            }
    }
};
struct EpiQup {
    static constexpr bool PERM = false, AFTER_DRAIN = false;
    bf16_t* QC; const float* cs; const float* sn;
    __device__ __forceinline__ void operator()(const f32x4 (&acc)[2][2][4][2], const Unit& u, int wr, int wc, int fr, int fq) const {
        typedef unsigned u32x2 __attribute__((ext_vector_type(2)));
        const int row0 = u.pm * BM + wr * 64 + fr;
#pragma unroll
        for (int bj = 0; bj < 2; ++bj) {
            const int cb = u.pn * BM + bj * HALF + wc * 32;
            if (cb >= 384) continue;
            const bool rope = (cb % 96) == 64;
#pragma unroll
            for (int ai = 0; ai < 2; ++ai)
#pragma unroll
                for (int m = 0; m < 4; ++m) {
                    const int row = row0 + ai * HALF + m * 16, t = row & (SEQ - 1);
                    f32x4 x0 = acc[ai][bj][m][0], x1 = acc[ai][bj][m][1];
                    if (rope) { const f32x4 c = GL(f32x4, cs + t * 16 + 4 * fq), s = GL(f32x4, sn + t * 16 + 4 * fq);
                        const f32x4 y0 = x0 * c - x1 * s, y1 = x0 * s + x1 * c; x0 = y0; x1 = y1; }
                    x0 = x0 * C2C; x1 = x1 * C2C;
                    u32x2 w0, w1; w0.x = cvt_pk_bf16(x0[0], x0[1]); w0.y = cvt_pk_bf16(x0[2], x0[3]); w1.x = cvt_pk_bf16(x1[0], x1[1]); w1.y = cvt_pk_bf16(x1[2], x1[3]);
                    bf16_t* d = QC + (size_t)row * 384 + cb + 4 * fq;
                    *(u32x2*)d = w0; GS(u32x2, d + 16) = w1;
                }
        }
    }
};
struct EpiPlain {
    static constexpr bool PERM = true, AFTER_DRAIN = false;
    bf16_t* O; int ldc;
    __device__ __forceinline__ void operator()(const f32x4 (&acc)[2][2][4][2], const Unit& u, int wr, int wc, int fr, int fq) const {
        const int row0 = u.pm * BM + wr * 64 + fr, col0 = u.pn * BM + wc * 32 + 8 * fq;
#pragma unroll
        for (int ai = 0; ai < 2; ++ai)
#pragma unroll
            for (int m = 0; m < 4; ++m)
#pragma unroll
                for (int bj = 0; bj < 2; ++bj) { const f32x4 v0 = acc[ai][bj][m][0], v1 = acc[ai][bj][m][1];
                    u32x4 w; w.x = cvt_pk_bf16(v0[0], v0[1]); w.y = cvt_pk_bf16(v0[2], v0[3]); w.z = cvt_pk_bf16(v1[0], v1[1]); w.w = cvt_pk_bf16(v1[2], v1[3]);
                    GS(u32x4, O + (size_t)(row0 + ai * HALF + m * 16) * ldc + col0 + bj * HALF) = w; asm volatile("" ::: "memory"); }
    }
};
struct EpiBr {
    static constexpr bool PERM = true, AFTER_DRAIN = false;
    bf16_t* YG; float* MG;
    __device__ __forceinline__ void operator()(const f32x4 (&acc)[2][2][4][2], const Unit& u, int wr, int wc, int fr, int fq) const {
        const unsigned row0 = u.pm * BM + wr * 64 + fr, col0 = u.pn * BM + wc * 32 + 8 * fq;
        const bf16_t* G = YG + (size_t)u.br * ((size_t)MTOK * DM);
#pragma unroll
        for (int ai = 0; ai < 2; ++ai) {
            u32x4 gw[4][2], mw[4][2];
#pragma unroll
            for (int m = 0; m < 4; ++m)
#pragma unroll
                for (int bj = 0; bj < 2; ++bj) { const unsigned off = ((row0 + ai * HALF + m * 16) * DM + col0 + bj * HALF) * 2u;
                    gw[m][bj] = GLB(u32x4, G, off); mw[m][bj] = (u.br > 0) ? GLB(u32x4, YG, off) : (u32x4){0u, 0u, 0u, 0u}; }
#pragma unroll
            for (int m = 0; m < 4; ++m)
#pragma unroll
                for (int bj = 0; bj < 2; ++bj) { const unsigned off = ((row0 + ai * HALF + m * 16) * DM + col0 + bj * HALF) * 2u;
                    const u32x4 g = gw[m][bj], r = mw[m][bj]; f32x4 g0, g1, r0, r1;
                    g0[0] = __uint_as_float(g.x << 16); g0[1] = __uint_as_float(g.x & 0xffff0000u); g0[2] = __uint_as_float(g.y << 16); g0[3] = __uint_as_float(g.y & 0xffff0000u);
                    g1[0] = __uint_as_float(g.z << 16); g1[1] = __uint_as_float(g.z & 0xffff0000u); g1[2] = __uint_as_float(g.w << 16); g1[3] = __uint_as_float(g.w & 0xffff0000u);
                    r0[0] = __uint_as_float(r.x << 16); r0[1] = __uint_as_float(r.x & 0xffff0000u); r0[2] = __uint_as_float(r.y << 16); r0[3] = __uint_as_float(r.y & 0xffff0000u);
                    r1[0] = __uint_as_float(r.z << 16); r1[1] = __uint_as_float(r.z & 0xffff0000u); r1[2] = __uint_as_float(r.w << 16); r1[3] = __uint_as_float(r.w & 0xffff0000u);
                    const f32x4 v0 = acc[ai][bj][m][0] * g0 + r0, v1 = acc[ai][bj][m][1] * g1 + r1;
                    u32x4 w; w.x = cvt_pk_bf16(v0[0], v0[1]); w.y = cvt_pk_bf16(v0[2], v0[3]); w.z = cvt_pk_bf16(v1[0], v1[1]); w.w = cvt_pk_bf16(v1[2], v1[3]); GSB(u32x4, YG, off) = w; }
        }
    }
};
}
namespace att {
using bf16 = unsigned short;
using bf16x8 = __attribute__((ext_vector_type(8))) short;
using s16x4 = __attribute__((ext_vector_type(4))) short;
using f32x16 = __attribute__((ext_vector_type(16))) float;
using u32x4 = __attribute__((ext_vector_type(4))) unsigned;
constexpr int LDS_K = 0, KSLOT_MAX = 12288, LDS_V = 2 * KSLOT_MAX, LDS_WS = LDS_V + 2 * 8192, LDS_BIAS = LDS_WS + 2048, LDS_OST = LDS_BIAS + 2048, LDS_BYTES = LDS_OST + 8 * 4096;
__device__ __forceinline__ int crow(int r, int hi) { return (r & 3) + 8 * (r >> 2) + 4 * hi; }
__device__ __forceinline__ void glds16(const void* gsrc, unsigned lds_dst) { unsigned keep;
    asm volatile("s_mov_b32 %0, m0\n\ts_mov_b32 m0, %2\n\ts_nop 0\n\tglobal_load_lds_dwordx4 %1, off\n\ts_mov_b32 m0, %0" : "=&s"(keep) : "v"(gsrc), "s"(lds_dst) : "memory"); }
typedef float f32x2_t __attribute__((ext_vector_type(2))); typedef __bf16 bf16x2_t __attribute__((ext_vector_type(2)));
__device__ __forceinline__ unsigned cvtpk_s(float lo, float hi) { f32x2_t v = {lo, hi}; bf16x2_t b = __builtin_convertvector(v, bf16x2_t); return __builtin_bit_cast(unsigned, b); }
typedef __attribute__((address_space(3))) char* ATT_LAS_T;
__device__ __forceinline__ float max3f(float a, float b, float c) { float r; asm("v_max3_f32 %0, %1, %2, %3" : "=v"(r) : "v"(a), "v"(b), "v"(c)); return r; }
__device__ __forceinline__ float max2f(float a, float b) { float r; asm("v_max_f32_e32 %0, %1, %2" : "=v"(r) : "v"(a), "v"(b)); return r; }
struct Desc { const bf16* Q; int ldq; const bf16* K0; int ldk0; const bf16* K1; int ldk1; const bf16* V; int ldv; bf16* O; int ldo; };

__device__ __forceinline__ void pv(f32x16* o, int vb, bf16x8 pa0, bf16x8 pa1, bf16x8 pa2, bf16x8 pa3) {
#pragma unroll
    for (int d0 = 0; d0 < 2; ++d0) { s16x4 lo[4], hi[4];
#pragma unroll
        for (int ks = 0; ks < 4; ++ks) {
            asm volatile("ds_read_b64_tr_b16 %0,%1 offset:%c2" : "=&v"(lo[ks]) : "v"(vb), "i"(d0 * 4096 + ks * 1024) : "memory");
            asm volatile("ds_read_b64_tr_b16 %0,%1 offset:%c2" : "=&v"(hi[ks]) : "v"(vb), "i"(d0 * 4096 + ks * 1024 + 512) : "memory"); }
        asm volatile("s_waitcnt lgkmcnt(0)" ::: "memory"); __builtin_amdgcn_sched_barrier(0);
#define ATT_PK(k) (bf16x8){lo[k][0], lo[k][1], lo[k][2], lo[k][3], hi[k][0], hi[k][1], hi[k][2], hi[k][3]}
        o[d0] = __builtin_amdgcn_mfma_f32_32x32x16_bf16(pa0, ATT_PK(0), o[d0], 0, 0, 0);
        o[d0] = __builtin_amdgcn_mfma_f32_32x32x16_bf16(pa1, ATT_PK(1), o[d0], 0, 0, 0);
        o[d0] = __builtin_amdgcn_mfma_f32_32x32x16_bf16(pa2, ATT_PK(2), o[d0], 0, 0, 0);
        o[d0] = __builtin_amdgcn_mfma_f32_32x32x16_bf16(pa3, ATT_PK(3), o[d0], 0, 0, 0);
#undef ATT_PK
    }
}
#define ATT_LAS __attribute__((address_space(3)))
template <int DQK, int MODE> __device__ __forceinline__ void unit(const Desc& d, int q0, ATT_LAS char* shm, const float* biasg, float sinkl2) {
    constexpr int NCH = DQK / 8, KSLOT = DQK * 128, ND0 = DQK / 16; constexpr float THR = 8.0f, NEGBIG = -1e30f;
    const int tid = lautid(), lane = tid & 63, r32 = lane & 31, hi = lane >> 5; const int wid = __builtin_amdgcn_readfirstlane(tid >> 6);
    const unsigned lds0 = (unsigned)(uintptr_t)shm;
    ATT_LAS float* wsf = (ATT_LAS float*)(shm + LDS_WS) + wid * 64;
    ATT_LAS float* bias_l = (ATT_LAS float*)(shm + LDS_BIAS);
    const int qw = q0 + wid * 32;
    int t0 = 0, t1 = 32, wt0 = 0, wt1 = 32;
    if (MODE == 1) { t0 = q0 >= 128 ? (q0 - 128) >> 6 : 0; t1 = ((q0 + 383) >> 6) + 1; if (t1 > 32) t1 = 32;
                     wt0 = qw >= 128 ? (qw - 128) >> 6 : 0; wt1 = ((qw + 159) >> 6) + 1; if (wt1 > 32) wt1 = 32; }
#define ATT_DMA(t, bsel) do { \
        _Pragma("unroll") for (int c_ = 0; c_ < 2; ++c_) { const int ch_ = wid + 8 * c_; if (ch_ < NCH) { \
            const bf16* s_ = (ch_ < 8) ? d.K0 + (size_t)((t) * 64 + lane) * d.ldk0 + ch_ * 8 : d.K1 + (size_t)((t) * 64 + lane) * d.ldk1 + (ch_ - 8) * 8; \
            glds16(s_, (unsigned)__builtin_amdgcn_readfirstlane(lds0 + LDS_K + (bsel) * KSLOT + ch_ * 1024)); } } \
        { const bf16* v_ = d.V + (size_t)((t) * 64 + 16 * (wid & 3) + (lane >> 2)) * d.ldv + (wid >> 2) * 32 + (lane & 3) * 8; \
          glds16(v_, (unsigned)__builtin_amdgcn_readfirstlane(lds0 + LDS_V + (bsel) * 8192 + wid * 1024)); } } while (0)
    if (MODE == 1) { const int idx = tid - 128; bias_l[tid] = (idx >= 0 && idx <= 256) ? biasg[idx] : NEGBIG; }
    ATT_DMA(t0, 0);
    bf16x8 qr[ND0];
    { const bf16* Qw = d.Q + (size_t)(qw + r32) * d.ldq + hi * 8;
#pragma unroll
      for (int d0 = 0; d0 < ND0; ++d0) qr[d0] = GL(bf16x8, Qw + d0 * 16); }
    float mhat = 0.f, l_reg = 0.f; f32x16 o[2]; o[0] = f32x16{}; o[1] = f32x16{}; f32x16 negm = f32x16{};
    constexpr bool MSUM = true;
    f32x16 lacc = f32x16{}; const bf16x8 ones8 = (bf16x8){0x3f80, 0x3f80, 0x3f80, 0x3f80, 0x3f80, 0x3f80, 0x3f80, 0x3f80};
    const int vb0 = (int)(lds0 + LDS_V) + ((lane >> 4) & 1) * 32 + (lane & 3) * 8 + (4 * hi + ((lane & 15) >> 2)) * 64;
    int buf = 0;
    for (int t = t0; t < t1; ++t) {
        asm volatile("s_waitcnt vmcnt(0) lgkmcnt(0)\n\ts_barrier" ::: "memory");
        if (t + 1 < t1) ATT_DMA(t + 1, buf ^ 1);
        const bool active = (MODE == 0) || (t >= wt0 && t < wt1);
        if (active) {
            f32x16 p0, p1;
            { const ATT_LAS char* kb = shm + LDS_K + buf * KSLOT + hi * 1024 + r32 * 16;
#pragma unroll
              for (int d0 = 0; d0 < ND0; ++d0) {
                  const bf16x8 b0 = *(const ATT_LAS bf16x8*)(kb + d0 * 2048);
                  const bf16x8 b1 = *(const ATT_LAS bf16x8*)(kb + d0 * 2048 + 512);
                  if (d0 == 0) { p0 = __builtin_amdgcn_mfma_f32_32x32x16_bf16(b0, qr[0], negm, 0, 0, 0); p1 = __builtin_amdgcn_mfma_f32_32x32x16_bf16(b1, qr[0], negm, 0, 0, 0); }
                  else { p0 = __builtin_amdgcn_mfma_f32_32x32x16_bf16(b0, qr[d0], p0, 0, 0, 0); p1 = __builtin_amdgcn_mfma_f32_32x32x16_bf16(b1, qr[d0], p1, 0, 0, 0); } } }
            if (MODE == 1) {
                const ATT_LAS float* bp = bias_l + (64 * t - (qw + r32) + 256 + 4 * hi);
#pragma unroll
                for (int r = 0; r < 16; ++r) { p0[r] += bp[(r & 3) + 8 * (r >> 2)]; p1[r] += bp[(r & 3) + 8 * (r >> 2) + 32]; }
            }
            asm volatile("s_nop 15\n\ts_nop 7" : "+v"(p0), "+v"(p1));
            float rm, rmb;
            rm = max3f(p0[0], p0[1], p1[0]); rmb = max3f(p0[2], p0[3], p1[1]); rm = max3f(rm, p1[2], p1[3]);
#pragma unroll
            for (int r = 4; r < 16; r += 4) { rm = max3f(rm, p0[r], p0[r + 1]); rmb = max3f(rmb, p0[r + 2], p0[r + 3]); rm = max3f(rm, p1[r], p1[r + 1]); rmb = max3f(rmb, p1[r + 2], p1[r + 3]); }
            rm = max2f(rm, rmb);
            { auto rr = __builtin_amdgcn_permlane32_swap(__float_as_uint(rm), __float_as_uint(rm), false, false); rm = max2f(__uint_as_float(rr[0]), __uint_as_float(rr[1])); }
            const bool first = (t == wt0);
            if (first) {
                mhat = rm;
#pragma unroll
                for (int r = 0; r < 16; ++r) { p0[r] -= rm; p1[r] -= rm; }
#pragma unroll
                for (int r = 0; r < 16; ++r) negm[r] = -mhat;
            } else if (__any(rm > THR)) {
                const float dl = fmaxf(rm, 0.f); mhat += dl;
#pragma unroll
                for (int r = 0; r < 16; ++r) { p0[r] -= dl; p1[r] -= dl; }
#pragma unroll
                for (int r = 0; r < 16; ++r) negm[r] = -mhat;
                const float f = __builtin_amdgcn_exp2f(-dl); l_reg *= f; if (hi == 0) wsf[r32] = f;
                asm volatile("s_waitcnt lgkmcnt(0)" ::: "memory");
#pragma unroll
                for (int d_ = 0; d_ < 2; ++d_)
#pragma unroll
                    for (int r = 0; r < 16; ++r) o[d_][r] *= wsf[crow(r, hi)];
                if (MSUM) {
#pragma unroll
                    for (int r = 0; r < 16; ++r) lacc[r] *= wsf[crow(r, hi)];
                }
                asm volatile("s_waitcnt lgkmcnt(0)" ::: "memory");
            }
            if (MSUM) {
#pragma unroll
                for (int r = 0; r < 16; ++r) { p0[r] = __builtin_amdgcn_exp2f(p0[r]); p1[r] = __builtin_amdgcn_exp2f(p1[r]); }
            } else {
                float sacc = 0.f;
#pragma unroll
                for (int r = 0; r < 16; ++r) { p0[r] = __builtin_amdgcn_exp2f(p0[r]); p1[r] = __builtin_amdgcn_exp2f(p1[r]); sacc += p0[r] + p1[r]; }
                l_reg += sacc;
            }
            u32x4 pw0, pw1, pw2, pw3;
            pw0 = (u32x4){cvtpk_s(p0[0], p0[1]), cvtpk_s(p0[2], p0[3]), cvtpk_s(p0[4], p0[5]), cvtpk_s(p0[6], p0[7])};
            pw1 = (u32x4){cvtpk_s(p0[8], p0[9]), cvtpk_s(p0[10], p0[11]), cvtpk_s(p0[12], p0[13]), cvtpk_s(p0[14], p0[15])};
            pw2 = (u32x4){cvtpk_s(p1[0], p1[1]), cvtpk_s(p1[2], p1[3]), cvtpk_s(p1[4], p1[5]), cvtpk_s(p1[6], p1[7])};
            pw3 = (u32x4){cvtpk_s(p1[8], p1[9]), cvtpk_s(p1[10], p1[11]), cvtpk_s(p1[12], p1[13]), cvtpk_s(p1[14], p1[15])};
            pv(o, vb0 + buf * 8192, __builtin_bit_cast(bf16x8, pw0), __builtin_bit_cast(bf16x8, pw1), __builtin_bit_cast(bf16x8, pw2), __builtin_bit_cast(bf16x8, pw3));
            if (MSUM) {
                lacc = __builtin_amdgcn_mfma_f32_32x32x16_bf16(__builtin_bit_cast(bf16x8, pw0), ones8, lacc, 0, 0, 0);
                lacc = __builtin_amdgcn_mfma_f32_32x32x16_bf16(__builtin_bit_cast(bf16x8, pw1), ones8, lacc, 0, 0, 0);
                lacc = __builtin_amdgcn_mfma_f32_32x32x16_bf16(__builtin_bit_cast(bf16x8, pw2), ones8, lacc, 0, 0, 0);
                lacc = __builtin_amdgcn_mfma_f32_32x32x16_bf16(__builtin_bit_cast(bf16x8, pw3), ones8, lacc, 0, 0, 0);
            }
        }
        buf ^= 1;
    }
    float rli[16];
    if (MSUM) {
        if (MODE == 1) { if (hi == 0) wsf[32 + r32] = __builtin_amdgcn_exp2f(sinkl2 - mhat); asm volatile("s_waitcnt lgkmcnt(0)" ::: "memory"); }
#pragma unroll
        for (int r = 0; r < 16; ++r) rli[r] = __builtin_amdgcn_rcpf(lacc[r] + (MODE == 1 ? wsf[32 + crow(r, hi)] : 0.f));
    } else {
        { auto rr = __builtin_amdgcn_permlane32_swap(__float_as_uint(l_reg), __float_as_uint(l_reg), false, false); l_reg = __uint_as_float(rr[0]) + __uint_as_float(rr[1]); }
        if (MODE == 1) l_reg += __builtin_amdgcn_exp2f(sinkl2 - mhat);
        if (hi == 0) wsf[32 + r32] = l_reg; asm volatile("s_waitcnt lgkmcnt(0)" ::: "memory");
#pragma unroll
        for (int r = 0; r < 16; ++r) rli[r] = __builtin_amdgcn_rcpf(wsf[32 + crow(r, hi)]);
    }
    bf16* Ow = d.O + (size_t)qw * d.ldo;
    { ATT_LAS bf16* stg = (ATT_LAS bf16*)(shm + LDS_OST) + wid * 2048;
#pragma unroll
      for (int r = 0; r < 16; ++r) { const int orow = crow(r, hi);
#pragma unroll
          for (int d0 = 0; d0 < 2; ++d0) { const unsigned w = cvtpk_s(o[d0][r] * rli[r], 0.f); stg[orow * 64 + d0 * 32 + r32] = (bf16)(w & 0xffffu); } }
      asm volatile("s_waitcnt lgkmcnt(0)" ::: "memory");
#pragma unroll
      for (int i = 0; i < 4; ++i) { const int row = i * 8 + (lane >> 3), ch = lane & 7; const u32x4 v = *(const ATT_LAS u32x4*)(stg + row * 64 + ch * 8); GS(u32x4, Ow + (size_t)row * d.ldo + ch * 8) = v; } }
    asm volatile("s_waitcnt lgkmcnt(0)\n\ts_barrier" ::: "memory");
#undef ATT_DMA
}
}
#define GAS __attribute__((address_space(1)))
#define LAS __attribute__((address_space(3)))
typedef unsigned short bf16;
typedef unsigned v4u __attribute__((ext_vector_type(4)));
typedef float f32x4 __attribute__((ext_vector_type(4)));
typedef float f32x16 __attribute__((ext_vector_type(16)));
constexpr int NWAVES = 8;
constexpr int LDS_BYTES = 155648;
constexpr size_t MiB = 1u << 20;
constexpr size_t WS_MODS = 0;
constexpr size_t WS_SHW = 3 * MiB;
constexpr size_t SHW_L = (size_t)32 * (NGU + NIN + NGU) * 4;
constexpr size_t WS_ROWSS = 8 * MiB;
constexpr size_t WS_RSTD = 13 * MiB;
constexpr size_t WS_CS = 12 * MiB, WS_SN = WS_CS + 131072;
constexpr size_t WS_BIAS = WS_SN + 131072;
constexpr size_t WS_CTL = 15 * MiB, CTL_BYTES = 16384;
constexpr size_t WS_W = 16 * MiB, W_LAYER = 48 * MiB;
constexpr size_t W_GU1 = 0, W_DN1 = 11 * MiB, W_GU2 = W_DN1 + 5632 * 1024, W_DN2 = W_GU2 + 11 * MiB, W_IN = 33 * MiB, W_QUP = W_IN + (size_t)NIN * 1024 * 2, W_KVUP = W_QUP + 262144, W_BR = 43 * MiB, W_OUT = 45 * MiB;
constexpr size_t WS_AP = 112 * MiB;
constexpr size_t WS_YS = 240 * MiB;
constexpr size_t WS_QC = 464 * MiB;
constexpr size_t WS_KVC = 512 * MiB;
constexpr size_t WS_YG = 576 * MiB;
constexpr size_t WS_H = 240 * MiB;
constexpr size_t WS_MG = 240 * MiB;
constexpr size_t WS_END = 960 * MiB;
static_assert(W_DN2 + 5632 * 1024 <= W_IN && W_KVUP + 131072 <= W_BR && W_OUT + 2 * MiB <= W_LAYER && WS_W + 2 * W_LAYER <= WS_AP, "weight map");
static_assert(WS_H + (size_t)MTOK * FF * 2 <= WS_YG + 3 * (size_t)MTOK * DM * 2 && WS_MG + (size_t)MTOK * DM * 4 <= WS_KVC && WS_SHW + 2 * SHW_L <= WS_ROWSS, "ws map");

struct Args { const float* in[25]; float* out; unsigned char* ws; };
__device__ __forceinline__ int lauint(int k) { asm volatile("" : "+s"(k)); return k; }
__device__ __forceinline__ unsigned char* lau(unsigned char* p) { asm volatile("" : "+s"(p)); return p; }

__device__ __forceinline__ unsigned f2bf(float f) { unsigned u = __builtin_bit_cast(unsigned, f); return (u + 0x7fffu + ((u >> 16) & 1u)) >> 16; }
__device__ __forceinline__ unsigned pk2(float lo, float hi) { return f2bf(lo) | (f2bf(hi) << 16); }
__device__ __forceinline__ float bflo(unsigned w) { return __uint_as_float(w << 16); }
__device__ __forceinline__ float bfhi(unsigned w) { return __uint_as_float(w & 0xffff0000u); }
__device__ __forceinline__ float wave_sum(float v) {
#pragma unroll
    for (int o = 1; o < 64; o <<= 1) v += __shfl_xor(v, o);
    return v;
}
__device__ __forceinline__ void tr_item(const float* W, int N, int k0, int n0, bf16* WT, int ldk, int drow0, int dk0, const float* kscale, LAS float* scr, int lane) {
    { const int rr = lane >> 3, c4 = lane & 7;
      f32x4 v[8];
#pragma unroll
      for (int i = 0; i < 8; ++i) v[i] = GL(f32x4, W + (size_t)(k0 + i * 8 + rr) * N + n0 + 4 * c4);
#pragma unroll
      for (int i = 0; i < 8; ++i) { const int kk = i * 8 + rr; f32x4 x = v[i]; if (kscale) x = x * kscale[k0 + kk];
          scr[kk * 33 + 4 * c4 + 0] = x[0]; scr[kk * 33 + 4 * c4 + 1] = x[1]; scr[kk * 33 + 4 * c4 + 2] = x[2]; scr[kk * 33 + 4 * c4 + 3] = x[3]; } }
    asm volatile("s_waitcnt lgkmcnt(0)" ::: "memory");
    const int c = lane & 7;
#pragma unroll
    for (int j = 0; j < 4; ++j) { const int n = (lane >> 3) + 8 * j; const LAS float* s = scr + (8 * c) * 33 + n;
        v4u o; o.x = pk2(s[0 * 33], s[1 * 33]); o.y = pk2(s[2 * 33], s[3 * 33]); o.z = pk2(s[4 * 33], s[5 * 33]); o.w = pk2(s[6 * 33], s[7 * 33]);
        GS(v4u, WT + (size_t)(drow0 + n) * ldk + dk0 + k0 + 8 * c) = o; }
    asm volatile("s_waitcnt lgkmcnt(0)" ::: "memory");
}
__device__ __forceinline__ void tr_matrix(const float* W, int K, int N, bf16* WT, int ldk, int dk0, int remap, const float* kscale, LAS float* scr, int lane, int gw, int NGW) {
    const int nblk = N / 32, items = (K / 64) * nblk;
    for (int it = gw; it < items; it += NGW) {
        const int kb = it / nblk, nb = it - kb * nblk, n0 = nb * 32;
        int dr = n0;
        if (remap == 1) dr = (n0 < FF) ? (n0 / 128) * 256 + (n0 % 128) : ((n0 - FF) / 128) * 256 + 128 + ((n0 - FF) % 128);
        else if (remap == 2) { dr = (n0 < 1696) ? n0 : n0 + 96; const int c = dr & 255; dr = (dr & ~255) + 128 * ((c & 63) >> 5) + 32 * (c >> 6); }
        tr_item(W, N, kb * 64, n0, WT, ldk, dr, dk0, kscale, scr, lane);
    }
}
__device__ __forceinline__ void sg_item(const float* in, int in_stride, bool do_silu, const float* W, int N, int n0, float* out, int out_stride, int dcol0, const float* bias, int lane) {
    const int i = lane & 31, hi = lane >> 5;
    f32x16 acc = f32x16{};
    const float* ip = in + (size_t)i * in_stride + 4 * hi;
    const float* wp = W + (size_t)(4 * hi) * N + n0 + i;
#pragma unroll 4
    for (int k0 = 0; k0 < 1024; k0 += 8) {
        f32x4 a = GL(f32x4, ip + k0);
        if (do_silu) { a[0] = a[0] / (1.0f + __expf(-a[0])); a[1] = a[1] / (1.0f + __expf(-a[1])); a[2] = a[2] / (1.0f + __expf(-a[2])); a[3] = a[3] / (1.0f + __expf(-a[3])); }
        const float b0 = wp[(size_t)(k0 + 0) * N], b1 = wp[(size_t)(k0 + 1) * N], b2 = wp[(size_t)(k0 + 2) * N], b3 = wp[(size_t)(k0 + 3) * N];
        acc = __builtin_amdgcn_mfma_f32_32x32x2f32(a[0], b0, acc, 0, 0, 0);
        acc = __builtin_amdgcn_mfma_f32_32x32x2f32(a[1], b1, acc, 0, 0, 0);
        acc = __builtin_amdgcn_mfma_f32_32x32x2f32(a[2], b2, acc, 0, 0, 0);
        acc = __builtin_amdgcn_mfma_f32_32x32x2f32(a[3], b3, acc, 0, 0, 0);
    }
    const float bv = bias ? bias[n0 + i] : 0.f;
#pragma unroll
    for (int r = 0; r < 16; ++r) { const int b = (r & 3) + 8 * (r >> 2) + 4 * hi; out[(size_t)b * out_stride + dcol0 + i] = acc[r] + bv; }
}
__device__ __forceinline__ void sincos_d(float af, float& sv, float& cv) {
    const double a = (double)af; const double kq = rint(a * 0.63661977236758134308); const double r = (a - kq * 1.57079632679489655800) - kq * 6.123233995736766e-17;
    const double r2 = r * r;
    const double s = r * (1.0 - r2 * (1.0 / 6.0 - r2 * (1.0 / 120.0 - r2 * (1.0 / 5040.0 - r2 * (1.0 / 362880.0 - r2 * (1.0 / 39916800.0 - r2 * (1.0 / 6227020800.0 - r2 * (1.0 / 1307674368000.0))))))));
    const double c = 1.0 - r2 * (0.5 - r2 * (1.0 / 24.0 - r2 * (1.0 / 720.0 - r2 * (1.0 / 40320.0 - r2 * (1.0 / 3628800.0 - r2 * (1.0 / 479001600.0 - r2 * (1.0 / 87178291200.0 - r2 * (1.0 / 20922789888000.0))))))));
    const int q = ((int)kq) & 3;
    const double ss = (q == 0) ? s : (q == 1) ? c : (q == 2) ? -s : -c;
    const double cc = (q == 0) ? c : (q == 1) ? -s : (q == 2) ? -c : s;
    sv = (float)ss; cv = (float)cc;
}
#define XB_TMO      128
#define XB_XCNT(j)  (256  + 64 * (j))
#define XB_XSUB(j)  (1280 + 64 * (j))
#define XB_XGEN(j)  (2304 + 64 * (j))
#define XB_TOP      3328
#define XB_TOPGEN   3392
#define XCD_BAR_WORDS 3456
#define XB_SPIN_CAP (1u << 18)

__device__ __forceinline__ unsigned xb_ld(unsigned* p)              { return __hip_atomic_load(p, __ATOMIC_RELAXED, __HIP_MEMORY_SCOPE_AGENT); }
__device__ __forceinline__ unsigned xb_add(unsigned* p, unsigned v) { return __hip_atomic_fetch_add(p, v, __ATOMIC_RELAXED, __HIP_MEMORY_SCOPE_AGENT); }
__device__ __forceinline__ unsigned xb_xcc_id() { return (unsigned)__builtin_amdgcn_s_getreg((3 << 11) | 20) & 0xFu; }
#define XB_SPIN(cond, bar) do { unsigned _sp = 0; while (cond) { __builtin_amdgcn_s_sleep(1); \
    if ((++_sp & 255u) == 0u) { if (xb_ld(&(bar)[XB_TMO])) break; if (_sp > XB_SPIN_CAP) { atomicAdd(&(bar)[XB_TMO], 1u); break; } } } } while (0)

struct XcdBarrier {
    unsigned* bar; unsigned x;
    volatile LAS unsigned* st;
};

__device__ __forceinline__ XcdBarrier xcd_barrier_post(unsigned* bar, volatile LAS unsigned* st) {
    XcdBarrier b; b.bar = bar; b.x = (unsigned)__builtin_amdgcn_readfirstlane((int)xb_xcc_id()); b.st = st;
    if (threadIdx.x == 0) (void)xb_add(&bar[XB_XCNT(b.x)], 1u);
    return b;
}
__device__ __forceinline__ void xcd_barrier_complete(unsigned* bar, unsigned x, unsigned& nloc, unsigned& nx) {
    const unsigned G = gridDim.x * gridDim.y * gridDim.z;
    unsigned sum, cnt, mine, sp = 0u;
    for (;;) {
        sum = 0u; cnt = 0u; mine = 0u;
#pragma unroll
        for (unsigned j = 0; j < 16; ++j) { const unsigned c = xb_ld(&bar[XB_XCNT(j)]); sum += c; cnt += (c > 0u) ? 1u : 0u; mine = (j == x) ? c : mine; }
        if (sum == G) break;
        __builtin_amdgcn_s_sleep(1);
        if ((++sp & 255u) == 0u) { if (xb_ld(&bar[XB_TMO])) break; if (sp > XB_SPIN_CAP) { atomicAdd(&bar[XB_TMO], 1u); break; } }
    }
    nloc = mine > 0u ? mine : 1u; nx = cnt > 0u ? cnt : 1u;
}

__device__ __forceinline__ void xcd_barrier(const XcdBarrier& b) {
    asm volatile("s_waitcnt vmcnt(0)" ::: "memory");
    __syncthreads();
    if (threadIdx.x == 0) {
        unsigned* bar = b.bar;
        __builtin_amdgcn_s_waitcnt(0);
        unsigned nloc = b.st[0], nx = b.st[1];
        if (nloc == 0u) { xcd_barrier_complete(bar, b.x, nloc, nx); b.st[0] = nloc; b.st[1] = nx; }
        const unsigned old = xb_add(&bar[XB_XSUB(b.x)], 1u);
        const unsigned gen = old / nloc;
        if (old + 1u == (gen + 1u) * nloc) {
            __builtin_amdgcn_fence(__ATOMIC_RELEASE, "agent");
            asm volatile("s_waitcnt vmcnt(0)" ::: "memory");
            const unsigned og = xb_add(&bar[XB_TOP], 1u);
            const unsigned tg = og / nx;
            if (og + 1u == (tg + 1u) * nx) xb_add(&bar[XB_TOPGEN], 1u);
            else XB_SPIN(xb_ld(&bar[XB_TOPGEN]) == tg, bar);
            __builtin_amdgcn_fence(__ATOMIC_ACQUIRE, "agent");
            xb_add(&bar[XB_XGEN(b.x)], 1u);
            asm volatile("s_waitcnt vmcnt(0)" ::: "memory");
        } else {
            XB_SPIN(xb_ld(&bar[XB_XGEN(b.x)]) == gen, bar);
            __builtin_amdgcn_fence(__ATOMIC_ACQUIRE, "agent");
            asm volatile("s_waitcnt vmcnt(0)" ::: "memory");
        }
    }
    __syncthreads();
}

#ifndef PHMASK
#define PHMASK 0x1FFF
#endif
#define PH_ON(k) (((PHMASK) >> (k)) & 1)
#define INP(k) (args.in[lauint(k)])
__global__ void __launch_bounds__(NWAVES * 64, 2) mega_fwd(Args args) {
    extern __shared__ __attribute__((aligned(16))) unsigned char lds[];
    cg::grid_group grid = cg::this_grid();
    const int G = gridDim.x, bx = blockIdx.x;
    const int vcu = (G % 8 == 0) ? (bx % 8) * (G / 8) + bx / 8 : bx;
    const int NGW = G * NWAVES;
    volatile LAS unsigned* MISC = (volatile LAS unsigned*)((LAS unsigned char*)lds + 131072 + 320);
    if (threadIdx.x < 32) MISC[threadIdx.x] = 0u;
    __syncthreads();
    XcdBarrier xbar = xcd_barrier_post((unsigned*)(args.ws + WS_CTL), MISC + 8);
#define GRID_BAR() do { XcdBarrier bb_ = xbar; bb_.bar = (unsigned*)lau((unsigned char*)bb_.bar); bb_.x = (unsigned)lauint((int)bb_.x); xcd_barrier(bb_); } while (0)
#define PTRS const int tid = lautid(), lane = tid & 63, wave = __builtin_amdgcn_readfirstlane(tid >> 6), gw = vcu * NWAVES + wave; (void)lane; (void)gw; unsigned char* ws = lau(args.ws); float* X = (float*)lau((unsigned char*)args.out); (void)X; \
    float* mods = (float*)(ws + WS_MODS); float* rowss = (float*)(ws + WS_ROWSS); float* rstdv = (float*)(ws + WS_RSTD); (void)rstdv; float* cs = (float*)(ws + WS_CS); float* sn = (float*)(ws + WS_SN); float* biasT = (float*)(ws + WS_BIAS); \
    bf16* AP = (bf16*)(ws + WS_AP); bf16* YS = (bf16*)(ws + WS_YS); bf16* QC = (bf16*)(ws + WS_QC); bf16* KVC = (bf16*)(ws + WS_KVC); bf16* YG = (bf16*)(ws + WS_YG); bf16* HB = (bf16*)(ws + WS_H); float* MG = (float*)(ws + WS_MG); \
    (void)mods; (void)rowss; (void)cs; (void)sn; (void)biasT; (void)AP; (void)YS; (void)QC; (void)KVC; (void)YG; (void)HB; (void)MG; \
    unsigned char* wl = ws + WS_W + (size_t)l * W_LAYER; const float* ml = mods + (size_t)l * NB * NMOD; const float* shw = (const float*)(ws + WS_SHW + (size_t)l * SHW_L); (void)wl; (void)ml; (void)shw;
    LAS unsigned char* ldsl = (LAS unsigned char*)lds;

    if (PH_ON(0)) {
        const int l = 0; PTRS
        for (int it = wave * G + vcu; it < 2 * (NMOD / 32); it += NGW) { const int l = it / (NMOD / 32), n0 = (it % (NMOD / 32)) * 32;
            sg_item(INP(1), DM, true, INP(2) + (size_t)l * DM * NMOD, NMOD, n0, mods + (size_t)l * NB * NMOD, NMOD, n0, INP(3) + (size_t)l * NMOD, lane); }
        for (int e = bx * 512 + tid; e < 2048 * 16; e += G * 512) { const int p = e >> 4, i = e & 15; const float inv = powf(10000.0f, -(float)(2 * i) / 32.0f); const float ang = (float)p * inv; float s, c; sincos_d(ang, s, c); cs[e] = c; sn[e] = s; }
        for (int e = bx * 512 + tid; e < 6 * 257; e += G * 512) { const int h = e / 257, idx = e % 257, rel = idx - 128, n = rel < 0 ? -rel : rel;
            int bk = rel > 0 ? 16 : 0; if (n < 8) bk += n; else { int lg = 31 - __clz(n * n); int large = 2 + lg; if (large > 15) large = 15; bk += large; }
            biasT[h * 260 + idx] = INP(12)[bk * 6 + h] * LOG2E; }
        LAS float* scr = (LAS float*)(ldsl + wave * 16384);
#pragma unroll 1
        for (int l2 = 0; l2 < 2; ++l2) { const int l = l2;
            unsigned char* wl = ws + WS_W + (size_t)l * W_LAYER;
            tr_matrix(INP(5) + (size_t)l * DM * NGU, DM, NGU, (bf16*)(wl + W_GU1), DM, 0, 1, nullptr, scr, lane, gw, NGW);
            tr_matrix(INP(6) + (size_t)l * FF * DM, FF, DM, (bf16*)(wl + W_DN1), FF, 0, 0, nullptr, scr, lane, gw, NGW);
            tr_matrix(INP(22) + (size_t)l * DM * NGU, DM, NGU, (bf16*)(wl + W_GU2), DM, 0, 1, nullptr, scr, lane, gw, NGW);
            tr_matrix(INP(23) + (size_t)l * FF * DM, FF, DM, (bf16*)(wl + W_DN2), FF, 0, 0, nullptr, scr, lane, gw, NGW);
            tr_matrix(INP(8) + (size_t)l * DM * 4768, DM, 4768, (bf16*)(wl + W_IN), DM, 0, 2, nullptr, scr, lane, gw, NGW);
            tr_matrix(INP(14) + (size_t)l * 256 * 384, 256, 384, (bf16*)(wl + W_QUP), 256, 0, 0, INP(13) + l * 256, scr, lane, gw, NGW);
            tr_matrix(INP(16) + (size_t)l * 128 * 512, 128, 512, (bf16*)(wl + W_KVUP), 128, 0, 0, INP(15) + l * 128, scr, lane, gw, NGW);
            tr_matrix(INP(17) + (size_t)l * 384 * DM, 384, DM, (bf16*)(wl + W_BR), DM, 0, 0, nullptr, scr, lane, gw, NGW);
            tr_matrix(INP(18) + (size_t)l * 384 * DM, 384, DM, (bf16*)(wl + W_BR), DM, 384, 0, nullptr, scr, lane, gw, NGW);
            tr_matrix(INP(19) + (size_t)l * 256 * DM, 256, DM, (bf16*)(wl + W_BR), DM, 768, 0, nullptr, scr, lane, gw, NGW);
            tr_matrix(INP(20) + (size_t)l * DM * DM, DM, DM, (bf16*)(wl + W_OUT), DM, 0, 0, nullptr, scr, lane, gw, NGW);
            for (int e = bx * 512 + tid; e < 96 * 1024 / 8; e += G * 512) { const int rr = e >> 7, r2 = rr < 32 ? 1536 + 96 + rr : 1536 + 192 + (rr - 32); ((v4u*)(wl + W_IN + (size_t)r2 * 1024 * 2))[e & 127] = (v4u){0u, 0u, 0u, 0u}; }
            for (int e = bx * 512 + tid; e < 128 * 256 / 8; e += G * 512) ((v4u*)(wl + W_QUP + (size_t)384 * 256 * 2))[e] = (v4u){0u, 0u, 0u, 0u};
        }
    }
    grid.sync();
    if (PH_ON(1)) {
        const int l = 0; PTRS
#pragma unroll 1
        for (int l2 = 0; l2 < 2; ++l2) { const int l = l2;
            float* shw = (float*)(ws + WS_SHW + (size_t)l * SHW_L); const float* ml = mods + (size_t)l * NB * NMOD;
            for (int it = wave * G + vcu; it < (NGU + 4768 + NGU) / 32; it += NGW) {
                int n0 = it * 32;
                if (n0 < NGU) { const int dr = (n0 < FF) ? (n0 / 128) * 256 + (n0 % 128) : ((n0 - FF) / 128) * 256 + 128 + ((n0 - FF) % 128);
                    sg_item(ml + 0 * DM, NMOD, false, INP(5) + (size_t)l * DM * NGU, NGU, n0, shw, NGU, dr, nullptr, lane); continue; }
                n0 -= NGU;
                if (n0 < 4768) { const int dr = (n0 < 1696) ? n0 : n0 + 96;
                    sg_item(ml + 3 * DM, NMOD, false, INP(8) + (size_t)l * DM * 4768, 4768, n0, shw + 32 * NGU, NIN, dr, nullptr, lane); continue; }
                n0 -= 4768;
                { const int dr = (n0 < FF) ? (n0 / 128) * 256 + (n0 % 128) : ((n0 - FF) / 128) * 256 + 128 + ((n0 - FF) % 128);
                    sg_item(ml + 6 * DM, NMOD, false, INP(22) + (size_t)l * DM * NGU, NGU, n0, shw + 32 * NGU + 32 * NIN, NGU, dr, nullptr, lane); }
            }
        }
        const float* gain = INP(4);
#pragma unroll 2
        for (int m = gw; m < MTOK; m += NGW) {
            const int b = m >> 11; const f32x4* xr = (const f32x4*)(INP(0) + (size_t)m * DM) + lane; const float* scp = mods + (size_t)b * NMOD + 1 * DM;
            f32x4 v[4]; float s = 0.f;
#pragma unroll
            for (int j = 0; j < 4; ++j) { v[j] = xr[64 * j]; s += (v[j][0] * v[j][0] + v[j][1] * v[j][1]) + (v[j][2] * v[j][2] + v[j][3] * v[j][3]); }
            s = wave_sum(s);
            if (lane < 16) rowss[(size_t)m * 16 + lane] = lane == 0 ? s : 0.f;
            unsigned long long* o8 = (unsigned long long*)(AP + (size_t)m * DM) + lane;
#pragma unroll
            for (int j = 0; j < 4; ++j) { const int col = 4 * lane + 256 * j; const f32x4 g = GL(f32x4, gain + col), sc = GL(f32x4, scp + col); const f32x4 y = v[j] * g * (sc + 1.0f);
                o8[64 * j] = (unsigned long long)pk2(y[0], y[1]) | ((unsigned long long)pk2(y[2], y[3]) << 32); }
        }
    }
    GRID_BAR();

#pragma unroll 1
    for (int ph = 0; ph < 26; ++ph) {
        const int l = ph >= 13 ? 1 : 0, k = ph - 13 * l, f = k >= 10 ? 1 : 0;
        if ((k == 0 || k == 3 || k == 10) && PH_ON(12)) { PTRS  for (int row = bx * 512 + tid; row < MTOK; row += G * 512) { const f32x4 a = GL(f32x4, rowss + (size_t)row * 16), b = GL(f32x4, rowss + (size_t)row * 16 + 4), c = GL(f32x4, rowss + (size_t)row * 16 + 8), d = GL(f32x4, rowss + (size_t)row * 16 + 12); const float sq = ((a[0] + a[1]) + (a[2] + a[3])) + ((b[0] + b[1]) + (b[2] + b[3])) + ((c[0] + c[1]) + (c[2] + c[3])) + ((d[0] + d[1]) + (d[2] + d[3])); rstdv[row] = 1.0f / sqrtf(sq * (1.0f / 1024.0f) + EPS); } }
        {
            {
                if (k == 4 && PH_ON(2)) { PTRS   pg8::Gemm g{AP, (const bf16*)(wl + W_IN), DM, DM}; pg8::Order S; S.init(MTOK, NIN, G, bx, DM / 64, 0);
                  pg8::EpiIn E{YS, YG, rstdv, shw + 32 * NGU, ldsl + 131072 + 1024};
                  pg8::gemm_phase<pg8::EpiIn, pg8::Order, true, true>(ldsl, g, S, E); }
                if (k == 5 && PH_ON(3)) { PTRS
                    const float* gq = INP(9) + l * 64; const float* gk = INP(10) + l * 64;
#pragma unroll 2
                    for (int m = gw; m < MTOK; m += NGW) {
                        const int t = m & (SEQ - 1), rp = t >> 6, cp = t & 63;
                        bf16* yr = YS + (size_t)m * NYS;
                        const v4u w1 = GL(v4u, yr + lane * 8), w2 = GL(v4u, yr + 1280 + lane * 8);
                        { float v[8] = {bflo(w1.x), bfhi(w1.x), bflo(w1.y), bfhi(w1.y), bflo(w1.z), bfhi(w1.z), bflo(w1.w), bfhi(w1.w)};
                          const int hh = lane >> 3, j = lane & 7;
                          float ss = 0.f;
#pragma unroll
                          for (int e = 0; e < 8; ++e) ss += v[e] * v[e];
                          ss += __shfl_xor(ss, 1); ss += __shfl_xor(ss, 2); ss += __shfl_xor(ss, 4);
                          const float rstd = 1.0f / sqrtf(ss * (1.0f / 64.0f) + EPS);
                          const float* gp = (hh < 6 ? gq : gk) + j * 8;
                          const int pos = (j < 4) ? rp : cp; const float* cp_ = cs + pos * 16 + (j & 1) * 8; const float* sp_ = sn + pos * 16 + (j & 1) * 8;
                          const float osc = hh < 6 ? C2A : 1.0f; float o[8];
#pragma unroll
                          for (int e = 0; e < 8; ++e) { const float a = v[e] * rstd * gp[e]; const float pa = __shfl_xor(a, 2); const float c = cp_[e], s = sp_[e];
                              o[e] = ((j & 2) == 0 ? a * c - pa * s : pa * s + a * c) * osc; }
                          v4u ow; ow.x = pk2(o[0], o[1]); ow.y = pk2(o[2], o[3]); ow.z = pk2(o[4], o[5]); ow.w = pk2(o[6], o[7]);
                          GS(v4u, yr + lane * 8) = ow; }
                        { float v[8] = {bflo(w2.x), bfhi(w2.x), bflo(w2.y), bfhi(w2.y), bflo(w2.z), bfhi(w2.z), bflo(w2.w), bfhi(w2.w)};
                          float ss = 0.f;
#pragma unroll
                          for (int e = 0; e < 8; ++e) ss += v[e] * v[e];
                          ss += __shfl_xor(ss, 1); ss += __shfl_xor(ss, 2); ss += __shfl_xor(ss, 4); ss += __shfl_xor(ss, 8);
                          const float s32 = ss + __shfl_xor(ss, 16);
                          const float rstd = lane < 32 ? 1.0f / sqrtf(s32 * (1.0f / 256.0f) + EPS) : 1.0f / sqrtf(ss * (1.0f / 128.0f) + EPS);
                          const int j = lane & 3; const float* cp_ = cs + t * 16 + (j & 1) * 8; const float* sp_ = sn + t * 16 + (j & 1) * 8;
                          float o[8];
#pragma unroll
                          for (int e = 0; e < 8; ++e) { const float pa = __shfl_xor(v[e], 2); const float c = cp_[e], s = sp_[e];
                              o[e] = lane < 48 ? v[e] * rstd : ((j & 2) == 0 ? v[e] * c - pa * s : pa * s + v[e] * c); }
                          v4u ow; ow.x = pk2(o[0], o[1]); ow.y = pk2(o[2], o[3]); ow.z = pk2(o[4], o[5]); ow.w = pk2(o[6], o[7]);
                          if (lane < 52) GS(v4u, yr + 1280 + lane * 8) = ow; }
                    }
                }
                if (k == 6 && PH_ON(4)) { PTRS  pg8::Gemm g{YS + 1280, (const bf16*)(wl + W_QUP), NYS, 256}; pg8::Order S; S.init(MTOK, 512, G, bx, 4, 0);
                  pg8::EpiQup E{QC, cs, sn};
                  pg8::gemm_phase<pg8::EpiQup, pg8::Order, true, true>(ldsl, g, S, E); }
                if (k == 6 && PH_ON(5)) { PTRS  pg8::Gemm g{YS + 1536, (const bf16*)(wl + W_KVUP), NYS, 128}; pg8::Order S; S.init(MTOK, 512, G, bx, 2, 0);
                  pg8::EpiPlain E{KVC, 512};
                  pg8::gemm_phase<pg8::EpiPlain, pg8::Order, true, true>(ldsl, g, S, E); }
#ifndef ATT_REP
#define ATT_REP 1
#endif
                for (int rep = 0; rep < ATT_REP; ++rep) if (k == 7 && PH_ON(6)) { PTRS
                    const int b = vcu >> 3, jj = vcu & 7; const size_t r0 = (size_t)b * SEQ;
#pragma unroll 1
                    for (int i = 0; i < 6; ++i) { const int e = (jj & 3) * 6 + i, h = (jj >> 2) * 3 + (e >> 3), qb = e & 7, kvh = jj >> 2;
                        att::Desc d{YS + r0 * NYS + h * 64, NYS, YS + r0 * NYS + 384 + kvh * 64, NYS, nullptr, 0, YS + r0 * NYS + 512 + kvh * 64, NYS, AP + r0 * DM + h * 64, DM};
                        att::unit<64, 0>(d, qb * 256, (att::ATT_LAS_T)lds, nullptr, 0.f); }
#pragma unroll 1
                    for (int i = 0; i < 4; ++i) { const int e = jj * 4 + i, h = e >> 3, qb = e & 7;
                        att::Desc d{QC + r0 * 384 + h * 96, 384, KVC + r0 * 512 + h * 128, 512, YS + r0 * NYS + 1664, NYS, KVC + r0 * 512 + h * 128 + 64, 512, AP + r0 * DM + 768 + h * 64, DM};
                        att::unit<96, 0>(d, qb * 256, (att::ATT_LAS_T)lds, nullptr, 0.f); }
#pragma unroll 1
                    for (int i = 0; i < 6; ++i) { const int e = (jj & 3) * 6 + i, h = (jj >> 2) * 3 + (e >> 3), qb = e & 7, kvh = jj >> 2;
                        att::Desc d{YS + r0 * NYS + 640 + h * 64, NYS, YS + r0 * NYS + 1024 + kvh * 64, NYS, nullptr, 0, YS + r0 * NYS + 1152 + kvh * 64, NYS, AP + r0 * DM + 384 + h * 64, DM};
                        att::unit<64, 1>(d, qb * 256, (att::ATT_LAS_T)lds, biasT + h * 260, INP(11)[l * 6 + h] * LOG2E); }
                }
                if (k == 8 && PH_ON(7)) { PTRS  pg8::Gemm g{AP, (const bf16*)(wl + W_BR), DM, DM}; pg8::Order S; S.init(MTOK, DM, G, bx, 0, 1);
                  pg8::EpiBr E{YG, MG};
                  pg8::gemm_phase<pg8::EpiBr, pg8::Order, true, true>(ldsl, g, S, E); }
                if (k == 9 && PH_ON(8)) { PTRS  pg8::Gemm g{YG, (const bf16*)(wl + W_OUT), DM, DM}; pg8::Order S; S.init(MTOK, DM, G, bx, DM / 64, 0);
                  pg8::EpiRes E{X, X, ml + 5 * DM, AP, INP(21) + l * DM, ml + 7 * DM, rowss, ldsl + 131072 + 1024, 1.0f, 0};
                  pg8::gemm_phase<pg8::EpiRes, pg8::Order, true, true>(ldsl, g, S, E); }
            }
            if ((k == 1 || k == 11) && PH_ON(9)) { PTRS   pg8::Gemm g{AP, (const bf16*)(wl + (f ? W_GU2 : W_GU1)), DM, DM}; pg8::Order S; S.init(MTOK, NGU, G, bx, DM / 64, 0);
              pg8::EpiGU E{HB, rstdv, shw + (f ? 32 * NGU + 32 * NIN : 0)};
              pg8::gemm_phase<pg8::EpiGU, pg8::Order, true, true>(ldsl, g, S, E); }
            if ((k == 2 || k == 12) && PH_ON(10)) { PTRS  pg8::Gemm g{HB, (const bf16*)(wl + (f ? W_DN2 : W_DN1)), FF, FF}; pg8::Order S; S.init(MTOK, DM, G, bx, FF / 64, 0);
              const float* base = (l == 0 && f == 0) ? INP(0) : X;
              const bool has_next = !(l == 1 && f == 1);
              const float* ngain = f == 0 ? INP(7) + l * DM : INP(4) + (l + 1) * DM;
              const float* nsc = f == 0 ? ml + 4 * DM : ml + (size_t)NB * NMOD + 1 * DM;
              pg8::EpiRes E{base, X, ml + (f ? 8 : 2) * DM, has_next ? AP : nullptr, ngain, nsc, rowss, ldsl + 131072 + 1024, 0.5f, 0};
              pg8::gemm_phase<pg8::EpiRes, pg8::Order, true, true>(ldsl, g, S, E); }
        }
        GRID_BAR();
    }
    if (PH_ON(11)) {
        const int l = 0; PTRS
        const float* gain = INP(24);
        for (int m = gw; m < MTOK; m += 2 * NGW) {
            f32x4* xr0 = (f32x4*)(X + (size_t)m * DM) + lane; f32x4* xr1 = (f32x4*)(X + (size_t)(m + NGW) * DM) + lane; f32x4 v[2][4]; float s0 = 0.f, s1 = 0.f;
#pragma unroll
            for (int j = 0; j < 4; ++j) { v[0][j] = GL(f32x4, xr0 + 64 * j); v[1][j] = GL(f32x4, xr1 + 64 * j); }
#pragma unroll
            for (int j = 0; j < 4; ++j) { s0 += (v[0][j][0] * v[0][j][0] + v[0][j][1] * v[0][j][1]) + (v[0][j][2] * v[0][j][2] + v[0][j][3] * v[0][j][3]); s1 += (v[1][j][0] * v[1][j][0] + v[1][j][1] * v[1][j][1]) + (v[1][j][2] * v[1][j][2] + v[1][j][3] * v[1][j][3]); }
            const float r0 = 1.0f / sqrtf(wave_sum(s0) * (1.0f / 1024.0f) + EPS), r1 = 1.0f / sqrtf(wave_sum(s1) * (1.0f / 1024.0f) + EPS);
#pragma unroll
            for (int j = 0; j < 4; ++j) { const f32x4 g = GL(f32x4, gain + 4 * lane + 256 * j); GS(f32x4, xr0 + 64 * j) = v[0][j] * r0 * g; GS(f32x4, xr1 + 64 * j) = v[1][j] * r1 * g; }
        }
    }
}

extern "C" void kernel_launch(void* const* d_in, const int* in_sizes, int n_in, void* d_out, int out_size, void* d_ws, size_t ws_size, hipStream_t stream) {
    static int grid = 0;
    if (grid == 0) {
        if (n_in != 25 || out_size != MTOK * DM || ws_size < WS_END) { fprintf(stderr, "kernel_launch: unexpected shapes (n_in %d, out %d, ws %zu)\n", n_in, out_size, ws_size); grid = -1; return; }
        int dev = 0, cus = 0, per_cu = 0;
        hipGetDevice(&dev); hipDeviceGetAttribute(&cus, hipDeviceAttributeMultiprocessorCount, dev);
        if (hipFuncSetAttribute((const void*)mega_fwd, hipFuncAttributeMaxDynamicSharedMemorySize, LDS_BYTES) != hipSuccess) { fprintf(stderr, "kernel_launch: hipFuncSetAttribute failed\n"); grid = -1; return; }
        if (hipOccupancyMaxActiveBlocksPerMultiprocessor(&per_cu, (const void*)mega_fwd, NWAVES * 64, LDS_BYTES) != hipSuccess || per_cu < 1) { fprintf(stderr, "kernel_launch: occupancy query failed (%d)\n", per_cu); per_cu = 1; }
        (void)hipGetLastError();
        grid = cus * (per_cu > 1 ? 1 : per_cu);
        fprintf(stderr, "kernel_launch: grid %d (cus %d, per_cu %d)\n", grid, cus, per_cu);
    }
    if (grid < 0) return;
    if (hipMemsetAsync((char*)d_ws + WS_CTL, 0, CTL_BYTES, stream) != hipSuccess) { fprintf(stderr, "kernel_launch: memset failed\n"); return; }
    Args a{};
    for (int i = 0; i < 25; ++i) a.in[i] = (const float*)d_in[i];
    a.out = (float*)d_out; a.ws = (unsigned char*)d_ws;
    void* kargs[] = {&a};
    hipError_t e = hipLaunchCooperativeKernel((const void*)mega_fwd, dim3(grid), dim3(NWAVES * 64), kargs, LDS_BYTES, stream);
    if (e != hipSuccess) fprintf(stderr, "kernel_launch: cooperative launch failed: %s (grid %d)\n", hipGetErrorString(e), grid);
}
```

```cpp
#include <hip/hip_runtime.h>
#include <hip/hip_cooperative_groups.h>
#include <hip/hip_bf16.h>
#include <cstdio>
#include <cstdint>
#include <cmath>
namespace cg = cooperative_groups;
#define GL(T, p) (*(const __attribute__((address_space(1))) T*)(p))
#define GS(T, p) (*(__attribute__((address_space(1))) T*)(p))
#define GLB(T, base, boff) (*(const __attribute__((address_space(1))) T*)((const __attribute__((address_space(1))) char*)(base) + (unsigned)(boff)))
#define GSB(T, base, boff) (*(__attribute__((address_space(1))) T*)((__attribute__((address_space(1))) char*)(base) + (unsigned)(boff)))
__device__ __forceinline__ int lautid() { int t = threadIdx.x; asm volatile("" : "+v"(t)); return t; }
namespace pg8 {
#define PG8_LAS __attribute__((address_space(3)))
typedef unsigned short bf16_t;
typedef short bf16x8 __attribute__((ext_vector_type(8)));
typedef float f32x4 __attribute__((ext_vector_type(4)));
typedef unsigned u32x4 __attribute__((ext_vector_type(4)));
constexpr int BM = 256, BK = 64, HALF = 128, HTB = HALF * BK * 2  , STAGE_BYTES = 8 * HTB, NXCD = 8, WGM = 8;

__host__ __device__ __forceinline__ int lds_byte(int r, int c) { const int st = (r >> 4) * 2 + (c >> 5), rr = r & 15, cc = c & 31, ob = rr * 64 + cc * 2; return st * 1024 + (ob ^ (((ob >> 9) & 1) << 5)); }
__host__ __device__ __forceinline__ void stage_rc(int b, int& R, int& C) { const int st = b / 1024, sb = b % 1024, swz = sb ^ (((sb >> 9) & 1) << 5); R = (st >> 1) * 16 + swz / 64; C = (st & 1) * 32 + (swz % 64) / 2; }
__host__ __device__ __forceinline__ int perm32(int rho) { const int n = rho >> 4, i = rho & 15; return 8 * (i >> 2) + 4 * n + (i & 3); }

struct Unit { int pm, pn, k0, nt, br; };
struct Gemm { const bf16_t* A; const bf16_t* Bt; int lda, ldb; };

struct Order {
    int nM, nN, nwg, G, c, nt, mode;
    __device__ __forceinline__ void init(int M, int N, int G_, int c_, int nt_, int mode_) { nM = M / BM; nN = N / BM; nwg = nM * nN; G = G_; c = c_; nt = nt_; mode = mode_; asm volatile("" : "+s"(nt)); }
    __device__ __forceinline__ bool next(int i, Unit& u) const {
        const int ii = mode ? i / 3 : i;
        const int L = ii * G + c; if (L >= nwg) return false;
        int wgid = L; { const int q = nwg / NXCD, r = nwg % NXCD, xcd = wgid % NXCD, off = wgid / NXCD; wgid = (xcd < r ? xcd * (q + 1) : r * (q + 1) + (xcd - r) * q) + off; }
        const int nig = WGM * nN, gid = wgid / nig, fm = gid * WGM, gsz = (nM - fm) < WGM ? (nM - fm) : WGM;
        u.pm = fm + ((wgid % nig) % gsz); u.pn = (wgid % nig) / gsz;
        if (mode) { const int br = i - ii * 3; u.br = br; u.k0 = br * 384; u.nt = (br == 2) ? 4 : 6; } else { u.br = 0; u.k0 = 0; u.nt = nt; }
        return true;
    }
    __device__ __forceinline__ void a_ready(const Unit&) const {}
    __device__ __forceinline__ void done(const Unit&) const {}
};
typedef float f32x2_cv __attribute__((ext_vector_type(2))); typedef __bf16 bf16x2_cv __attribute__((ext_vector_type(2)));
__device__ __forceinline__ unsigned cvt_pk_bf16(float lo, float hi) { f32x2_cv v = {lo, hi}; bf16x2_cv b = __builtin_convertvector(v, bf16x2_cv); return __builtin_bit_cast(unsigned, b); }
template <class Epi, class Sched, bool ALIGN_EPI = false, bool SP2 = false>
__device__ __forceinline__ void gemm_phase(PG8_LAS unsigned char* lds, const Gemm g, const Sched& S, const Epi& E) {
    const int tid = lautid(), wid = __builtin_amdgcn_readfirstlane(tid >> 6), lane = tid & 63, wr = wid >> 2, wc = wid & 3, fr = lane & 15, fq = lane >> 4;
    int nt;
    unsigned voffA[2], voffB[2];
#pragma unroll
    for (int i = 0; i < 2; ++i) { int R, C; stage_rc(tid * 16 + i * 8192, R, C); const int Rb = Epi::PERM ? ((R & ~31) + perm32(R & 31)) : R;
        voffA[i] = (unsigned)(R * g.lda + C) * 2u; voffB[i] = (unsigned)(Rb * g.ldb + C) * 2u; }
    const size_t kstep = (size_t)(BK * 2);
    const size_t hstepA = (size_t)HALF * g.lda * 2, hstepB = (size_t)HALF * g.ldb * 2;
    const size_t tstepA = 2 * hstepA, tstepB = 2 * hstepB;
    const unsigned ldsw = (unsigned)wid * 1024u;
    const int aoff = lds_byte(wr * 64 + fr, fq * 8), boff = lds_byte(wc * 32 + fr, fq * 8);
#define PG8_SA(b, h) (((b) * 2 + (h)) * HTB)
#define PG8_SB(b, h) ((4 + (b) * 2 + (h)) * HTB)
#define PG8_STAGE(bufoff, gbase, voff) do { _Pragma("unroll") for (int _i = 0; _i < 2; ++_i) \
        __builtin_amdgcn_global_load_lds((const unsigned*)((const char*)(gbase) + (voff)[_i]), (PG8_LAS unsigned*)(lds + (bufoff) + ldsw + _i * 8192), 16, 0, 0); } while (0)
#define PG8_LDA(dst, b, h) do { _Pragma("unroll") for (int m = 0; m < 4; ++m) _Pragma("unroll") for (int k = 0; k < 2; ++k) dst[m][k] = *(const PG8_LAS bf16x8*)(lds + PG8_SA(b, h) + aoff + m * 2048 + k * 1024); } while (0)
#define PG8_LDB(dst, b, h) do { _Pragma("unroll") for (int n = 0; n < 2; ++n) _Pragma("unroll") for (int k = 0; k < 2; ++k) dst[n][k] = *(const PG8_LAS bf16x8*)(lds + PG8_SB(b, h) + boff + n * 2048 + k * 1024); } while (0)
#define PG8_MMA(ai, bj, At, Bt) do { __builtin_amdgcn_s_setprio(1); _Pragma("unroll") for (int m = 0; m < 4; ++m) _Pragma("unroll") for (int n = 0; n < 2; ++n) _Pragma("unroll") for (int k = 0; k < 2; ++k) \
        acc[ai][bj][m][n] = __builtin_amdgcn_mfma_f32_16x16x32_bf16(Bt[n][k], At[m][k], acc[ai][bj][m][n], 0, 0, 0); __builtin_amdgcn_s_setprio(0); } while (0)
#define PG8_WAIT_V(n) asm volatile("s_waitcnt vmcnt(" #n ")" ::: "memory")
#define PG8_WAIT_L(n) asm volatile("s_waitcnt lgkmcnt(" #n ")" ::: "memory")
#define PG8_BAR __builtin_amdgcn_s_barrier()
#define PG8_SCHED __builtin_amdgcn_sched_barrier(0)
    Unit cur, nxt; int ui = 0;
    if (!S.next(0, cur)) return;
    f32x4 acc[2][2][4][2];
#pragma unroll
    for (int a = 0; a < 2; ++a)
#pragma unroll
        for (int b = 0; b < 2; ++b)
#pragma unroll
            for (int m = 0; m < 4; ++m)
#pragma unroll
                for (int n = 0; n < 2; ++n) acc[a][b][m][n] = (f32x4){0.f, 0.f, 0.f, 0.f};
    bf16x8 At[4][2], B0[2][2], B1[2][2];
    const char* cA = (const char*)g.A + (size_t)cur.pm * tstepA + (size_t)cur.k0 * 2; const char* cB = (const char*)g.Bt + (size_t)cur.pn * tstepB + (size_t)cur.k0 * 2; nt = cur.nt;
    S.a_ready(cur);
    if constexpr (SP2) {
        PG8_STAGE(PG8_SB(0, 0), cB, voffB); PG8_STAGE(PG8_SB(0, 1), cB + hstepB, voffB); PG8_STAGE(PG8_SA(0, 0), cA, voffA); PG8_STAGE(PG8_SA(0, 1), cA + hstepA, voffA);
        if (wr == 1) PG8_BAR;
        PG8_WAIT_V(2); PG8_BAR;
        PG8_STAGE(PG8_SB(1, 0), cB + kstep, voffB); PG8_STAGE(PG8_SA(1, 0), cA + kstep, voffA); PG8_STAGE(PG8_SB(1, 1), cB + hstepB + kstep, voffB);
        PG8_WAIT_V(6); PG8_BAR;
    } else {
        PG8_STAGE(PG8_SB(0, 0), cB, voffB); PG8_STAGE(PG8_SA(0, 0), cA, voffA); PG8_STAGE(PG8_SB(0, 1), cB + hstepB, voffB); PG8_STAGE(PG8_SA(0, 1), cA + hstepA, voffA);
        if (wr == 1) PG8_BAR;
        PG8_WAIT_V(4); PG8_BAR;
        PG8_STAGE(PG8_SB(1, 0), cB + kstep, voffB); PG8_STAGE(PG8_SA(1, 0), cA + kstep, voffA); PG8_STAGE(PG8_SB(1, 1), cB + hstepB + kstep, voffB);
        PG8_WAIT_V(6); PG8_BAR;
    }
    for (;;) {
        const bool has_next = S.next(ui + 1, nxt);
        const char* nA = has_next ? (const char*)g.A + (size_t)nxt.pm * tstepA + (size_t)nxt.k0 * 2 : cA; const char* nB = has_next ? (const char*)g.Bt + (size_t)nxt.pn * tstepB + (size_t)nxt.k0 * 2 : cB;
        for (int t = 0; t < nt; t += 2) {
            const bool last = (t == nt - 2);
            const char* a1 = cA + (size_t)(t + 1) * kstep;
            const char* a2 = last ? nA : cA + (size_t)(t + 2) * kstep; const char* b2 = last ? nB : cB + (size_t)(t + 2) * kstep;
            const char* a3 = a2 + kstep; const char* b3 = b2 + kstep;
            if (last && has_next) S.a_ready(nxt);
            if constexpr (SP2) {
            PG8_LDB(B0, 0, 0); PG8_LDB(B1, 0, 1); PG8_SCHED; PG8_LDA(At, 0, 0); PG8_STAGE(PG8_SA(1, 1), a1 + hstepA, voffA);
            PG8_WAIT_V(8); PG8_WAIT_L(0); PG8_BAR; PG8_MMA(0, 0, At, B0); PG8_MMA(0, 1, At, B1); PG8_BAR; PG8_SCHED;
            PG8_LDA(At, 0, 1); PG8_STAGE(PG8_SB(0, 0), b2, voffB); PG8_STAGE(PG8_SB(0, 1), b2 + hstepB, voffB); PG8_STAGE(PG8_SA(0, 0), a2, voffA);
            PG8_WAIT_V(8); PG8_WAIT_L(0); PG8_BAR; PG8_MMA(1, 0, At, B0); PG8_MMA(1, 1, At, B1); PG8_BAR; PG8_SCHED;
            PG8_LDB(B0, 1, 0); PG8_LDB(B1, 1, 1); PG8_SCHED; PG8_LDA(At, 1, 0); PG8_STAGE(PG8_SA(0, 1), a2 + hstepA, voffA);
            PG8_WAIT_V(8); PG8_WAIT_L(0); PG8_BAR; PG8_MMA(0, 0, At, B0); PG8_MMA(0, 1, At, B1); PG8_BAR; PG8_SCHED;
            PG8_LDA(At, 1, 1); PG8_STAGE(PG8_SB(1, 0), b3, voffB); PG8_STAGE(PG8_SB(1, 1), b3 + hstepB, voffB); PG8_STAGE(PG8_SA(1, 0), a3, voffA);
            PG8_WAIT_V(8); PG8_WAIT_L(0); PG8_BAR; PG8_MMA(1, 0, At, B0); PG8_MMA(1, 1, At, B1); PG8_BAR; PG8_SCHED;
            } else {
            PG8_LDB(B0, 0, 0); PG8_SCHED; PG8_LDA(At, 0, 0); PG8_STAGE(PG8_SA(1, 1), a1 + hstepA, voffA);
            PG8_WAIT_L(8); PG8_BAR; PG8_WAIT_L(0); PG8_MMA(0, 0, At, B0); PG8_BAR; PG8_SCHED;
            PG8_LDB(B1, 0, 1); PG8_STAGE(PG8_SB(0, 0), b2, voffB);
            PG8_BAR; PG8_WAIT_L(0); PG8_MMA(0, 1, At, B1); PG8_BAR;
            PG8_LDA(At, 0, 1); PG8_STAGE(PG8_SA(0, 0), a2, voffA);
            PG8_BAR; PG8_WAIT_L(0); PG8_MMA(1, 0, At, B0); PG8_BAR; PG8_SCHED;
            PG8_STAGE(PG8_SB(0, 1), b2 + hstepB, voffB);
            PG8_WAIT_V(6); PG8_BAR; PG8_MMA(1, 1, At, B1); PG8_BAR;
            PG8_LDB(B0, 1, 0); PG8_SCHED; PG8_LDA(At, 1, 0); PG8_STAGE(PG8_SA(0, 1), a2 + hstepA, voffA);
            PG8_WAIT_L(8); PG8_BAR; PG8_WAIT_L(0); PG8_MMA(0, 0, At, B0); PG8_BAR; PG8_SCHED;
            PG8_LDB(B1, 1, 1); PG8_STAGE(PG8_SB(1, 0), b3, voffB);
            PG8_BAR; PG8_WAIT_L(0); PG8_MMA(0, 1, At, B1); PG8_BAR;
            PG8_LDA(At, 1, 1); PG8_STAGE(PG8_SA(1, 0), a3, voffA);
            PG8_BAR; PG8_WAIT_L(0); PG8_MMA(1, 0, At, B0); PG8_BAR; PG8_SCHED;
            PG8_STAGE(PG8_SB(1, 1), b3 + hstepB, voffB);
            PG8_WAIT_V(6); PG8_BAR; PG8_MMA(1, 1, At, B1); PG8_BAR;
            }
        }
        if constexpr (ALIGN_EPI) { if (wr == 0) PG8_BAR; }
        if constexpr (!Epi::AFTER_DRAIN) { E(acc, cur, wr, wc, fr, fq); S.done(cur); }
        if (!has_next) break;
#pragma unroll
        for (int a = 0; a < 2; ++a)
#pragma unroll
            for (int b = 0; b < 2; ++b)
#pragma unroll
                for (int m = 0; m < 4; ++m)
#pragma unroll
                    for (int n = 0; n < 2; ++n) acc[a][b][m][n] = (f32x4){0.f, 0.f, 0.f, 0.f};
        cur = nxt; cA = nA; cB = nB; ++ui; nt = cur.nt;
        if constexpr (ALIGN_EPI) { if (wr == 1) PG8_BAR; }
    }
    PG8_WAIT_V(0);
    if constexpr (!ALIGN_EPI) { if (wr == 0) PG8_BAR; }
    PG8_BAR;
    if constexpr (Epi::AFTER_DRAIN) { E.fused(acc, cur, wr, wc, fr, fq, lds, wid, lane); S.done(cur); }
#undef PG8_SA
#undef PG8_SB
#undef PG8_STAGE
#undef PG8_LDA
#undef PG8_LDB
#undef PG8_MMA
#undef PG8_WAIT_V
#undef PG8_WAIT_L
#undef PG8_BAR
#undef PG8_SCHED
}
}
constexpr int MTOK = 65536, DM = 1024, SEQ = 2048, NB = 32, FF = 2816, NGU = 5632, NIN = 4864, NYS = 1792, NMOD = 9216;
constexpr float EPS = 1e-6f, LOG2E = 1.4426950408889634f;
constexpr float C2A = 0.125f * LOG2E;
constexpr float C2C = 0.10206207261596575f * LOG2E;

namespace pg8 {
__device__ __forceinline__ float fsigmoid(float x) { return __builtin_amdgcn_rcpf(1.0f + __builtin_amdgcn_exp2f(-x * LOG2E)); }
__device__ __forceinline__ void load_rstd(const float* rstdv, int row0, float (&rs)[2][4]) {
#pragma unroll
    for (int ai = 0; ai < 2; ++ai)
#pragma unroll
        for (int m = 0; m < 4; ++m) rs[ai][m] = GL(float, rstdv + row0 + ai * HALF + m * 16);
}
struct EpiGU {
    static constexpr bool PERM = true, AFTER_DRAIN = false;
    bf16_t* H; const float* rowss; const float* shW;
    __device__ __forceinline__ void operator()(const f32x4 (&acc)[2][2][4][2], const Unit& u, int wr, int wc, int fr, int fq) const {
        const int row0 = u.pm * BM + wr * 64 + fr, b = u.pm >> 3;
        const int cg0 = u.pn * BM + wc * 32 + 8 * fq, hc = u.pn * HALF + wc * 32 + 8 * fq;
        f32x4 sg[2], su[2];
#pragma unroll
        for (int n = 0; n < 2; ++n) { sg[n] = GL(f32x4, shW + (size_t)b * NGU + cg0 + 4 * n); su[n] = GL(f32x4, shW + (size_t)b * NGU + cg0 + HALF + 4 * n); }
        float rs[2][4]; load_rstd(rowss, row0, rs);
#pragma unroll
        for (int ai = 0; ai < 2; ++ai)
#pragma unroll
            for (int m = 0; m < 4; ++m) {
                const float r = rs[ai][m]; float h[8];
#pragma unroll
                for (int n = 0; n < 2; ++n) { const f32x4 g = acc[ai][0][m][n] * r + sg[n], up = acc[ai][1][m][n] * r + su[n];
#pragma unroll
                    for (int j = 0; j < 4; ++j) h[4 * n + j] = g[j] * fsigmoid(g[j]) * up[j]; }
                u32x4 w; w.x = cvt_pk_bf16(h[0], h[1]); w.y = cvt_pk_bf16(h[2], h[3]); w.z = cvt_pk_bf16(h[4], h[5]); w.w = cvt_pk_bf16(h[6], h[7]);
                GS(u32x4, H + (size_t)(row0 + ai * HALF + m * 16) * FF + hc) = w;
            }
    }
};
struct EpiRes {
    static constexpr bool PERM = false, AFTER_DRAIN = false;
    const float* base; float* out; const float* gate; bf16_t* AP; const float* gain; const float* sc; float* rowss; PG8_LAS unsigned char* stg; float gscale; int pad;
    __device__ __forceinline__ void operator()(const f32x4 (&acc)[2][2][4][2], const Unit& u, int wr, int wc, int fr, int fq) const {
        typedef unsigned u32x2 __attribute__((ext_vector_type(2)));
        const unsigned row0 = u.pm * BM + wr * 64 + fr, b = u.pm >> 3, col0 = u.pn * BM + wc * 32 + 4 * fq;
        const int lane = fq * 16 + fr, r8 = lane >> 3, c8 = lane & 7;
        PG8_LAS float* st = (PG8_LAS float*)(stg + (wr * 4 + wc) * 2304);
        f32x4 gv[2][2], mu2[2];
#pragma unroll
        for (int bj = 0; bj < 2; ++bj) {
#pragma unroll
            for (int n = 0; n < 2; ++n) gv[bj][n] = GLB(f32x4, gate, (b * NMOD + col0 + bj * HALF + n * 16) * 4u) * gscale;
            const unsigned cb2 = u.pn * BM + bj * HALF + wc * 32 + 4 * c8;
            if (AP) mu2[bj] = GLB(f32x4, gain, cb2 * 4u) * (GLB(f32x4, sc, (b * NMOD + cb2) * 4u) + 1.0f); else mu2[bj] = (f32x4){0.f, 0.f, 0.f, 0.f};
        }
#pragma unroll
        for (int ai = 0; ai < 2; ++ai) {
            f32x4 xb[4][2][2];
#pragma unroll
            for (int m = 0; m < 4; ++m)
#pragma unroll
                for (int bj = 0; bj < 2; ++bj)
#pragma unroll
                    for (int n = 0; n < 2; ++n) xb[m][bj][n] = GLB(f32x4, base, ((row0 + ai * HALF + m * 16) * DM + col0 + bj * HALF + n * 16) * 4u);
#pragma unroll
            for (int m = 0; m < 4; ++m) {
                const unsigned row = row0 + ai * HALF + m * 16, rowb = u.pm * BM + wr * 64 + ai * HALF + m * 16; float ss = 0.f;
#pragma unroll
                for (int bj = 0; bj < 2; ++bj) {
#pragma unroll
                    for (int n = 0; n < 2; ++n) { const f32x4 x = xb[m][bj][n] + gv[bj][n] * acc[ai][bj][m][n];
                        ss += (x[0] * x[0] + x[1] * x[1]) + (x[2] * x[2] + x[3] * x[3]);
                        *(PG8_LAS f32x4*)(st + fr * 36 + n * 16 + fq * 4) = x; }
                    asm volatile("s_waitcnt lgkmcnt(0)" ::: "memory");
#pragma unroll
                    for (int h = 0; h < 2; ++h) { const f32x4 v = *(const PG8_LAS f32x4*)(st + (h * 8 + r8) * 36 + c8 * 4);
                        const unsigned off = (rowb + h * 8 + r8) * DM + u.pn * BM + bj * HALF + wc * 32 + 4 * c8;
                        GSB(f32x4, out, off * 4u) = v;
                        if (AP) { const f32x4 y = v * mu2[bj]; u32x2 w; w.x = cvt_pk_bf16(y[0], y[1]); w.y = cvt_pk_bf16(y[2], y[3]); GSB(u32x2, AP, off * 2u) = w; } }
                    asm volatile("s_waitcnt lgkmcnt(0)" ::: "memory");
                }
                ss += __shfl_xor(ss, 16); ss += __shfl_xor(ss, 32);
                if (fq == 0) GSB(float, rowss, (row * 16 + u.pn * 4 + wc) * 4u) = ss;
            }
        }
    }
};
struct EpiIn {
    static constexpr bool PERM = true, AFTER_DRAIN = false;
    bf16_t* YS; bf16_t* YG; const float* rowss; const float* shW; PG8_LAS unsigned char* stg;
    __device__ __forceinline__ void operator()(const f32x4 (&acc)[2][2][4][2], const Unit& u, int wr, int wc, int fr, int fq) const {
        const int row0 = u.pm * BM + wr * 64 + fr, b = u.pm >> 3;
        const int lane = fq * 16 + fr, r8 = lane >> 3, c8 = lane & 7;
        PG8_LAS unsigned char* st = stg + (wr * 4 + wc) * 2304;
        float rs[2][4]; load_rstd(rowss, row0, rs);
        const bool gates = u.pn >= 7;
        f32x4 sh[2][2]; float scale[2];
#pragma unroll
        for (int bj = 0; bj < 2; ++bj) { const int cg = u.pn * BM + 64 * wc + 32 * bj;
            scale[bj] = (!gates && cg >= 640 && cg < 1024) ? C2A : 1.0f;
#pragma unroll
            for (int n = 0; n < 2; ++n) sh[bj][n] = GL(f32x4, shW + (size_t)b * NIN + cg + 8 * fq + 4 * n); }
        bf16_t* dst; unsigned ld;
        if (gates) { dst = YG + (size_t)((u.pn - 7) >> 2) * ((size_t)MTOK * DM) + ((u.pn - 7) & 3) * BM + 64 * wc + 8 * c8; ld = DM; }
        else { dst = YS + u.pn * BM + 64 * wc + 8 * c8; ld = NYS; }
        const unsigned rowa = u.pm * BM + wr * 64;
        if (gates) body<true>(acc, rs, sh, scale, st, dst, ld, rowa, fr, fq, r8, c8); else body<false>(acc, rs, sh, scale, st, dst, ld, rowa, fr, fq, r8, c8);
    }
    template <bool GATES> __device__ __forceinline__ void body(const f32x4 (&acc)[2][2][4][2], const float (&rs)[2][4], const f32x4 (&sh)[2][2], const float (&scale)[2], PG8_LAS unsigned char* st,
                                                                bf16_t* dst, unsigned ld, unsigned rowa, int fr, int fq, int r8, int c8) const {
#pragma unroll
        for (int ai = 0; ai < 2; ++ai)
#pragma unroll
            for (int m = 0; m < 4; ++m) {
                const float r = rs[ai][m];
#pragma unroll
                for (int bj = 0; bj < 2; ++bj) { float h[8];
#pragma unroll
                    for (int n = 0; n < 2; ++n) { const f32x4 v = acc[ai][bj][m][n] * r + sh[bj][n];
#pragma unroll
                        for (int j = 0; j < 4; ++j) h[4 * n + j] = GATES ? fsigmoid(v[j]) : v[j] * scale[bj]; }
                    u32x4 w; w.x = cvt_pk_bf16(h[0], h[1]); w.y = cvt_pk_bf16(h[2], h[3]); w.z = cvt_pk_bf16(h[4], h[5]); w.w = cvt_pk_bf16(h[6], h[7]);
                    *(PG8_LAS u32x4*)(st + fr * 144 + bj * 64 + fq * 16) = w; }
                asm volatile("s_waitcnt lgkmcnt(0)" ::: "memory");
#pragma unroll
                for (int h2 = 0; h2 < 2; ++h2) { const u32x4 w = *(const PG8_LAS u32x4*)(st + (h2 * 8 + r8) * 144 + c8 * 16);
                    GS(u32x4, dst + (size_t)(rowa + ai * HALF + m * 16 + h2 * 8 + r8) * ld) = w; }
                asm volatile("s_waitcnt lgkmcnt(0)" ::: "memory");
            }
    }
};
struct EpiQup {
    static constexpr bool PERM = false, AFTER_DRAIN = false;
    bf16_t* QC; const float* cs; const float* sn;
    __device__ __forceinline__ void operator()(const f32x4 (&acc)[2][2][4][2], const Unit& u, int wr, int wc, int fr, int fq) const {
        typedef unsigned u32x2 __attribute__((ext_vector_type(2)));
        const int row0 = u.pm * BM + wr * 64 + fr;
#pragma unroll
        for (int bj = 0; bj < 2; ++bj) {
            const int cb = u.pn * BM + bj * HALF + wc * 32;
            if (cb >= 384) continue;
            const bool rope = (cb % 96) == 64;
#pragma unroll
            for (int ai = 0; ai < 2; ++ai)
#pragma unroll
                for (int m = 0; m < 4; ++m) {
                    const int row = row0 + ai * HALF + m * 16, t = row & (SEQ - 1);
                    f32x4 x0 = acc[ai][bj][m][0], x1 = acc[ai][bj][m][1];
                    if (rope) { const f32x4 c = GL(f32x4, cs + t * 16 + 4 * fq), s = GL(f32x4, sn + t * 16 + 4 * fq);
                        const f32x4 y0 = x0 * c - x1 * s, y1 = x0 * s + x1 * c; x0 = y0; x1 = y1; }
                    x0 = x0 * C2C; x1 = x1 * C2C;
                    u32x2 w0, w1; w0.x = cvt_pk_bf16(x0[0], x0[1]); w0.y = cvt_pk_bf16(x0[2], x0[3]); w1.x = cvt_pk_bf16(x1[0], x1[1]); w1.y = cvt_pk_bf16(x1[2], x1[3]);
                    bf16_t* d = QC + (size_t)row * 384 + cb + 4 * fq;
                    *(u32x2*)d = w0; GS(u32x2, d + 16) = w1;
                }
        }
    }
};
struct EpiPlain {
    static constexpr bool PERM = true, AFTER_DRAIN = false;
    bf16_t* O; int ldc;
    __device__ __forceinline__ void operator()(const f32x4 (&acc)[2][2][4][2], const Unit& u, int wr, int wc, int fr, int fq) const {
        const int row0 = u.pm * BM + wr * 64 + fr, col0 = u.pn * BM + wc * 32 + 8 * fq;
#pragma unroll
        for (int ai = 0; ai < 2; ++ai)
#pragma unroll
            for (int m = 0; m < 4; ++m)
#pragma unroll
                for (int bj = 0; bj < 2; ++bj) { const f32x4 v0 = acc[ai][bj][m][0], v1 = acc[ai][bj][m][1];
                    u32x4 w; w.x = cvt_pk_bf16(v0[0], v0[1]); w.y = cvt_pk_bf16(v0[2], v0[3]); w.z = cvt_pk_bf16(v1[0], v1[1]); w.w = cvt_pk_bf16(v1[2], v1[3]);
                    GS(u32x4, O + (size_t)(row0 + ai * HALF + m * 16) * ldc + col0 + bj * HALF) = w; asm volatile("" ::: "memory"); }
    }
};
struct EpiBr {
    static constexpr bool PERM = true, AFTER_DRAIN = false;
    bf16_t* YG; float* MG;
    __device__ __forceinline__ void operator()(const f32x4 (&acc)[2][2][4][2], const Unit& u, int wr, int wc, int fr, int fq) const {
        const unsigned row0 = u.pm * BM + wr * 64 + fr, col0 = u.pn * BM + wc * 32 + 8 * fq;
        const bf16_t* G = YG + (size_t)u.br * ((size_t)MTOK * DM);
#pragma unroll
        for (int ai = 0; ai < 2; ++ai) {
            u32x4 gw[4][2], mw[4][2];
#pragma unroll
            for (int m = 0; m < 4; ++m)
#pragma unroll
                for (int bj = 0; bj < 2; ++bj) { const unsigned off = ((row0 + ai * HALF + m * 16) * DM + col0 + bj * HALF) * 2u;
                    gw[m][bj] = GLB(u32x4, G, off); mw[m][bj] = (u.br > 0) ? GLB(u32x4, YG, off) : (u32x4){0u, 0u, 0u, 0u}; }
#pragma unroll
            for (int m = 0; m < 4; ++m)
#pragma unroll
                for (int bj = 0; bj < 2; ++bj) { const unsigned off = ((row0 + ai * HALF + m * 16) * DM + col0 + bj * HALF) * 2u;
                    const u32x4 g = gw[m][bj], r = mw[m][bj]; f32x4 g0, g1, r0, r1;
                    g0[0] = __uint_as_float(g.x << 16); g0[1] = __uint_as_float(g.x & 0xffff0000u); g0[2] = __uint_as_float(g.y << 16); g0[3] = __uint_as_float(g.y & 0xffff0000u);
                    g1[0] = __uint_as_float(g.z << 16); g1[1] = __uint_as_float(g.z & 0xffff0000u); g1[2] = __uint_as_float(g.w << 16); g1[3] = __uint_as_float(g.w & 0xffff0000u);
                    r0[0] = __uint_as_float(r.x << 16); r0[1] = __uint_as_float(r.x & 0xffff0000u); r0[2] = __uint_as_float(r.y << 16); r0[3] = __uint_as_float(r.y & 0xffff0000u);
                    r1[0] = __uint_as_float(r.z << 16); r1[1] = __uint_as_float(r.z & 0xffff0000u); r1[2] = __uint_as_float(r.w << 16); r1[3] = __uint_as_float(r.w & 0xffff0000u);
                    const f32x4 v0 = acc[ai][bj][m][0] * g0 + r0, v1 = acc[ai][bj][m][1] * g1 + r1;
                    u32x4 w; w.x = cvt_pk_bf16(v0[0], v0[1]); w.y = cvt_pk_bf16(v0[2], v0[3]); w.z = cvt_pk_bf16(v1[0], v1[1]); w.w = cvt_pk_bf16(v1[2], v1[3]); GSB(u32x4, YG, off) = w; }
        }
    }
};
}
namespace att {
using bf16 = unsigned short;
using bf16x8 = __attribute__((ext_vector_type(8))) short;
using s16x4 = __attribute__((ext_vector_type(4))) short;
using f32x16 = __attribute__((ext_vector_type(16))) float;
using u32x4 = __attribute__((ext_vector_type(4))) unsigned;
constexpr int LDS_K = 0, KSLOT_MAX = 12288, LDS_V = 2 * KSLOT_MAX, LDS_WS = LDS_V + 2 * 8192, LDS_BIAS = LDS_WS + 2048, LDS_OST = LDS_BIAS + 2048, LDS_BYTES = LDS_OST + 8 * 4096;
__device__ __forceinline__ int crow(int r, int hi) { return (r & 3) + 8 * (r >> 2) + 4 * hi; }
__device__ __forceinline__ void glds16(const void* gsrc, unsigned lds_dst) { unsigned keep;
    asm volatile("s_mov_b32 %0, m0\n\ts_mov_b32 m0, %2\n\ts_nop 0\n\tglobal_load_lds_dwordx4 %1, off\n\ts_mov_b32 m0, %0" : "=&s"(keep) : "v"(gsrc), "s"(lds_dst) : "memory"); }
typedef float f32x2_t __attribute__((ext_vector_type(2))); typedef __bf16 bf16x2_t __attribute__((ext_vector_type(2)));
__device__ __forceinline__ unsigned cvtpk_s(float lo, float hi) { f32x2_t v = {lo, hi}; bf16x2_t b = __builtin_convertvector(v, bf16x2_t); return __builtin_bit_cast(unsigned, b); }
typedef __attribute__((address_space(3))) char* ATT_LAS_T;
__device__ __forceinline__ float max3f(float a, float b, float c) { float r; asm("v_max3_f32 %0, %1, %2, %3" : "=v"(r) : "v"(a), "v"(b), "v"(c)); return r; }
__device__ __forceinline__ float max2f(float a, float b) { float r; asm("v_max_f32_e32 %0, %1, %2" : "=v"(r) : "v"(a), "v"(b)); return r; }
struct Desc { const bf16* Q; int ldq; const bf16* K0; int ldk0; const bf16* K1; int ldk1; const bf16* V; int ldv; bf16* O; int ldo; };

__device__ __forceinline__ void pv(f32x16* o, int vb, bf16x8 pa0, bf16x8 pa1, bf16x8 pa2, bf16x8 pa3) {
#pragma unroll
    for (int d0 = 0; d0 < 2; ++d0) { s16x4 lo[4], hi[4];
#pragma unroll
        for (int ks = 0; ks < 4; ++ks) {
            asm volatile("ds_read_b64_tr_b16 %0,%1 offset:%c2" : "=&v"(lo[ks]) : "v"(vb), "i"(d0 * 4096 + ks * 1024) : "memory");
            asm volatile("ds_read_b64_tr_b16 %0,%1 offset:%c2" : "=&v"(hi[ks]) : "v"(vb), "i"(d0 * 4096 + ks * 1024 + 512) : "memory"); }
        asm volatile("s_waitcnt lgkmcnt(0)" ::: "memory"); __builtin_amdgcn_sched_barrier(0);
#define ATT_PK(k) (bf16x8){lo[k][0], lo[k][1], lo[k][2], lo[k][3], hi[k][0], hi[k][1], hi[k][2], hi[k][3]}
        o[d0] = __builtin_amdgcn_mfma_f32_32x32x16_bf16(pa0, ATT_PK(0), o[d0], 0, 0, 0);
        o[d0] = __builtin_amdgcn_mfma_f32_32x32x16_bf16(pa1, ATT_PK(1), o[d0], 0, 0, 0);
        o[d0] = __builtin_amdgcn_mfma_f32_32x32x16_bf16(pa2, ATT_PK(2), o[d0], 0, 0, 0);
        o[d0] = __builtin_amdgcn_mfma_f32_32x32x16_bf16(pa3, ATT_PK(3), o[d0], 0, 0, 0);
#undef ATT_PK
    }
}
#define ATT_LAS __attribute__((address_space(3)))
template <int DQK, int MODE> __device__ __forceinline__ void unit(const Desc& d, int q0, ATT_LAS char* shm, const float* biasg, float sinkl2) {
    constexpr int NCH = DQK / 8, KSLOT = DQK * 128, ND0 = DQK / 16; constexpr float THR = 8.0f, NEGBIG = -1e30f;
    const int tid = lautid(), lane = tid & 63, r32 = lane & 31, hi = lane >> 5; const int wid = __builtin_amdgcn_readfirstlane(tid >> 6);
    const unsigned lds0 = (unsigned)(uintptr_t)shm;
    ATT_LAS float* wsf = (ATT_LAS float*)(shm + LDS_WS) + wid * 64;
    ATT_LAS float* bias_l = (ATT_LAS float*)(shm + LDS_BIAS);
    const int qw = q0 + wid * 32;
    int t0 = 0, t1 = 32, wt0 = 0, wt1 = 32;
    if (MODE == 1) { t0 = q0 >= 128 ? (q0 - 128) >> 6 : 0; t1 = ((q0 + 383) >> 6) + 1; if (t1 > 32) t1 = 32;
                     wt0 = qw >= 128 ? (qw - 128) >> 6 : 0; wt1 = ((qw + 159) >> 6) + 1; if (wt1 > 32) wt1 = 32; }
#define ATT_DMA(t, bsel) do { \
        _Pragma("unroll") for (int c_ = 0; c_ < 2; ++c_) { const int ch_ = wid + 8 * c_; if (ch_ < NCH) { \
            const bf16* s_ = (ch_ < 8) ? d.K0 + (size_t)((t) * 64 + lane) * d.ldk0 + ch_ * 8 : d.K1 + (size_t)((t) * 64 + lane) * d.ldk1 + (ch_ - 8) * 8; \
            glds16(s_, (unsigned)__builtin_amdgcn_readfirstlane(lds0 + LDS_K + (bsel) * KSLOT + ch_ * 1024)); } } \
        { const bf16* v_ = d.V + (size_t)((t) * 64 + 16 * (wid & 3) + (lane >> 2)) * d.ldv + (wid >> 2) * 32 + (lane & 3) * 8; \
          glds16(v_, (unsigned)__builtin_amdgcn_readfirstlane(lds0 + LDS_V + (bsel) * 8192 + wid * 1024)); } } while (0)
    if (MODE == 1) { const int idx = tid - 128; bias_l[tid] = (idx >= 0 && idx <= 256) ? biasg[idx] : NEGBIG; }
    ATT_DMA(t0, 0);
    bf16x8 qr[ND0];
    { const bf16* Qw = d.Q + (size_t)(qw + r32) * d.ldq + hi * 8;
#pragma unroll
      for (int d0 = 0; d0 < ND0; ++d0) qr[d0] = GL(bf16x8, Qw + d0 * 16); }
    float mhat = 0.f, l_reg = 0.f; f32x16 o[2]; o[0] = f32x16{}; o[1] = f32x16{}; f32x16 negm = f32x16{};
    constexpr bool MSUM = true;
    f32x16 lacc = f32x16{}; const bf16x8 ones8 = (bf16x8){0x3f80, 0x3f80, 0x3f80, 0x3f80, 0x3f80, 0x3f80, 0x3f80, 0x3f80};
    const int vb0 = (int)(lds0 + LDS_V) + ((lane >> 4) & 1) * 32 + (lane & 3) * 8 + (4 * hi + ((lane & 15) >> 2)) * 64;
    int buf = 0;
    for (int t = t0; t < t1; ++t) {
        asm volatile("s_waitcnt vmcnt(0) lgkmcnt(0)\n\ts_barrier" ::: "memory");
        if (t + 1 < t1) ATT_DMA(t + 1, buf ^ 1);
        const bool active = (MODE == 0) || (t >= wt0 && t < wt1);
        if (active) {
            f32x16 p0, p1;
            { const ATT_LAS char* kb = shm + LDS_K + buf * KSLOT + hi * 1024 + r32 * 16;
#pragma unroll
              for (int d0 = 0; d0 < ND0; ++d0) {
                  const bf16x8 b0 = *(const ATT_LAS bf16x8*)(kb + d0 * 2048);
                  const bf16x8 b1 = *(const ATT_LAS bf16x8*)(kb + d0 * 2048 + 512);
                  if (d0 == 0) { p0 = __builtin_amdgcn_mfma_f32_32x32x16_bf16(b0, qr[0], negm, 0, 0, 0); p1 = __builtin_amdgcn_mfma_f32_32x32x16_bf16(b1, qr[0], negm, 0, 0, 0); }
                  else { p0 = __builtin_amdgcn_mfma_f32_32x32x16_bf16(b0, qr[d0], p0, 0, 0, 0); p1 = __builtin_amdgcn_mfma_f32_32x32x16_bf16(b1, qr[d0], p1, 0, 0, 0); } } }
            if (MODE == 1) {
                const ATT_LAS float* bp = bias_l + (64 * t - (qw + r32) + 256 + 4 * hi);
#pragma unroll
                for (int r = 0; r < 16; ++r) { p0[r] += bp[(r & 3) + 8 * (r >> 2)]; p1[r] += bp[(r & 3) + 8 * (r >> 2) + 32]; }
            }
            asm volatile("s_nop 15\n\ts_nop 7" : "+v"(p0), "+v"(p1));
            float rm, rmb;
            rm = max3f(p0[0], p0[1], p1[0]); rmb = max3f(p0[2], p0[3], p1[1]); rm = max3f(rm, p1[2], p1[3]);
#pragma unroll
            for (int r = 4; r < 16; r += 4) { rm = max3f(rm, p0[r], p0[r + 1]); rmb = max3f(rmb, p0[r + 2], p0[r + 3]); rm = max3f(rm, p1[r], p1[r + 1]); rmb = max3f(rmb, p1[r + 2], p1[r + 3]); }
            rm = max2f(rm, rmb);
            { auto rr = __builtin_amdgcn_permlane32_swap(__float_as_uint(rm), __float_as_uint(rm), false, false); rm = max2f(__uint_as_float(rr[0]), __uint_as_float(rr[1])); }
            const bool first = (t == wt0);
            if (first) {
                mhat = rm;
#pragma unroll
                for (int r = 0; r < 16; ++r) { p0[r] -= rm; p1[r] -= rm; }
#pragma unroll
                for (int r = 0; r < 16; ++r) negm[r] = -mhat;
            } else if (__any(rm > THR)) {
                const float dl = fmaxf(rm, 0.f); mhat += dl;
#pragma unroll
                for (int r = 0; r < 16; ++r) { p0[r] -= dl; p1[r] -= dl; }
#pragma unroll
                for (int r = 0; r < 16; ++r) negm[r] = -mhat;
                const float f = __builtin_amdgcn_exp2f(-dl); l_reg *= f; if (hi == 0) wsf[r32] = f;
                asm volatile("s_waitcnt lgkmcnt(0)" ::: "memory");
#pragma unroll
                for (int d_ = 0; d_ < 2; ++d_)
#pragma unroll
                    for (int r = 0; r < 16; ++r) o[d_][r] *= wsf[crow(r, hi)];
                if (MSUM) {
#pragma unroll
                    for (int r = 0; r < 16; ++r) lacc[r] *= wsf[crow(r, hi)];
                }
                asm volatile("s_waitcnt lgkmcnt(0)" ::: "memory");
            }
            if (MSUM) {
#pragma unroll
                for (int r = 0; r < 16; ++r) { p0[r] = __builtin_amdgcn_exp2f(p0[r]); p1[r] = __builtin_amdgcn_exp2f(p1[r]); }
            } else {
                float sacc = 0.f;
#pragma unroll
                for (int r = 0; r < 16; ++r) { p0[r] = __builtin_amdgcn_exp2f(p0[r]); p1[r] = __builtin_amdgcn_exp2f(p1[r]); sacc += p0[r] + p1[r]; }
                l_reg += sacc;
            }
            u32x4 pw0, pw1, pw2, pw3;
            pw0 = (u32x4){cvtpk_s(p0[0], p0[1]), cvtpk_s(p0[2], p0[3]), cvtpk_s(p0[4], p0[5]), cvtpk_s(p0[6], p0[7])};
            pw1 = (u32x4){cvtpk_s(p0[8], p0[9]), cvtpk_s(p0[10], p0[11]), cvtpk_s(p0[12], p0[13]), cvtpk_s(p0[14], p0[15])};
            pw2 = (u32x4){cvtpk_s(p1[0], p1[1]), cvtpk_s(p1[2], p1[3]), cvtpk_s(p1[4], p1[5]), cvtpk_s(p1[6], p1[7])};
            pw3 = (u32x4){cvtpk_s(p1[8], p1[9]), cvtpk_s(p1[10], p1[11]), cvtpk_s(p1[12], p1[13]), cvtpk_s(p1[14], p1[15])};
            pv(o, vb0 + buf * 8192, __builtin_bit_cast(bf16x8, pw0), __builtin_bit_cast(bf16x8, pw1), __builtin_bit_cast(bf16x8, pw2), __builtin_bit_cast(bf16x8, pw3));
            if (MSUM) {
                lacc = __builtin_amdgcn_mfma_f32_32x32x16_bf16(__builtin_bit_cast(bf16x8, pw0), ones8, lacc, 0, 0, 0);
                lacc = __builtin_amdgcn_mfma_f32_32x32x16_bf16(__builtin_bit_cast(bf16x8, pw1), ones8, lacc, 0, 0, 0);
                lacc = __builtin_amdgcn_mfma_f32_32x32x16_bf16(__builtin_bit_cast(bf16x8, pw2), ones8, lacc, 0, 0, 0);
                lacc = __builtin_amdgcn_mfma_f32_32x32x16_bf16(__builtin_bit_cast(bf16x8, pw3), ones8, lacc, 0, 0, 0);
            }
        }
        buf ^= 1;
    }
    float rli[16];
    if (MSUM) {
        if (MODE == 1) { if (hi == 0) wsf[32 + r32] = __builtin_amdgcn_exp2f(sinkl2 - mhat); asm volatile("s_waitcnt lgkmcnt(0)" ::: "memory"); }
#pragma unroll
        for (int r = 0; r < 16; ++r) rli[r] = __builtin_amdgcn_rcpf(lacc[r] + (MODE == 1 ? wsf[32 + crow(r, hi)] : 0.f));
    } else {
        { auto rr = __builtin_amdgcn_permlane32_swap(__float_as_uint(l_reg), __float_as_uint(l_reg), false, false); l_reg = __uint_as_float(rr[0]) + __uint_as_float(rr[1]); }
        if (MODE == 1) l_reg += __builtin_amdgcn_exp2f(sinkl2 - mhat);
        if (hi == 0) wsf[32 + r32] = l_reg; asm volatile("s_waitcnt lgkmcnt(0)" ::: "memory");
#pragma unroll
        for (int r = 0; r < 16; ++r) rli[r] = __builtin_amdgcn_rcpf(wsf[32 + crow(r, hi)]);
    }
    bf16* Ow = d.O + (size_t)qw * d.ldo;
    { ATT_LAS bf16* stg = (ATT_LAS bf16*)(shm + LDS_OST) + wid * 2048;
#pragma unroll
      for (int r = 0; r < 16; ++r) { const int orow = crow(r, hi);
#pragma unroll
          for (int d0 = 0; d0 < 2; ++d0) { const unsigned w = cvtpk_s(o[d0][r] * rli[r], 0.f); stg[orow * 64 + d0 * 32 + r32] = (bf16)(w & 0xffffu); } }
      asm volatile("s_waitcnt lgkmcnt(0)" ::: "memory");
#pragma unroll
      for (int i = 0; i < 4; ++i) { const int row = i * 8 + (lane >> 3), ch = lane & 7; const u32x4 v = *(const ATT_LAS u32x4*)(stg + row * 64 + ch * 8); GS(u32x4, Ow + (size_t)row * d.ldo + ch * 8) = v; } }
    asm volatile("s_waitcnt lgkmcnt(0)\n\ts_barrier" ::: "memory");
#undef ATT_DMA
}
}
#define GAS __attribute__((address_space(1)))
#define LAS __attribute__((address_space(3)))
typedef unsigned short bf16;
typedef unsigned v4u __attribute__((ext_vector_type(4)));
typedef float f32x4 __attribute__((ext_vector_type(4)));
typedef float f32x16 __attribute__((ext_vector_type(16)));
constexpr int NWAVES = 8;
constexpr int LDS_BYTES = 155648;
constexpr size_t MiB = 1u << 20;
constexpr size_t WS_MODS = 0;
constexpr size_t WS_SHW = 3 * MiB;
constexpr size_t SHW_L = (size_t)32 * (NGU + NIN + NGU) * 4;
constexpr size_t WS_ROWSS = 8 * MiB;
constexpr size_t WS_RSTD = 13 * MiB;
constexpr size_t WS_CS = 12 * MiB, WS_SN = WS_CS + 131072;
constexpr size_t WS_BIAS = WS_SN + 131072;
constexpr size_t WS_CTL = 15 * MiB, CTL_BYTES = 16384;
constexpr size_t WS_W = 16 * MiB, W_LAYER = 48 * MiB;
constexpr size_t W_GU1 = 0, W_DN1 = 11 * MiB, W_GU2 = W_DN1 + 5632 * 1024, W_DN2 = W_GU2 + 11 * MiB, W_IN = 33 * MiB, W_QUP = W_IN + (size_t)NIN * 1024 * 2, W_KVUP = W_QUP + 262144, W_BR = 43 * MiB, W_OUT = 45 * MiB;
constexpr size_t WS_AP = 112 * MiB;
constexpr size_t WS_YS = 240 * MiB;
constexpr size_t WS_QC = 464 * MiB;
constexpr size_t WS_KVC = 512 * MiB;
constexpr size_t WS_YG = 576 * MiB;
constexpr size_t WS_H = 240 * MiB;
constexpr size_t WS_MG = 240 * MiB;
constexpr size_t WS_END = 960 * MiB;
static_assert(W_DN2 + 5632 * 1024 <= W_IN && W_KVUP + 131072 <= W_BR && W_OUT + 2 * MiB <= W_LAYER && WS_W + 2 * W_LAYER <= WS_AP, "weight map");
static_assert(WS_H + (size_t)MTOK * FF * 2 <= WS_YG + 3 * (size_t)MTOK * DM * 2 && WS_MG + (size_t)MTOK * DM * 4 <= WS_KVC && WS_SHW + 2 * SHW_L <= WS_ROWSS, "ws map");

struct Args { const float* in[25]; float* out; unsigned char* ws; };
__device__ __forceinline__ int lauint(int k) { asm volatile("" : "+s"(k)); return k; }
__device__ __forceinline__ unsigned char* lau(unsigned char* p) { asm volatile("" : "+s"(p)); return p; }

__device__ __forceinline__ unsigned f2bf(float f) { unsigned u = __builtin_bit_cast(unsigned, f); return (u + 0x7fffu + ((u >> 16) & 1u)) >> 16; }
__device__ __forceinline__ unsigned pk2(float lo, float hi) { return f2bf(lo) | (f2bf(hi) << 16); }
__device__ __forceinline__ float bflo(unsigned w) { return __uint_as_float(w << 16); }
__device__ __forceinline__ float bfhi(unsigned w) { return __uint_as_float(w & 0xffff0000u); }
__device__ __forceinline__ float wave_sum(float v) {
#pragma unroll
    for (int o = 1; o < 64; o <<= 1) v += __shfl_xor(v, o);
    return v;
}
__device__ __forceinline__ void tr_item(const float* W, int N, int k0, int n0, bf16* WT, int ldk, int drow0, int dk0, const float* kscale, LAS float* scr, int lane) {
    { const int rr = lane >> 3, c4 = lane & 7;
      f32x4 v[8];
#pragma unroll
      for (int i = 0; i < 8; ++i) v[i] = GL(f32x4, W + (size_t)(k0 + i * 8 + rr) * N + n0 + 4 * c4);
#pragma unroll
      for (int i = 0; i < 8; ++i) { const int kk = i * 8 + rr; f32x4 x = v[i]; if (kscale) x = x * kscale[k0 + kk];
          scr[kk * 33 + 4 * c4 + 0] = x[0]; scr[kk * 33 + 4 * c4 + 1] = x[1]; scr[kk * 33 + 4 * c4 + 2] = x[2]; scr[kk * 33 + 4 * c4 + 3] = x[3]; } }
    asm volatile("s_waitcnt lgkmcnt(0)" ::: "memory");
    const int c = lane & 7;
#pragma unroll
    for (int j = 0; j < 4; ++j) { const int n = (lane >> 3) + 8 * j; const LAS float* s = scr + (8 * c) * 33 + n;
        v4u o; o.x = pk2(s[0 * 33], s[1 * 33]); o.y = pk2(s[2 * 33], s[3 * 33]); o.z = pk2(s[4 * 33], s[5 * 33]); o.w = pk2(s[6 * 33], s[7 * 33]);
        GS(v4u, WT + (size_t)(drow0 + n) * ldk + dk0 + k0 + 8 * c) = o; }
    asm volatile("s_waitcnt lgkmcnt(0)" ::: "memory");
}
__device__ __forceinline__ void tr_matrix(const float* W, int K, int N, bf16* WT, int ldk, int dk0, int remap, const float* kscale, LAS float* scr, int lane, int gw, int NGW) {
    const int nblk = N / 32, items = (K / 64) * nblk;
    for (int it = gw; it < items; it += NGW) {
        const int kb = it / nblk, nb = it - kb * nblk, n0 = nb * 32;
        int dr = n0;
        if (remap == 1) dr = (n0 < FF) ? (n0 / 128) * 256 + (n0 % 128) : ((n0 - FF) / 128) * 256 + 128 + ((n0 - FF) % 128);
        else if (remap == 2) { dr = (n0 < 1696) ? n0 : n0 + 96; const int c = dr & 255; dr = (dr & ~255) + 128 * ((c & 63) >> 5) + 32 * (c >> 6); }
        tr_item(W, N, kb * 64, n0, WT, ldk, dr, dk0, kscale, scr, lane);
    }
}
__device__ __forceinline__ void sg_item(const float* in, int in_stride, bool do_silu, const float* W, int N, int n0, float* out, int out_stride, int dcol0, const float* bias, int lane) {
    const int i = lane & 31, hi = lane >> 5;
    f32x16 acc = f32x16{};
    const float* ip = in + (size_t)i * in_stride + 4 * hi;
    const float* wp = W + (size_t)(4 * hi) * N + n0 + i;
#pragma unroll 16
    for (int k0 = 0; k0 < 1024; k0 += 8) {
        f32x4 a = GL(f32x4, ip + k0);
        if (do_silu) { a[0] = a[0] / (1.0f + __expf(-a[0])); a[1] = a[1] / (1.0f + __expf(-a[1])); a[2] = a[2] / (1.0f + __expf(-a[2])); a[3] = a[3] / (1.0f + __expf(-a[3])); }
        const float b0 = wp[(size_t)(k0 + 0) * N], b1 = wp[(size_t)(k0 + 1) * N], b2 = wp[(size_t)(k0 + 2) * N], b3 = wp[(size_t)(k0 + 3) * N];
        acc = __builtin_amdgcn_mfma_f32_32x32x2f32(a[0], b0, acc, 0, 0, 0);
        acc = __builtin_amdgcn_mfma_f32_32x32x2f32(a[1], b1, acc, 0, 0, 0);
        acc = __builtin_amdgcn_mfma_f32_32x32x2f32(a[2], b2, acc, 0, 0, 0);
        acc = __builtin_amdgcn_mfma_f32_32x32x2f32(a[3], b3, acc, 0, 0, 0);
    }
    const float bv = bias ? bias[n0 + i] : 0.f;
#pragma unroll
    for (int r = 0; r < 16; ++r) { const int b = (r & 3) + 8 * (r >> 2) + 4 * hi; out[(size_t)b * out_stride + dcol0 + i] = acc[r] + bv; }
}
__device__ __forceinline__ void sincos_d(float af, float& sv, float& cv) {
    const double a = (double)af; const double kq = rint(a * 0.63661977236758134308); const double r = (a - kq * 1.57079632679489655800) - kq * 6.123233995736766e-17;
    const double r2 = r * r;
    const double s = r * (1.0 - r2 * (1.0 / 6.0 - r2 * (1.0 / 120.0 - r2 * (1.0 / 5040.0 - r2 * (1.0 / 362880.0 - r2 * (1.0 / 39916800.0 - r2 * (1.0 / 6227020800.0 - r2 * (1.0 / 1307674368000.0))))))));
    const double c = 1.0 - r2 * (0.5 - r2 * (1.0 / 24.0 - r2 * (1.0 / 720.0 - r2 * (1.0 / 40320.0 - r2 * (1.0 / 3628800.0 - r2 * (1.0 / 479001600.0 - r2 * (1.0 / 87178291200.0 - r2 * (1.0 / 20922789888000.0))))))));
    const int q = ((int)kq) & 3;
    const double ss = (q == 0) ? s : (q == 1) ? c : (q == 2) ? -s : -c;
    const double cc = (q == 0) ? c : (q == 1) ? -s : (q == 2) ? -c : s;
    sv = (float)ss; cv = (float)cc;
}
#define XB_TMO      128
#define XB_XCNT(j)  (256  + 64 * (j))
#define XB_XSUB(j)  (1280 + 64 * (j))
#define XB_XGEN(j)  (2304 + 64 * (j))
#define XB_TOP      3328
#define XB_TOPGEN   3392
#define XCD_BAR_WORDS 3456
#define XB_SPIN_CAP (1u << 18)

__device__ __forceinline__ unsigned xb_ld(unsigned* p)              { return __hip_atomic_load(p, __ATOMIC_RELAXED, __HIP_MEMORY_SCOPE_AGENT); }
__device__ __forceinline__ unsigned xb_add(unsigned* p, unsigned v) { return __hip_atomic_fetch_add(p, v, __ATOMIC_RELAXED, __HIP_MEMORY_SCOPE_AGENT); }
__device__ __forceinline__ unsigned xb_xcc_id() { return (unsigned)__builtin_amdgcn_s_getreg((3 << 11) | 20) & 0xFu; }
#define XB_SPIN(cond, bar) do { unsigned _sp = 0; while (cond) { __builtin_amdgcn_s_sleep(1); \
    if ((++_sp & 255u) == 0u) { if (xb_ld(&(bar)[XB_TMO])) break; if (_sp > XB_SPIN_CAP) { atomicAdd(&(bar)[XB_TMO], 1u); break; } } } } while (0)

struct XcdBarrier {
    unsigned* bar; unsigned x;
    volatile LAS unsigned* st;
};

__device__ __forceinline__ XcdBarrier xcd_barrier_post(unsigned* bar, volatile LAS unsigned* st) {
    XcdBarrier b; b.bar = bar; b.x = (unsigned)__builtin_amdgcn_readfirstlane((int)xb_xcc_id()); b.st = st;
    if (threadIdx.x == 0) (void)xb_add(&bar[XB_XCNT(b.x)], 1u);
    return b;
}
__device__ __forceinline__ void xcd_barrier_complete(unsigned* bar, unsigned x, unsigned& nloc, unsigned& nx) {
    const unsigned G = gridDim.x * gridDim.y * gridDim.z;
    unsigned sum, cnt, mine, sp = 0u;
    for (;;) {
        sum = 0u; cnt = 0u; mine = 0u;
#pragma unroll
        for (unsigned j = 0; j < 16; ++j) { const unsigned c = xb_ld(&bar[XB_XCNT(j)]); sum += c; cnt += (c > 0u) ? 1u : 0u; mine = (j == x) ? c : mine; }
        if (sum == G) break;
        __builtin_amdgcn_s_sleep(1);
        if ((++sp & 255u) == 0u) { if (xb_ld(&bar[XB_TMO])) break; if (sp > XB_SPIN_CAP) { atomicAdd(&bar[XB_TMO], 1u); break; } }
    }
    nloc = mine > 0u ? mine : 1u; nx = cnt > 0u ? cnt : 1u;
}

__device__ __forceinline__ void xcd_barrier(const XcdBarrier& b) {
    asm volatile("s_waitcnt vmcnt(0)" ::: "memory");
    __syncthreads();
    if (threadIdx.x == 0) {
        unsigned* bar = b.bar;
        __builtin_amdgcn_s_waitcnt(0);
        unsigned nloc = b.st[0], nx = b.st[1];
        if (nloc == 0u) { xcd_barrier_complete(bar, b.x, nloc, nx); b.st[0] = nloc; b.st[1] = nx; }
        const unsigned old = xb_add(&bar[XB_XSUB(b.x)], 1u);
        const unsigned gen = old / nloc;
        if (old + 1u == (gen + 1u) * nloc) {
            __builtin_amdgcn_fence(__ATOMIC_RELEASE, "agent");
            asm volatile("s_waitcnt vmcnt(0)" ::: "memory");
            const unsigned og = xb_add(&bar[XB_TOP], 1u);
            const unsigned tg = og / nx;
            if (og + 1u == (tg + 1u) * nx) xb_add(&bar[XB_TOPGEN], 1u);
            else XB_SPIN(xb_ld(&bar[XB_TOPGEN]) == tg, bar);
            __builtin_amdgcn_fence(__ATOMIC_ACQUIRE, "agent");
            xb_add(&bar[XB_XGEN(b.x)], 1u);
            asm volatile("s_waitcnt vmcnt(0)" ::: "memory");
        } else {
            XB_SPIN(xb_ld(&bar[XB_XGEN(b.x)]) == gen, bar);
            __builtin_amdgcn_fence(__ATOMIC_ACQUIRE, "agent");
            asm volatile("s_waitcnt vmcnt(0)" ::: "memory");
        }
    }
    __syncthreads();
}

#ifndef PHMASK
#define PHMASK 0x1FFF
#endif
#define PH_ON(k) (((PHMASK) >> (k)) & 1)
#define INP(k) (args.in[lauint(k)])
__global__ void __launch_bounds__(NWAVES * 64, 2) mega_fwd(Args args) {
    extern __shared__ __attribute__((aligned(16))) unsigned char lds[];
    cg::grid_group grid = cg::this_grid();
    const int G = gridDim.x, bx = blockIdx.x;
    const int vcu = (G % 8 == 0) ? (bx % 8) * (G / 8) + bx / 8 : bx;
    const int NGW = G * NWAVES;
    volatile LAS unsigned* MISC = (volatile LAS unsigned*)((LAS unsigned char*)lds + 131072 + 320);
    if (threadIdx.x < 32) MISC[threadIdx.x] = 0u;
    __syncthreads();
    XcdBarrier xbar = xcd_barrier_post((unsigned*)(args.ws + WS_CTL), MISC + 8);
#define GRID_BAR() do { XcdBarrier bb_ = xbar; bb_.bar = (unsigned*)lau((unsigned char*)bb_.bar); bb_.x = (unsigned)lauint((int)bb_.x); xcd_barrier(bb_); } while (0)
#define PTRS const int tid = lautid(), lane = tid & 63, wave = __builtin_amdgcn_readfirstlane(tid >> 6), gw = vcu * NWAVES + wave; (void)lane; (void)gw; unsigned char* ws = lau(args.ws); float* X = (float*)lau((unsigned char*)args.out); (void)X; \
    float* mods = (float*)(ws + WS_MODS); float* rowss = (float*)(ws + WS_ROWSS); float* rstdv = (float*)(ws + WS_RSTD); (void)rstdv; float* cs = (float*)(ws + WS_CS); float* sn = (float*)(ws + WS_SN); float* biasT = (float*)(ws + WS_BIAS); \
    bf16* AP = (bf16*)(ws + WS_AP); bf16* YS = (bf16*)(ws + WS_YS); bf16* QC = (bf16*)(ws + WS_QC); bf16* KVC = (bf16*)(ws + WS_KVC); bf16* YG = (bf16*)(ws + WS_YG); bf16* HB = (bf16*)(ws + WS_H); float* MG = (float*)(ws + WS_MG); \
    (void)mods; (void)rowss; (void)cs; (void)sn; (void)biasT; (void)AP; (void)YS; (void)QC; (void)KVC; (void)YG; (void)HB; (void)MG; \
    unsigned char* wl = ws + WS_W + (size_t)l * W_LAYER; const float* ml = mods + (size_t)l * NB * NMOD; const float* shw = (const float*)(ws + WS_SHW + (size_t)l * SHW_L); (void)wl; (void)ml; (void)shw;
    LAS unsigned char* ldsl = (LAS unsigned char*)lds;

    if (PH_ON(0)) {
        const int l = 0; PTRS
        for (int it = wave * G + vcu; it < 2 * (NMOD / 32); it += NGW) { const int l = it / (NMOD / 32), n0 = (it % (NMOD / 32)) * 32;
            sg_item(INP(1), DM, true, INP(2) + (size_t)l * DM * NMOD, NMOD, n0, mods + (size_t)l * NB * NMOD, NMOD, n0, INP(3) + (size_t)l * NMOD, lane); }
        for (int e = bx * 512 + tid; e < 2048 * 16; e += G * 512) { const int p = e >> 4, i = e & 15; const float inv = powf(10000.0f, -(float)(2 * i) / 32.0f); const float ang = (float)p * inv; float s, c; sincos_d(ang, s, c); cs[e] = c; sn[e] = s; }
        for (int e = bx * 512 + tid; e < 6 * 257; e += G * 512) { const int h = e / 257, idx = e % 257, rel = idx - 128, n = rel < 0 ? -rel : rel;
            int bk = rel > 0 ? 16 : 0; if (n < 8) bk += n; else { int lg = 31 - __clz(n * n); int large = 2 + lg; if (large > 15) large = 15; bk += large; }
            biasT[h * 260 + idx] = INP(12)[bk * 6 + h] * LOG2E; }
        LAS float* scr = (LAS float*)(ldsl + wave * 16384);
#pragma unroll 1
        for (int l2 = 0; l2 < 2; ++l2) { const int l = l2;
            unsigned char* wl = ws + WS_W + (size_t)l * W_LAYER;
            tr_matrix(INP(5) + (size_t)l * DM * NGU, DM, NGU, (bf16*)(wl + W_GU1), DM, 0, 1, nullptr, scr, lane, gw, NGW);
            tr_matrix(INP(6) + (size_t)l * FF * DM, FF, DM, (bf16*)(wl + W_DN1), FF, 0, 0, nullptr, scr, lane, gw, NGW);
            tr_matrix(INP(22) + (size_t)l * DM * NGU, DM, NGU, (bf16*)(wl + W_GU2), DM, 0, 1, nullptr, scr, lane, gw, NGW);
            tr_matrix(INP(23) + (size_t)l * FF * DM, FF, DM, (bf16*)(wl + W_DN2), FF, 0, 0, nullptr, scr, lane, gw, NGW);
            tr_matrix(INP(8) + (size_t)l * DM * 4768, DM, 4768, (bf16*)(wl + W_IN), DM, 0, 2, nullptr, scr, lane, gw, NGW);
            tr_matrix(INP(14) + (size_t)l * 256 * 384, 256, 384, (bf16*)(wl + W_QUP), 256, 0, 0, INP(13) + l * 256, scr, lane, gw, NGW);
            tr_matrix(INP(16) + (size_t)l * 128 * 512, 128, 512, (bf16*)(wl + W_KVUP), 128, 0, 0, INP(15) + l * 128, scr, lane, gw, NGW);
            tr_matrix(INP(17) + (size_t)l * 384 * DM, 384, DM, (bf16*)(wl + W_BR), DM, 0, 0, nullptr, scr, lane, gw, NGW);
            tr_matrix(INP(18) + (size_t)l * 384 * DM, 384, DM, (bf16*)(wl + W_BR), DM, 384, 0, nullptr, scr, lane, gw, NGW);
            tr_matrix(INP(19) + (size_t)l * 256 * DM, 256, DM, (bf16*)(wl + W_BR), DM, 768, 0, nullptr, scr, lane, gw, NGW);
            tr_matrix(INP(20) + (size_t)l * DM * DM, DM, DM, (bf16*)(wl + W_OUT), DM, 0, 0, nullptr, scr, lane, gw, NGW);
            for (int e = bx * 512 + tid; e < 96 * 1024 / 8; e += G * 512) { const int rr = e >> 7, r2 = rr < 32 ? 1536 + 96 + rr : 1536 + 192 + (rr - 32); ((v4u*)(wl + W_IN + (size_t)r2 * 1024 * 2))[e & 127] = (v4u){0u, 0u, 0u, 0u}; }
            for (int e = bx * 512 + tid; e < 128 * 256 / 8; e += G * 512) ((v4u*)(wl + W_QUP + (size_t)384 * 256 * 2))[e] = (v4u){0u, 0u, 0u, 0u};
        }
    }
    grid.sync();
    if (PH_ON(1)) {
        const int l = 0; PTRS
#pragma unroll 1
        for (int l2 = 0; l2 < 2; ++l2) { const int l = l2;
            float* shw = (float*)(ws + WS_SHW + (size_t)l * SHW_L); const float* ml = mods + (size_t)l * NB * NMOD;
            for (int it = wave * G + vcu; it < (NGU + 4768 + NGU) / 32; it += NGW) {
                int n0 = it * 32;
                if (n0 < NGU) { const int dr = (n0 < FF) ? (n0 / 128) * 256 + (n0 % 128) : ((n0 - FF) / 128) * 256 + 128 + ((n0 - FF) % 128);
                    sg_item(ml + 0 * DM, NMOD, false, INP(5) + (size_t)l * DM * NGU, NGU, n0, shw, NGU, dr, nullptr, lane); continue; }
                n0 -= NGU;
                if (n0 < 4768) { const int dr = (n0 < 1696) ? n0 : n0 + 96;
                    sg_item(ml + 3 * DM, NMOD, false, INP(8) + (size_t)l * DM * 4768, 4768, n0, shw + 32 * NGU, NIN, dr, nullptr, lane); continue; }
                n0 -= 4768;
                { const int dr = (n0 < FF) ? (n0 / 128) * 256 + (n0 % 128) : ((n0 - FF) / 128) * 256 + 128 + ((n0 - FF) % 128);
                    sg_item(ml + 6 * DM, NMOD, false, INP(22) + (size_t)l * DM * NGU, NGU, n0, shw + 32 * NGU + 32 * NIN, NGU, dr, nullptr, lane); }
            }
        }
        const float* gain = INP(4);
#pragma unroll 2
        for (int m = gw; m < MTOK; m += NGW) {
            const int b = m >> 11; const f32x4* xr = (const f32x4*)(INP(0) + (size_t)m * DM) + lane; const float* scp = mods + (size_t)b * NMOD + 1 * DM;
            f32x4 v[4]; float s = 0.f;
#pragma unroll
            for (int j = 0; j < 4; ++j) { v[j] = xr[64 * j]; s += (v[j][0] * v[j][0] + v[j][1] * v[j][1]) + (v[j][2] * v[j][2] + v[j][3] * v[j][3]); }
            s = wave_sum(s);
            if (lane < 16) rowss[(size_t)m * 16 + lane] = lane == 0 ? s : 0.f;
            unsigned long long* o8 = (unsigned long long*)(AP + (size_t)m * DM) + lane;
#pragma unroll
            for (int j = 0; j < 4; ++j) { const int col = 4 * lane + 256 * j; const f32x4 g = GL(f32x4, gain + col), sc = GL(f32x4, scp + col); const f32x4 y = v[j] * g * (sc + 1.0f);
                o8[64 * j] = (unsigned long long)pk2(y[0], y[1]) | ((unsigned long long)pk2(y[2], y[3]) << 32); }
        }
    }
    GRID_BAR();

#pragma unroll 1
    for (int ph = 0; ph < 26; ++ph) {
        const int l = ph >= 13 ? 1 : 0, k = ph - 13 * l, f = k >= 10 ? 1 : 0;
        if ((k == 0 || k == 3 || k == 10) && PH_ON(12)) { PTRS  for (int row = bx * 512 + tid; row < MTOK; row += G * 512) { const f32x4 a = GL(f32x4, rowss + (size_t)row * 16), b = GL(f32x4, rowss + (size_t)row * 16 + 4), c = GL(f32x4, rowss + (size_t)row * 16 + 8), d = GL(f32x4, rowss + (size_t)row * 16 + 12); const float sq = ((a[0] + a[1]) + (a[2] + a[3])) + ((b[0] + b[1]) + (b[2] + b[3])) + ((c[0] + c[1]) + (c[2] + c[3])) + ((d[0] + d[1]) + (d[2] + d[3])); rstdv[row] = 1.0f / sqrtf(sq * (1.0f / 1024.0f) + EPS); } }
        {
            {
                if (k == 4 && PH_ON(2)) { PTRS   pg8::Gemm g{AP, (const bf16*)(wl + W_IN), DM, DM}; pg8::Order S; S.init(MTOK, NIN, G, bx, DM / 64, 0);
                  pg8::EpiIn E{YS, YG, rstdv, shw + 32 * NGU, ldsl + 131072 + 1024};
                  pg8::gemm_phase<pg8::EpiIn, pg8::Order, true, true>(ldsl, g, S, E); }
                if (k == 5 && PH_ON(3)) { PTRS
                    const float* gq = INP(9) + l * 64; const float* gk = INP(10) + l * 64;
#pragma unroll 2
                    for (int m = gw; m < MTOK; m += NGW) {
                        const int t = m & (SEQ - 1), rp = t >> 6, cp = t & 63;
                        bf16* yr = YS + (size_t)m * NYS;
                        const v4u w1 = GL(v4u, yr + lane * 8), w2 = GL(v4u, yr + 1280 + lane * 8);
                        { float v[8] = {bflo(w1.x), bfhi(w1.x), bflo(w1.y), bfhi(w1.y), bflo(w1.z), bfhi(w1.z), bflo(w1.w), bfhi(w1.w)};
                          const int hh = lane >> 3, j = lane & 7;
                          float ss = 0.f;
#pragma unroll
                          for (int e = 0; e < 8; ++e) ss += v[e] * v[e];
                          ss += __shfl_xor(ss, 1); ss += __shfl_xor(ss, 2); ss += __shfl_xor(ss, 4);
                          const float rstd = 1.0f / sqrtf(ss * (1.0f / 64.0f) + EPS);
                          const float* gp = (hh < 6 ? gq : gk) + j * 8;
                          const int pos = (j < 4) ? rp : cp; const float* cp_ = cs + pos * 16 + (j & 1) * 8; const float* sp_ = sn + pos * 16 + (j & 1) * 8;
                          const float osc = hh < 6 ? C2A : 1.0f; float o[8];
#pragma unroll
                          for (int e = 0; e < 8; ++e) { const float a = v[e] * rstd * gp[e]; const float pa = __shfl_xor(a, 2); const float c = cp_[e], s = sp_[e];
                              o[e] = ((j & 2) == 0 ? a * c - pa * s : pa * s + a * c) * osc; }
                          v4u ow; ow.x = pk2(o[0], o[1]); ow.y = pk2(o[2], o[3]); ow.z = pk2(o[4], o[5]); ow.w = pk2(o[6], o[7]);
                          GS(v4u, yr + lane * 8) = ow; }
                        { float v[8] = {bflo(w2.x), bfhi(w2.x), bflo(w2.y), bfhi(w2.y), bflo(w2.z), bfhi(w2.z), bflo(w2.w), bfhi(w2.w)};
                          float ss = 0.f;
#pragma unroll
                          for (int e = 0; e < 8; ++e) ss += v[e] * v[e];
                          ss += __shfl_xor(ss, 1); ss += __shfl_xor(ss, 2); ss += __shfl_xor(ss, 4); ss += __shfl_xor(ss, 8);
                          const float s32 = ss + __shfl_xor(ss, 16);
                          const float rstd = lane < 32 ? 1.0f / sqrtf(s32 * (1.0f / 256.0f) + EPS) : 1.0f / sqrtf(ss * (1.0f / 128.0f) + EPS);
                          const int j = lane & 3; const float* cp_ = cs + t * 16 + (j & 1) * 8; const float* sp_ = sn + t * 16 + (j & 1) * 8;
                          float o[8];
#pragma unroll
                          for (int e = 0; e < 8; ++e) { const float pa = __shfl_xor(v[e], 2); const float c = cp_[e], s = sp_[e];
                              o[e] = lane < 48 ? v[e] * rstd : ((j & 2) == 0 ? v[e] * c - pa * s : pa * s + v[e] * c); }
                          v4u ow; ow.x = pk2(o[0], o[1]); ow.y = pk2(o[2], o[3]); ow.z = pk2(o[4], o[5]); ow.w = pk2(o[6], o[7]);
                          if (lane < 52) GS(v4u, yr + 1280 + lane * 8) = ow; }
                    }
                }
                if (k == 6 && PH_ON(4)) { PTRS  pg8::Gemm g{YS + 1280, (const bf16*)(wl + W_QUP), NYS, 256}; pg8::Order S; S.init(MTOK, 512, G, bx, 4, 0);
                  pg8::EpiQup E{QC, cs, sn};
                  pg8::gemm_phase<pg8::EpiQup, pg8::Order, true, true>(ldsl, g, S, E); }
                if (k == 6 && PH_ON(5)) { PTRS  pg8::Gemm g{YS + 1536, (const bf16*)(wl + W_KVUP), NYS, 128}; pg8::Order S; S.init(MTOK, 512, G, bx, 2, 0);
                  pg8::EpiPlain E{KVC, 512};
                  pg8::gemm_phase<pg8::EpiPlain, pg8::Order, true, true>(ldsl, g, S, E); }
#ifndef ATT_REP
#define ATT_REP 1
#endif
                for (int rep = 0; rep < ATT_REP; ++rep) if (k == 7 && PH_ON(6)) { PTRS
                    const int b = vcu >> 3, jj = vcu & 7; const size_t r0 = (size_t)b * SEQ;
#pragma unroll 1
                    for (int i = 0; i < 6; ++i) { const int e = (jj & 3) * 6 + i, h = (jj >> 2) * 3 + (e >> 3), qb = e & 7, kvh = jj >> 2;
                        att::Desc d{YS + r0 * NYS + h * 64, NYS, YS + r0 * NYS + 384 + kvh * 64, NYS, nullptr, 0, YS + r0 * NYS + 512 + kvh * 64, NYS, AP + r0 * DM + h * 64, DM};
                        att::unit<64, 0>(d, qb * 256, (att::ATT_LAS_T)lds, nullptr, 0.f); }
#pragma unroll 1
                    for (int i = 0; i < 4; ++i) { const int e = jj * 4 + i, h = e >> 3, qb = e & 7;
                        att::Desc d{QC + r0 * 384 + h * 96, 384, KVC + r0 * 512 + h * 128, 512, YS + r0 * NYS + 1664, NYS, KVC + r0 * 512 + h * 128 + 64, 512, AP + r0 * DM + 768 + h * 64, DM};
                        att::unit<96, 0>(d, qb * 256, (att::ATT_LAS_T)lds, nullptr, 0.f); }
#pragma unroll 1
                    for (int i = 0; i < 6; ++i) { const int e = (jj & 3) * 6 + i, h = (jj >> 2) * 3 + (e >> 3), qb = e & 7, kvh = jj >> 2;
                        att::Desc d{YS + r0 * NYS + 640 + h * 64, NYS, YS + r0 * NYS + 1024 + kvh * 64, NYS, nullptr, 0, YS + r0 * NYS + 1152 + kvh * 64, NYS, AP + r0 * DM + 384 + h * 64, DM};
                        att::unit<64, 1>(d, qb * 256, (att::ATT_LAS_T)lds, biasT + h * 260, INP(11)[l * 6 + h] * LOG2E); }
                }
                if (k == 8 && PH_ON(7)) { PTRS  pg8::Gemm g{AP, (const bf16*)(wl + W_BR), DM, DM}; pg8::Order S; S.init(MTOK, DM, G, bx, 0, 1);
                  pg8::EpiBr E{YG, MG};
                  pg8::gemm_phase<pg8::EpiBr, pg8::Order, true, true>(ldsl, g, S, E); }
                if (k == 9 && PH_ON(8)) { PTRS  pg8::Gemm g{YG, (const bf16*)(wl + W_OUT), DM, DM}; pg8::Order S; S.init(MTOK, DM, G, bx, DM / 64, 0);
                  pg8::EpiRes E{X, X, ml + 5 * DM, AP, INP(21) + l * DM, ml + 7 * DM, rowss, ldsl + 131072 + 1024, 1.0f, 0};
                  pg8::gemm_phase<pg8::EpiRes, pg8::Order, true, true>(ldsl, g, S, E); }
            }
            if ((k == 1 || k == 11) && PH_ON(9)) { PTRS   pg8::Gemm g{AP, (const bf16*)(wl + (f ? W_GU2 : W_GU1)), DM, DM}; pg8::Order S; S.init(MTOK, NGU, G, bx, DM / 64, 0);
              pg8::EpiGU E{HB, rstdv, shw + (f ? 32 * NGU + 32 * NIN : 0)};
              pg8::gemm_phase<pg8::EpiGU, pg8::Order, true, true>(ldsl, g, S, E); }
            if ((k == 2 || k == 12) && PH_ON(10)) { PTRS  pg8::Gemm g{HB, (const bf16*)(wl + (f ? W_DN2 : W_DN1)), FF, FF}; pg8::Order S; S.init(MTOK, DM, G, bx, FF / 64, 0);
              const float* base = (l == 0 && f == 0) ? INP(0) : X;
              const bool has_next = !(l == 1 && f == 1);
              const float* ngain = f == 0 ? INP(7) + l * DM : INP(4) + (l + 1) * DM;
              const float* nsc = f == 0 ? ml + 4 * DM : ml + (size_t)NB * NMOD + 1 * DM;
              pg8::EpiRes E{base, X, ml + (f ? 8 : 2) * DM, has_next ? AP : nullptr, ngain, nsc, rowss, ldsl + 131072 + 1024, 0.5f, 0};
              pg8::gemm_phase<pg8::EpiRes, pg8::Order, true, true>(ldsl, g, S, E); }
        }
        GRID_BAR();
    }
    if (PH_ON(11)) {
        const int l = 0; PTRS
        const float* gain = INP(24);
        for (int m = gw; m < MTOK; m += 2 * NGW) {
            f32x4* xr0 = (f32x4*)(X + (size_t)m * DM) + lane; f32x4* xr1 = (f32x4*)(X + (size_t)(m + NGW) * DM) + lane; f32x4 v[2][4]; float s0 = 0.f, s1 = 0.f;
#pragma unroll
            for (int j = 0; j < 4; ++j) { v[0][j] = GL(f32x4, xr0 + 64 * j); v[1][j] = GL(f32x4, xr1 + 64 * j); }
#pragma unroll
            for (int j = 0; j < 4; ++j) { s0 += (v[0][j][0] * v[0][j][0] + v[0][j][1] * v[0][j][1]) + (v[0][j][2] * v[0][j][2] + v[0][j][3] * v[0][j][3]); s1 += (v[1][j][0] * v[1][j][0] + v[1][j][1] * v[1][j][1]) + (v[1][j][2] * v[1][j][2] + v[1][j][3] * v[1][j][3]); }
            const float r0 = 1.0f / sqrtf(wave_sum(s0) * (1.0f / 1024.0f) + EPS), r1 = 1.0f / sqrtf(wave_sum(s1) * (1.0f / 1024.0f) + EPS);
#pragma unroll
            for (int j = 0; j < 4; ++j) { const f32x4 g = GL(f32x4, gain + 4 * lane + 256 * j); GS(f32x4, xr0 + 64 * j) = v[0][j] * r0 * g; GS(f32x4, xr1 + 64 * j) = v[1][j] * r1 * g; }
        }
    }
}

extern "C" void kernel_launch(void* const* d_in, const int* in_sizes, int n_in, void* d_out, int out_size, void* d_ws, size_t ws_size, hipStream_t stream) {
    static int grid = 0;
    if (grid == 0) {
        if (n_in != 25 || out_size != MTOK * DM || ws_size < WS_END) { fprintf(stderr, "kernel_launch: unexpected shapes (n_in %d, out %d, ws %zu)\n", n_in, out_size, ws_size); grid = -1; return; }
        int dev = 0, cus = 0, per_cu = 0;
        hipGetDevice(&dev); hipDeviceGetAttribute(&cus, hipDeviceAttributeMultiprocessorCount, dev);
        if (hipFuncSetAttribute((const void*)mega_fwd, hipFuncAttributeMaxDynamicSharedMemorySize, LDS_BYTES) != hipSuccess) { fprintf(stderr, "kernel_launch: hipFuncSetAttribute failed\n"); grid = -1; return; }
        if (hipOccupancyMaxActiveBlocksPerMultiprocessor(&per_cu, (const void*)mega_fwd, NWAVES * 64, LDS_BYTES) != hipSuccess || per_cu < 1) { fprintf(stderr, "kernel_launch: occupancy query failed (%d)\n", per_cu); per_cu = 1; }
        (void)hipGetLastError();
        grid = cus * (per_cu > 1 ? 1 : per_cu);
        fprintf(stderr, "kernel_launch: grid %d (cus %d, per_cu %d)\n", grid, cus, per_cu);
    }
    if (grid < 0) return;
    if (hipMemsetAsync((char*)d_ws + WS_CTL, 0, CTL_BYTES, stream) != hipSuccess) { fprintf(stderr, "kernel_launch: memset failed\n"); return; }
    Args a{};
    for (int i = 0; i < 25; ++i) a.in[i] = (const float*)d_in[i];
    a.out = (float*)d_out; a.ws = (unsigned char*)d_ws;
    void* kargs[] = {&a};
    hipError_t e = hipLaunchCooperativeKernel((const void*)mega_fwd, dim3(grid), dim3(NWAVES * 64), kargs, LDS_BYTES, stream);
    if (e != hipSuccess) fprintf(stderr, "kernel_launch: cooperative launch failed: %s (grid %d)\n", hipGetErrorString(e), grid);
}
```

```cpp
#include <hip/hip_runtime.h>
#include <hip/hip_cooperative_groups.h>
#include <hip/hip_bf16.h>
#include <cstdio>
#include <cstdint>
#include <cmath>
namespace cg = cooperative_groups;
#define GL(T, p) (*(const __attribute__((address_space(1))) T*)(p))
#define GS(T, p) (*(__attribute__((address_space(1))) T*)(p))
#define GLB(T, base, boff) (*(const __attribute__((address_space(1))) T*)((const __attribute__((address_space(1))) char*)(base) + (unsigned)(boff)))
#define GSB(T, base, boff) (*(__attribute__((address_space(1))) T*)((__attribute__((address_space(1))) char*)(base) + (unsigned)(boff)))
__device__ __forceinline__ int lautid() { int t = threadIdx.x; asm volatile("" : "+v"(t)); return t; }
namespace pg8 {
#define PG8_LAS __attribute__((address_space(3)))
typedef unsigned short bf16_t;
typedef short bf16x8 __attribute__((ext_vector_type(8)));
typedef float f32x4 __attribute__((ext_vector_type(4)));
typedef unsigned u32x4 __attribute__((ext_vector_type(4)));
constexpr int BM = 256, BK = 64, HALF = 128, HTB = HALF * BK * 2  , STAGE_BYTES = 8 * HTB, NXCD = 8, WGM = 8;

__host__ __device__ __forceinline__ int lds_byte(int r, int c) { const int st = (r >> 4) * 2 + (c >> 5), rr = r & 15, cc = c & 31, ob = rr * 64 + cc * 2; return st * 1024 + (ob ^ (((ob >> 9) & 1) << 5)); }
__host__ __device__ __forceinline__ void stage_rc(int b, int& R, int& C) { const int st = b / 1024, sb = b % 1024, swz = sb ^ (((sb >> 9) & 1) << 5); R = (st >> 1) * 16 + swz / 64; C = (st & 1) * 32 + (swz % 64) / 2; }
__host__ __device__ __forceinline__ int perm32(int rho) { const int n = rho >> 4, i = rho & 15; return 8 * (i >> 2) + 4 * n + (i & 3); }

struct Unit { int pm, pn, k0, nt, br; };
struct Gemm { const bf16_t* A; const bf16_t* Bt; int lda, ldb; };

struct Order {
    int nM, nN, nwg, G, c, nt, mode;
    __device__ __forceinline__ void init(int M, int N, int G_, int c_, int nt_, int mode_) { nM = M / BM; nN = N / BM; nwg = nM * nN; G = G_; c = c_; nt = nt_; mode = mode_; asm volatile("" : "+s"(nt)); }
    __device__ __forceinline__ bool next(int i, Unit& u) const {
        const int ii = mode ? i / 3 : i;
        const int L = ii * G + c; if (L >= nwg) return false;
        int wgid = L; { const int q = nwg / NXCD, r = nwg % NXCD, xcd = wgid % NXCD, off = wgid / NXCD; wgid = (xcd < r ? xcd * (q + 1) : r * (q + 1) + (xcd - r) * q) + off; }
        const int nig = WGM * nN, gid = wgid / nig, fm = gid * WGM, gsz = (nM - fm) < WGM ? (nM - fm) : WGM;
        u.pm = fm + ((wgid % nig) % gsz); u.pn = (wgid % nig) / gsz;
        if (mode) { const int br = i - ii * 3; u.br = br; u.k0 = br * 384; u.nt = (br == 2) ? 4 : 6; } else { u.br = 0; u.k0 = 0; u.nt = nt; }
        return true;
    }
    __device__ __forceinline__ void a_ready(const Unit&) const {}
    __device__ __forceinline__ void done(const Unit&) const {}
};
typedef float f32x2_cv __attribute__((ext_vector_type(2))); typedef __bf16 bf16x2_cv __attribute__((ext_vector_type(2)));
__device__ __forceinline__ unsigned cvt_pk_bf16(float lo, float hi) { f32x2_cv v = {lo, hi}; bf16x2_cv b = __builtin_convertvector(v, bf16x2_cv); return __builtin_bit_cast(unsigned, b); }
template <class Epi, class Sched, bool ALIGN_EPI = false, bool SP2 = false>
__device__ __forceinline__ void gemm_phase(PG8_LAS unsigned char* lds, const Gemm g, const Sched& S, const Epi& E) {
    const int tid = lautid(), wid = __builtin_amdgcn_readfirstlane(tid >> 6), lane = tid & 63, wr = wid >> 2, wc = wid & 3, fr = lane & 15, fq = lane >> 4;
    int nt;
    unsigned voffA[2], voffB[2];
#pragma unroll
    for (int i = 0; i < 2; ++i) { int R, C; stage_rc(tid * 16 + i * 8192, R, C); const int Rb = Epi::PERM ? ((R & ~31) + perm32(R & 31)) : R;
        voffA[i] = (unsigned)(R * g.lda + C) * 2u; voffB[i] = (unsigned)(Rb * g.ldb + C) * 2u; }
    const size_t kstep = (size_t)(BK * 2);
    const size_t hstepA = (size_t)HALF * g.lda * 2, hstepB = (size_t)HALF * g.ldb * 2;
    const size_t tstepA = 2 * hstepA, tstepB = 2 * hstepB;
    const unsigned ldsw = (unsigned)wid * 1024u;
    const int aoff = lds_byte(wr * 64 + fr, fq * 8), boff = lds_byte(wc * 32 + fr, fq * 8);
#define PG8_SA(b, h) (((b) * 2 + (h)) * HTB)
#define PG8_SB(b, h) ((4 + (b) * 2 + (h)) * HTB)
#define PG8_STAGE(bufoff, gbase, voff) do { _Pragma("unroll") for (int _i = 0; _i < 2; ++_i) \
        __builtin_amdgcn_global_load_lds((const unsigned*)((const char*)(gbase) + (voff)[_i]), (PG8_LAS unsigned*)(lds + (bufoff) + ldsw + _i * 8192), 16, 0, 0); } while (0)
#define PG8_LDA(dst, b, h) do { _Pragma("unroll") for (int m = 0; m < 4; ++m) _Pragma("unroll") for (int k = 0; k < 2; ++k) dst[m][k] = *(const PG8_LAS bf16x8*)(lds + PG8_SA(b, h) + aoff + m * 2048 + k * 1024); } while (0)
#define PG8_LDB(dst, b, h) do { _Pragma("unroll") for (int n = 0; n < 2; ++n) _Pragma("unroll") for (int k = 0; k < 2; ++k) dst[n][k] = *(const PG8_LAS bf16x8*)(lds + PG8_SB(b, h) + boff + n * 2048 + k * 1024); } while (0)
#define PG8_MMA(ai, bj, At, Bt) do { __builtin_amdgcn_s_setprio(1); _Pragma("unroll") for (int m = 0; m < 4; ++m) _Pragma("unroll") for (int n = 0; n < 2; ++n) _Pragma("unroll") for (int k = 0; k < 2; ++k) \
        acc[ai][bj][m][n] = __builtin_amdgcn_mfma_f32_16x16x32_bf16(Bt[n][k], At[m][k], acc[ai][bj][m][n], 0, 0, 0); __builtin_amdgcn_s_setprio(0); } while (0)
#define PG8_WAIT_V(n) asm volatile("s_waitcnt vmcnt(" #n ")" ::: "memory")
#define PG8_WAIT_L(n) asm volatile("s_waitcnt lgkmcnt(" #n ")" ::: "memory")
#define PG8_BAR __builtin_amdgcn_s_barrier()
#define PG8_SCHED __builtin_amdgcn_sched_barrier(0)
    Unit cur, nxt; int ui = 0;
    if (!S.next(0, cur)) return;
    f32x4 acc[2][2][4][2];
#pragma unroll
    for (int a = 0; a < 2; ++a)
#pragma unroll
        for (int b = 0; b < 2; ++b)
#pragma unroll
            for (int m = 0; m < 4; ++m)
#pragma unroll
                for (int n = 0; n < 2; ++n) acc[a][b][m][n] = (f32x4){0.f, 0.f, 0.f, 0.f};
    bf16x8 At[4][2], B0[2][2], B1[2][2];
    const char* cA = (const char*)g.A + (size_t)cur.pm * tstepA + (size_t)cur.k0 * 2; const char* cB = (const char*)g.Bt + (size_t)cur.pn * tstepB + (size_t)cur.k0 * 2; nt = cur.nt;
    S.a_ready(cur);
    if constexpr (SP2) {
        PG8_STAGE(PG8_SB(0, 0), cB, voffB); PG8_STAGE(PG8_SB(0, 1), cB + hstepB, voffB); PG8_STAGE(PG8_SA(0, 0), cA, voffA); PG8_STAGE(PG8_SA(0, 1), cA + hstepA, voffA);
        if (wr == 1) PG8_BAR;
        PG8_WAIT_V(2); PG8_BAR;
        PG8_STAGE(PG8_SB(1, 0), cB + kstep, voffB); PG8_STAGE(PG8_SA(1, 0), cA + kstep, voffA); PG8_STAGE(PG8_SB(1, 1), cB + hstepB + kstep, voffB);
        PG8_WAIT_V(6); PG8_BAR;
    } else {
        PG8_STAGE(PG8_SB(0, 0), cB, voffB); PG8_STAGE(PG8_SA(0, 0), cA, voffA); PG8_STAGE(PG8_SB(0, 1), cB + hstepB, voffB); PG8_STAGE(PG8_SA(0, 1), cA + hstepA, voffA);
        if (wr == 1) PG8_BAR;
        PG8_WAIT_V(4); PG8_BAR;
        PG8_STAGE(PG8_SB(1, 0), cB + kstep, voffB); PG8_STAGE(PG8_SA(1, 0), cA + kstep, voffA); PG8_STAGE(PG8_SB(1, 1), cB + hstepB + kstep, voffB);
        PG8_WAIT_V(6); PG8_BAR;
    }
    for (;;) {
        const bool has_next = S.next(ui + 1, nxt);
        const char* nA = has_next ? (const char*)g.A + (size_t)nxt.pm * tstepA + (size_t)nxt.k0 * 2 : cA; const char* nB = has_next ? (const char*)g.Bt + (size_t)nxt.pn * tstepB + (size_t)nxt.k0 * 2 : cB;
        for (int t = 0; t < nt; t += 2) {
            const bool last = (t == nt - 2);
            const char* a1 = cA + (size_t)(t + 1) * kstep;
            const char* a2 = last ? nA : cA + (size_t)(t + 2) * kstep; const char* b2 = last ? nB : cB + (size_t)(t + 2) * kstep;
            const char* a3 = a2 + kstep; const char* b3 = b2 + kstep;
            if (last && has_next) S.a_ready(nxt);
            if constexpr (SP2) {
            PG8_LDB(B0, 0, 0); PG8_LDB(B1, 0, 1); PG8_SCHED; PG8_LDA(At, 0, 0); PG8_STAGE(PG8_SA(1, 1), a1 + hstepA, voffA);
            PG8_WAIT_V(8); PG8_WAIT_L(0); PG8_BAR; PG8_MMA(0, 0, At, B0); PG8_MMA(0, 1, At, B1); PG8_BAR; PG8_SCHED;
            PG8_LDA(At, 0, 1); PG8_STAGE(PG8_SB(0, 0), b2, voffB); PG8_STAGE(PG8_SB(0, 1), b2 + hstepB, voffB); PG8_STAGE(PG8_SA(0, 0), a2, voffA);
            PG8_WAIT_V(8); PG8_WAIT_L(0); PG8_BAR; PG8_MMA(1, 0, At, B0); PG8_MMA(1, 1, At, B1); PG8_BAR; PG8_SCHED;
            PG8_LDB(B0, 1, 0); PG8_LDB(B1, 1, 1); PG8_SCHED; PG8_LDA(At, 1, 0); PG8_STAGE(PG8_SA(0, 1), a2 + hstepA, voffA);
            PG8_WAIT_V(8); PG8_WAIT_L(0); PG8_BAR; PG8_MMA(0, 0, At, B0); PG8_MMA(0, 1, At, B1); PG8_BAR; PG8_SCHED;
            PG8_LDA(At, 1, 1); PG8_STAGE(PG8_SB(1, 0), b3, voffB); PG8_STAGE(PG8_SB(1, 1), b3 + hstepB, voffB); PG8_STAGE(PG8_SA(1, 0), a3, voffA);
            PG8_WAIT_V(8); PG8_WAIT_L(0); PG8_BAR; PG8_MMA(1, 0, At, B0); PG8_MMA(1, 1, At, B1); PG8_BAR; PG8_SCHED;
            } else {
            PG8_LDB(B0, 0, 0); PG8_SCHED; PG8_LDA(At, 0, 0); PG8_STAGE(PG8_SA(1, 1), a1 + hstepA, voffA);
            PG8_WAIT_L(8); PG8_BAR; PG8_WAIT_L(0); PG8_MMA(0, 0, At, B0); PG8_BAR; PG8_SCHED;
            PG8_LDB(B1, 0, 1); PG8_STAGE(PG8_SB(0, 0), b2, voffB);
            PG8_BAR; PG8_WAIT_L(0); PG8_MMA(0, 1, At, B1); PG8_BAR;
            PG8_LDA(At, 0, 1); PG8_STAGE(PG8_SA(0, 0), a2, voffA);
            PG8_BAR; PG8_WAIT_L(0); PG8_MMA(1, 0, At, B0); PG8_BAR; PG8_SCHED;
            PG8_STAGE(PG8_SB(0, 1), b2 + hstepB, voffB);
            PG8_WAIT_V(6); PG8_BAR; PG8_MMA(1, 1, At, B1); PG8_BAR;
            PG8_LDB(B0, 1, 0); PG8_SCHED; PG8_LDA(At, 1, 0); PG8_STAGE(PG8_SA(0, 1), a2 + hstepA, voffA);
            PG8_WAIT_L(8); PG8_BAR; PG8_WAIT_L(0); PG8_MMA(0, 0, At, B0); PG8_BAR; PG8_SCHED;
            PG8_LDB(B1, 1, 1); PG8_STAGE(PG8_SB(1, 0), b3, voffB);
            PG8_BAR; PG8_WAIT_L(0); PG8_MMA(0, 1, At, B1); PG8_BAR;
            PG8_LDA(At, 1, 1); PG8_STAGE(PG8_SA(1, 0), a3, voffA);
            PG8_BAR; PG8_WAIT_L(0); PG8_MMA(1, 0, At, B0); PG8_BAR; PG8_SCHED;
            PG8_STAGE(PG8_SB(1, 1), b3 + hstepB, voffB);
            PG8_WAIT_V(6); PG8_BAR; PG8_MMA(1, 1, At, B1); PG8_BAR;
            }
        }
        if constexpr (ALIGN_EPI) { if (wr == 0) PG8_BAR; }
        if constexpr (!Epi::AFTER_DRAIN) { E(acc, cur, wr, wc, fr, fq); S.done(cur); }
        if (!has_next) break;
#pragma unroll
        for (int a = 0; a < 2; ++a)
#pragma unroll
            for (int b = 0; b < 2; ++b)
#pragma unroll
                for (int m = 0; m < 4; ++m)
#pragma unroll
                    for (int n = 0; n < 2; ++n) acc[a][b][m][n] = (f32x4){0.f, 0.f, 0.f, 0.f};
        cur = nxt; cA = nA; cB = nB; ++ui; nt = cur.nt;
        if constexpr (ALIGN_EPI) { if (wr == 1) PG8_BAR; }
    }
    PG8_WAIT_V(0);
    if constexpr (!ALIGN_EPI) { if (wr == 0) PG8_BAR; }
    PG8_BAR;
    if constexpr (Epi::AFTER_DRAIN) { E.fused(acc, cur, wr, wc, fr, fq, lds, wid, lane); S.done(cur); }
#undef PG8_SA
#undef PG8_SB
#undef PG8_STAGE
#undef PG8_LDA
#undef PG8_LDB
#undef PG8_MMA
#undef PG8_WAIT_V
#undef PG8_WAIT_L
#undef PG8_BAR
#undef PG8_SCHED
}
}
constexpr int MTOK = 65536, DM = 1024, SEQ = 2048, NB = 32, FF = 2816, NGU = 5632, NIN = 4864, NYS = 1792, NMOD = 9216;
constexpr float EPS = 1e-6f, LOG2E = 1.4426950408889634f;
constexpr float C2A = 0.125f * LOG2E;
constexpr float C2C = 0.10206207261596575f * LOG2E;

namespace pg8 {
__device__ __forceinline__ float fsigmoid(float x) { return __builtin_amdgcn_rcpf(1.0f + __builtin_amdgcn_exp2f(-x * LOG2E)); }
__device__ __forceinline__ void load_rstd(const float* rstdv, int row0, float (&rs)[2][4]) {
#pragma unroll
    for (int ai = 0; ai < 2; ++ai)
#pragma unroll
        for (int m = 0; m < 4; ++m) rs[ai][m] = GL(float, rstdv + row0 + ai * HALF + m * 16);
}
struct EpiGU {
    static constexpr bool PERM = true, AFTER_DRAIN = false;
    bf16_t* H; const float* rowss; const float* shW;
    __device__ __forceinline__ void operator()(const f32x4 (&acc)[2][2][4][2], const Unit& u, int wr, int wc, int fr, int fq) const {
        const int row0 = u.pm * BM + wr * 64 + fr, b = u.pm >> 3;
        const int cg0 = u.pn * BM + wc * 32 + 8 * fq, hc = u.pn * HALF + wc * 32 + 8 * fq;
        f32x4 sg[2], su[2];
#pragma unroll
        for (int n = 0; n < 2; ++n) { sg[n] = GL(f32x4, shW + (size_t)b * NGU + cg0 + 4 * n); su[n] = GL(f32x4, shW + (size_t)b * NGU + cg0 + HALF + 4 * n); }
        float rs[2][4]; load_rstd(rowss, row0, rs);
#pragma unroll
        for (int ai = 0; ai < 2; ++ai)
#pragma unroll
            for (int m = 0; m < 4; ++m) {
                const float r = rs[ai][m]; float h[8];
#pragma unroll
                for (int n = 0; n < 2; ++n) { const f32x4 g = acc[ai][0][m][n] * r + sg[n], up = acc[ai][1][m][n] * r + su[n];
#pragma unroll
                    for (int j = 0; j < 4; ++j) h[4 * n + j] = g[j] * fsigmoid(g[j]) * up[j]; }
                u32x4 w; w.x = cvt_pk_bf16(h[0], h[1]); w.y = cvt_pk_bf16(h[2], h[3]); w.z = cvt_pk_bf16(h[4], h[5]); w.w = cvt_pk_bf16(h[6], h[7]);
                GS(u32x4, H + (size_t)(row0 + ai * HALF + m * 16) * FF + hc) = w;
            }
    }
};
struct EpiRes {
    static constexpr bool PERM = false, AFTER_DRAIN = false;
    const float* base; float* out; const float* gate; bf16_t* AP; const float* gain; const float* sc; float* rowss; PG8_LAS unsigned char* stg; float gscale; int pad;
    __device__ __forceinline__ void operator()(const f32x4 (&acc)[2][2][4][2], const Unit& u, int wr, int wc, int fr, int fq) const {
        typedef unsigned u32x2 __attribute__((ext_vector_type(2)));
        const unsigned row0 = u.pm * BM + wr * 64 + fr, b = u.pm >> 3, col0 = u.pn * BM + wc * 32 + 4 * fq;
        const int lane = fq * 16 + fr, r8 = lane >> 3, c8 = lane & 7;
        PG8_LAS float* st = (PG8_LAS float*)(stg + (wr * 4 + wc) * 2304);
        f32x4 gv[2][2], mu2[2];
#pragma unroll
        for (int bj = 0; bj < 2; ++bj) {
#pragma unroll
            for (int n = 0; n < 2; ++n) gv[bj][n] = GLB(f32x4, gate, (b * NMOD + col0 + bj * HALF + n * 16) * 4u) * gscale;
            const unsigned cb2 = u.pn * BM + bj * HALF + wc * 32 + 4 * c8;
            if (AP) mu2[bj] = GLB(f32x4, gain, cb2 * 4u) * (GLB(f32x4, sc, (b * NMOD + cb2) * 4u) + 1.0f); else mu2[bj] = (f32x4){0.f, 0.f, 0.f, 0.f};
        }
#pragma unroll
        for (int ai = 0; ai < 2; ++ai) {
            f32x4 xb[4][2][2];
#pragma unroll
            for (int m = 0; m < 4; ++m)
#pragma unroll
                for (int bj = 0; bj < 2; ++bj)
#pragma unroll
                    for (int n = 0; n < 2; ++n) xb[m][bj][n] = GLB(f32x4, base, ((row0 + ai * HALF + m * 16) * DM + col0 + bj * HALF + n * 16) * 4u);
#pragma unroll
            for (int m = 0; m < 4; ++m) {
                const unsigned row = row0 + ai * HALF + m * 16, rowb = u.pm * BM + wr * 64 + ai * HALF + m * 16; float ss = 0.f;
#pragma unroll
                for (int bj = 0; bj < 2; ++bj) {
#pragma unroll
                    for (int n = 0; n < 2; ++n) { const f32x4 x = xb[m][bj][n] + gv[bj][n] * acc[ai][bj][m][n];
                        ss += (x[0] * x[0] + x[1] * x[1]) + (x[2] * x[2] + x[3] * x[3]);
                        *(PG8_LAS f32x4*)(st + fr * 36 + n * 16 + fq * 4) = x; }
                    asm volatile("s_waitcnt lgkmcnt(0)" ::: "memory");
#pragma unroll
                    for (int h = 0; h < 2; ++h) { const f32x4 v = *(const PG8_LAS f32x4*)(st + (h * 8 + r8) * 36 + c8 * 4);
                        const unsigned off = (rowb + h * 8 + r8) * DM + u.pn * BM + bj * HALF + wc * 32 + 4 * c8;
                        GSB(f32x4, out, off * 4u) = v;
                        if (AP) { const f32x4 y = v * mu2[bj]; u32x2 w; w.x = cvt_pk_bf16(y[0], y[1]); w.y = cvt_pk_bf16(y[2], y[3]); GSB(u32x2, AP, off * 2u) = w; } }
                    asm volatile("s_waitcnt lgkmcnt(0)" ::: "memory");
                }
                ss += __shfl_xor(ss, 16); ss += __shfl_xor(ss, 32);
                if (fq == 0) GSB(float, rowss, (row * 16 + u.pn * 4 + wc) * 4u) = ss;
            }
        }
    }
};
struct EpiIn {
    static constexpr bool PERM = true, AFTER_DRAIN = false;
    bf16_t* YS; bf16_t* YG; const float* rowss; const float* shW; PG8_LAS unsigned char* stg;
    __device__ __forceinline__ void operator()(const f32x4 (&acc)[2][2][4][2], const Unit& u, int wr, int wc, int fr, int fq) const {
        const int row0 = u.pm * BM + wr * 64 + fr, b = u.pm >> 3;
        const int lane = fq * 16 + fr, r8 = lane >> 3, c8 = lane & 7;
        PG8_LAS unsigned char* st = stg + (wr * 4 + wc) * 2304;
        float rs[2][4]; load_rstd(rowss, row0, rs);
        const bool gates = u.pn >= 7;
        f32x4 sh[2][2]; float scale[2];
#pragma unroll
        for (int bj = 0; bj < 2; ++bj) { const int cg = u.pn * BM + 64 * wc + 32 * bj;
            scale[bj] = (!gates && cg >= 640 && cg < 1024) ? C2A : 1.0f;
#pragma unroll
            for (int n = 0; n < 2; ++n) sh[bj][n] = GL(f32x4, shW + (size_t)b * NIN + cg + 8 * fq + 4 * n); }
        bf16_t* dst; unsigned ld;
        if (gates) { dst = YG + (size_t)((u.pn - 7) >> 2) * ((size_t)MTOK * DM) + ((u.pn - 7) & 3) * BM + 64 * wc + 8 * c8; ld = DM; }
        else { dst = YS + u.pn * BM + 64 * wc + 8 * c8; ld = NYS; }
        const unsigned rowa = u.pm * BM + wr * 64;
        if (gates) body<true>(acc, rs, sh, scale, st, dst, ld, rowa, fr, fq, r8, c8); else body<false>(acc, rs, sh, scale, st, dst, ld, rowa, fr, fq, r8, c8);
    }
    template <bool GATES> __device__ __forceinline__ void body(const f32x4 (&acc)[2][2][4][2], const float (&rs)[2][4], const f32x4 (&sh)[2][2], const float (&scale)[2], PG8_LAS unsigned char* st,
                                                                bf16_t* dst, unsigned ld, unsigned rowa, int fr, int fq, int r8, int c8) const {
#pragma unroll
        for (int ai = 0; ai < 2; ++ai)
#pragma unroll
            for (int m = 0; m < 4; ++m) {
                const float r = rs[ai][m];
#pragma unroll
                for (int bj = 0; bj < 2; ++bj) { float h[8];
#pragma unroll
                    for (int n = 0; n < 2; ++n) { const f32x4 v = acc[ai][bj][m][n] * r + sh[bj][n];
#pragma unroll
                        for (int j = 0; j < 4; ++j) h[4 * n + j] = GATES ? fsigmoid(v[j]) : v[j] * scale[bj]; }
                    u32x4 w; w.x = cvt_pk_bf16(h[0], h[1]); w.y = cvt_pk_bf16(h[2], h[3]); w.z = cvt_pk_bf16(h[4], h[5]); w.w = cvt_pk_bf16(h[6], h[7]);
                    *(PG8_LAS u32x4*)(st + fr * 144 + bj * 64 + fq * 16) = w; }
                asm volatile("s_waitcnt lgkmcnt(0)" ::: "memory");
#pragma unroll
                for (int h2 = 0; h2 < 2; ++h2) { const u32x4 w = *(const PG8_LAS u32x4*)(st + (h2 * 8 + r8) * 144 + c8 * 16);
                    GS(u32x4, dst + (size_t)(rowa + ai * HALF + m * 16 + h2 * 8 + r8) * ld) = w; }
                asm volatile("s_waitcnt lgkmcnt(0)" ::: "memory");
            }
    }
};
struct EpiQup {
    static constexpr bool PERM = false, AFTER_DRAIN = false;
    bf16_t* QC; const float* cs; const float* sn;
    __device__ __forceinline__ void operator()(const f32x4 (&acc)[2][2][4][2], const Unit& u, int wr, int wc, int fr, int fq) const {
        typedef unsigned u32x2 __attribute__((ext_vector_type(2)));
        const int row0 = u.pm * BM + wr * 64 + fr;
#pragma unroll
        for (int bj = 0; bj < 2; ++bj) {
            const int cb = u.pn * BM + bj * HALF + wc * 32;
            if (cb >= 384) continue;
            const bool rope = (cb % 96) == 64;
#pragma unroll
            for (int ai = 0; ai < 2; ++ai)
#pragma unroll
                for (int m = 0; m < 4; ++m) {
                    const int row = row0 + ai * HALF + m * 16, t = row & (SEQ - 1);
                    f32x4 x0 = acc[ai][bj][m][0], x1 = acc[ai][bj][m][1];
                    if (rope) { const f32x4 c = GL(f32x4, cs + t * 16 + 4 * fq), s = GL(f32x4, sn + t * 16 + 4 * fq);
                        const f32x4 y0 = x0 * c - x1 * s, y1 = x0 * s + x1 * c; x0 = y0; x1 = y1; }
                    x0 = x0 * C2C; x1 = x1 * C2C;
                    u32x2 w0, w1; w0.x = cvt_pk_bf16(x0[0], x0[1]); w0.y = cvt_pk_bf16(x0[2], x0[3]); w1.x = cvt_pk_bf16(x1[0], x1[1]); w1.y = cvt_pk_bf16(x1[2], x1[3]);
                    bf16_t* d = QC + (size_t)row * 384 + cb + 4 * fq;
                    *(u32x2*)d = w0; GS(u32x2, d + 16) = w1;
                }
        }
    }
};
struct EpiPlain {
    static constexpr bool PERM = true, AFTER_DRAIN = false;
    bf16_t* O; int ldc;
    __device__ __forceinline__ void operator()(const f32x4 (&acc)[2][2][4][2], const Unit& u, int wr, int wc, int fr, int fq) const {
        const int row0 = u.pm * BM + wr * 64 + fr, col0 = u.pn * BM + wc * 32 + 8 * fq;
#pragma unroll
        for (int ai = 0; ai < 2; ++ai)
#pragma unroll
            for (int m = 0; m < 4; ++m)
#pragma unroll
                for (int bj = 0; bj < 2; ++bj) { const f32x4 v0 = acc[ai][bj][m][0], v1 = acc[ai][bj][m][1];
                    u32x4 w; w.x = cvt_pk_bf16(v0[0], v0[1]); w.y = cvt_pk_bf16(v0[2], v0[3]); w.z = cvt_pk_bf16(v1[0], v1[1]); w.w = cvt_pk_bf16(v1[2], v1[3]);
                    GS(u32x4, O + (size_t)(row0 + ai * HALF + m * 16) * ldc + col0 + bj * HALF) = w; asm volatile("" ::: "memory"); }
    }
};
struct EpiBr {
    static constexpr bool PERM = true, AFTER_DRAIN = false;
    bf16_t* YG; float* MG;
    __device__ __forceinline__ void operator()(const f32x4 (&acc)[2][2][4][2], const Unit& u, int wr, int wc, int fr, int fq) const {
        const unsigned row0 = u.pm * BM + wr * 64 + fr, col0 = u.pn * BM + wc * 32 + 8 * fq;
        const bf16_t* G = YG + (size_t)u.br * ((size_t)MTOK * DM);
#pragma unroll
        for (int ai = 0; ai < 2; ++ai) {
            u32x4 gw[4][2], mw[4][2];
#pragma unroll
            for (int m = 0; m < 4; ++m)
#pragma unroll
                for (int bj = 0; bj < 2; ++bj) { const unsigned off = ((row0 + ai * HALF + m * 16) * DM + col0 + bj * HALF) * 2u;
                    gw[m][bj] = GLB(u32x4, G, off); mw[m][bj] = (u.br > 0) ? GLB(u32x4, YG, off) : (u32x4){0u, 0u, 0u, 0u}; }
#pragma unroll
            for (int m = 0; m < 4; ++m)
#pragma unroll
                for (int bj = 0; bj < 2; ++bj) { const unsigned off = ((row0 + ai * HALF + m * 16) * DM + col0 + bj * HALF) * 2u;
                    const u32x4 g = gw[m][bj], r = mw[m][bj]; f32x4 g0, g1, r0, r1;
                    g0[0] = __uint_as_float(g.x << 16); g0[1] = __uint_as_float(g.x & 0xffff0000u); g0[2] = __uint_as_float(g.y << 16); g0[3] = __uint_as_float(g.y & 0xffff0000u);
                    g1[0] = __uint_as_float(g.z << 16); g1[1] = __uint_as_float(g.z & 0xffff0000u); g1[2] = __uint_as_float(g.w << 16); g1[3] = __uint_as_float(g.w & 0xffff0000u);
                    r0[0] = __uint_as_float(r.x << 16); r0[1] = __uint_as_float(r.x & 0xffff0000u); r0[2] = __uint_as_float(r.y << 16); r0[3] = __uint_as_float(r.y & 0xffff0000u);
                    r1[0] = __uint_as_float(r.z << 16); r1[1] = __uint_as_float(r.z & 0xffff0000u); r1[2] = __uint_as_float(r.w << 16); r1[3] = __uint_as_float(r.w & 0xffff0000u);
                    const f32x4 v0 = acc[ai][bj][m][0] * g0 + r0, v1 = acc[ai][bj][m][1] * g1 + r1;
                    u32x4 w; w.x = cvt_pk_bf16(v0[0], v0[1]); w.y = cvt_pk_bf16(v0[2], v0[3]); w.z = cvt_pk_bf16(v1[0], v1[1]); w.w = cvt_pk_bf16(v1[2], v1[3]); GSB(u32x4, YG, off) = w; }
        }
    }
};
}
namespace att {
using bf16 = unsigned short;
using bf16x8 = __attribute__((ext_vector_type(8))) short;
using s16x4 = __attribute__((ext_vector_type(4))) short;
using f32x16 = __attribute__((ext_vector_type(16))) float;
using u32x4 = __attribute__((ext_vector_type(4))) unsigned;
constexpr int LDS_K = 0, KSLOT_MAX = 12288, LDS_V = 2 * KSLOT_MAX, LDS_WS = LDS_V + 2 * 8192, LDS_BIAS = LDS_WS + 2048, LDS_OST = LDS_BIAS + 2048, LDS_BYTES = LDS_OST + 8 * 4096;
__device__ __forceinline__ int crow(int r, int hi) { return (r & 3) + 8 * (r >> 2) + 4 * hi; }
__device__ __forceinline__ void glds16(const void* gsrc, unsigned lds_dst) { unsigned keep;
    asm volatile("s_mov_b32 %0, m0\n\ts_mov_b32 m0, %2\n\ts_nop 0\n\tglobal_load_lds_dwordx4 %1, off\n\ts_mov_b32 m0, %0" : "=&s"(keep) : "v"(gsrc), "s"(lds_dst) : "memory"); }
typedef float f32x2_t __attribute__((ext_vector_type(2))); typedef __bf16 bf16x2_t __attribute__((ext_vector_type(2)));
__device__ __forceinline__ unsigned cvtpk_s(float lo, float hi) { f32x2_t v = {lo, hi}; bf16x2_t b = __builtin_convertvector(v, bf16x2_t); return __builtin_bit_cast(unsigned, b); }
typedef __attribute__((address_space(3))) char* ATT_LAS_T;
__device__ __forceinline__ float max3f(float a, float b, float c) { float r; asm("v_max3_f32 %0, %1, %2, %3" : "=v"(r) : "v"(a), "v"(b), "v"(c)); return r; }
__device__ __forceinline__ float max2f(float a, float b) { float r; asm("v_max_f32_e32 %0, %1, %2" : "=v"(r) : "v"(a), "v"(b)); return r; }
struct Desc { const bf16* Q; int ldq; const bf16* K0; int ldk0; const bf16* K1; int ldk1; const bf16* V; int ldv; bf16* O; int ldo; };

__device__ __forceinline__ void pv(f32x16* o, int vb, bf16x8 pa0, bf16x8 pa1, bf16x8 pa2, bf16x8 pa3) {
#pragma unroll
    for (int d0 = 0; d0 < 2; ++d0) { s16x4 lo[4], hi[4];
#pragma unroll
        for (int ks = 0; ks < 4; ++ks) {
            asm volatile("ds_read_b64_tr_b16 %0,%1 offset:%c2" : "=&v"(lo[ks]) : "v"(vb), "i"(d0 * 4096 + ks * 1024) : "memory");
            asm volatile("ds_read_b64_tr_b16 %0,%1 offset:%c2" : "=&v"(hi[ks]) : "v"(vb), "i"(d0 * 4096 + ks * 1024 + 512) : "memory"); }
        asm volatile("s_waitcnt lgkmcnt(0)" ::: "memory"); __builtin_amdgcn_sched_barrier(0);
#define ATT_PK(k) (bf16x8){lo[k][0], lo[k][1], lo[k][2], lo[k][3], hi[k][0], hi[k][1], hi[k][2], hi[k][3]}
        o[d0] = __builtin_amdgcn_mfma_f32_32x32x16_bf16(pa0, ATT_PK(0), o[d0], 0, 0, 0);
        o[d0] = __builtin_amdgcn_mfma_f32_32x32x16_bf16(pa1, ATT_PK(1), o[d0], 0, 0, 0);
        o[d0] = __builtin_amdgcn_mfma_f32_32x32x16_bf16(pa2, ATT_PK(2), o[d0], 0, 0, 0);
        o[d0] = __builtin_amdgcn_mfma_f32_32x32x16_bf16(pa3, ATT_PK(3), o[d0], 0, 0, 0);
#undef ATT_PK
    }
}
#define ATT_LAS __attribute__((address_space(3)))
template <int DQK, int MODE, bool FIXREF = false> __device__ __forceinline__ void unit(const Desc& d, int q0, ATT_LAS char* shm, const float* biasg, float sinkl2) {
    constexpr int NCH = DQK / 8, KSLOT = DQK * 128, ND0 = DQK / 16; constexpr float THR = 8.0f, NEGBIG = -1e30f;
    const int tid = lautid(), lane = tid & 63, r32 = lane & 31, hi = lane >> 5; const int wid = __builtin_amdgcn_readfirstlane(tid >> 6);
    const unsigned lds0 = (unsigned)(uintptr_t)shm;
    ATT_LAS float* wsf = (ATT_LAS float*)(shm + LDS_WS) + wid * 64;
    ATT_LAS float* bias_l = (ATT_LAS float*)(shm + LDS_BIAS);
    const int qw = q0 + wid * 32;
    int t0 = 0, t1 = 32, wt0 = 0, wt1 = 32;
    if (MODE == 1) { t0 = q0 >= 128 ? (q0 - 128) >> 6 : 0; t1 = ((q0 + 383) >> 6) + 1; if (t1 > 32) t1 = 32;
                     wt0 = qw >= 128 ? (qw - 128) >> 6 : 0; wt1 = ((qw + 159) >> 6) + 1; if (wt1 > 32) wt1 = 32; }
#define ATT_DMA(t, bsel) do { \
        _Pragma("unroll") for (int c_ = 0; c_ < 2; ++c_) { const int ch_ = wid + 8 * c_; if (ch_ < NCH) { \
            const bf16* s_ = (ch_ < 8) ? d.K0 + (size_t)((t) * 64 + lane) * d.ldk0 + ch_ * 8 : d.K1 + (size_t)((t) * 64 + lane) * d.ldk1 + (ch_ - 8) * 8; \
            glds16(s_, (unsigned)__builtin_amdgcn_readfirstlane(lds0 + LDS_K + (bsel) * KSLOT + ch_ * 1024)); } } \
        { const bf16* v_ = d.V + (size_t)((t) * 64 + 16 * (wid & 3) + (lane >> 2)) * d.ldv + (wid >> 2) * 32 + (lane & 3) * 8; \
          glds16(v_, (unsigned)__builtin_amdgcn_readfirstlane(lds0 + LDS_V + (bsel) * 8192 + wid * 1024)); } } while (0)
    if (MODE == 1) { const int idx = tid - 128; bias_l[tid] = (idx >= 0 && idx <= 256) ? biasg[idx] : NEGBIG; }
    ATT_DMA(t0, 0);
    bf16x8 qr[ND0];
    { const bf16* Qw = d.Q + (size_t)(qw + r32) * d.ldq + hi * 8;
#pragma unroll
      for (int d0 = 0; d0 < ND0; ++d0) qr[d0] = GL(bf16x8, Qw + d0 * 16); }
    float mhat = 0.f, l_reg = 0.f; f32x16 o[2]; o[0] = f32x16{}; o[1] = f32x16{}; f32x16 negm = f32x16{};
    if (FIXREF) { mhat = sinkl2;
#pragma unroll
        for (int r = 0; r < 16; ++r) negm[r] = -sinkl2; }
    constexpr bool MSUM = true;
    f32x16 lacc = f32x16{}; const bf16x8 ones8 = (bf16x8){0x3f80, 0x3f80, 0x3f80, 0x3f80, 0x3f80, 0x3f80, 0x3f80, 0x3f80};
    const int vb0 = (int)(lds0 + LDS_V) + ((lane >> 4) & 1) * 32 + (lane & 3) * 8 + (4 * hi + ((lane & 15) >> 2)) * 64;
    int buf = 0;
    for (int t = t0; t < t1; ++t) {
        asm volatile("s_waitcnt vmcnt(0) lgkmcnt(0)\n\ts_barrier" ::: "memory");
        if (t + 1 < t1) ATT_DMA(t + 1, buf ^ 1);
        const bool active = (MODE == 0) || (t >= wt0 && t < wt1);
        if (active) {
            f32x16 p0, p1;
            { const ATT_LAS char* kb = shm + LDS_K + buf * KSLOT + hi * 1024 + r32 * 16;
#pragma unroll
              for (int d0 = 0; d0 < ND0; ++d0) {
                  const bf16x8 b0 = *(const ATT_LAS bf16x8*)(kb + d0 * 2048);
                  const bf16x8 b1 = *(const ATT_LAS bf16x8*)(kb + d0 * 2048 + 512);
                  if (d0 == 0) { p0 = __builtin_amdgcn_mfma_f32_32x32x16_bf16(b0, qr[0], negm, 0, 0, 0); p1 = __builtin_amdgcn_mfma_f32_32x32x16_bf16(b1, qr[0], negm, 0, 0, 0); }
                  else { p0 = __builtin_amdgcn_mfma_f32_32x32x16_bf16(b0, qr[d0], p0, 0, 0, 0); p1 = __builtin_amdgcn_mfma_f32_32x32x16_bf16(b1, qr[d0], p1, 0, 0, 0); } } }
            if (MODE == 1) {
                const ATT_LAS float* bp = bias_l + (64 * t - (qw + r32) + 256 + 4 * hi);
#pragma unroll
                for (int r = 0; r < 16; ++r) { p0[r] += bp[(r & 3) + 8 * (r >> 2)]; p1[r] += bp[(r & 3) + 8 * (r >> 2) + 32]; }
            }
            if (!FIXREF) {
            asm volatile("s_nop 15\n\ts_nop 7" : "+v"(p0), "+v"(p1));
            float rm, rmb;
            rm = max3f(p0[0], p0[1], p1[0]); rmb = max3f(p0[2], p0[3], p1[1]); rm = max3f(rm, p1[2], p1[3]);
#pragma unroll
            for (int r = 4; r < 16; r += 4) { rm = max3f(rm, p0[r], p0[r + 1]); rmb = max3f(rmb, p0[r + 2], p0[r + 3]); rm = max3f(rm, p1[r], p1[r + 1]); rmb = max3f(rmb, p1[r + 2], p1[r + 3]); }
            rm = max2f(rm, rmb);
            { auto rr = __builtin_amdgcn_permlane32_swap(__float_as_uint(rm), __float_as_uint(rm), false, false); rm = max2f(__uint_as_float(rr[0]), __uint_as_float(rr[1])); }
            const bool first = (t == wt0);
            if (first) {
                mhat = rm;
#pragma unroll
                for (int r = 0; r < 16; ++r) { p0[r] -= rm; p1[r] -= rm; }
#pragma unroll
                for (int r = 0; r < 16; ++r) negm[r] = -mhat;
            } else if (__any(rm > THR)) {
                const float dl = fmaxf(rm, 0.f); mhat += dl;
#pragma unroll
                for (int r = 0; r < 16; ++r) { p0[r] -= dl; p1[r] -= dl; }
#pragma unroll
                for (int r = 0; r < 16; ++r) negm[r] = -mhat;
                const float f = __builtin_amdgcn_exp2f(-dl); l_reg *= f; if (hi == 0) wsf[r32] = f;
                asm volatile("s_waitcnt lgkmcnt(0)" ::: "memory");
#pragma unroll
                for (int d_ = 0; d_ < 2; ++d_)
#pragma unroll
                    for (int r = 0; r < 16; ++r) o[d_][r] *= wsf[crow(r, hi)];
                if (MSUM) {
#pragma unroll
                    for (int r = 0; r < 16; ++r) lacc[r] *= wsf[crow(r, hi)];
                }
                asm volatile("s_waitcnt lgkmcnt(0)" ::: "memory");
            }
            }
            if (MSUM) {
#pragma unroll
                for (int r = 0; r < 16; ++r) { p0[r] = __builtin_amdgcn_exp2f(p0[r]); p1[r] = __builtin_amdgcn_exp2f(p1[r]); }
            } else {
                float sacc = 0.f;
#pragma unroll
                for (int r = 0; r < 16; ++r) { p0[r] = __builtin_amdgcn_exp2f(p0[r]); p1[r] = __builtin_amdgcn_exp2f(p1[r]); sacc += p0[r] + p1[r]; }
                l_reg += sacc;
            }
            u32x4 pw0, pw1, pw2, pw3;
            pw0 = (u32x4){cvtpk_s(p0[0], p0[1]), cvtpk_s(p0[2], p0[3]), cvtpk_s(p0[4], p0[5]), cvtpk_s(p0[6], p0[7])};
            pw1 = (u32x4){cvtpk_s(p0[8], p0[9]), cvtpk_s(p0[10], p0[11]), cvtpk_s(p0[12], p0[13]), cvtpk_s(p0[14], p0[15])};
            pw2 = (u32x4){cvtpk_s(p1[0], p1[1]), cvtpk_s(p1[2], p1[3]), cvtpk_s(p1[4], p1[5]), cvtpk_s(p1[6], p1[7])};
            pw3 = (u32x4){cvtpk_s(p1[8], p1[9]), cvtpk_s(p1[10], p1[11]), cvtpk_s(p1[12], p1[13]), cvtpk_s(p1[14], p1[15])};
            pv(o, vb0 + buf * 8192, __builtin_bit_cast(bf16x8, pw0), __builtin_bit_cast(bf16x8, pw1), __builtin_bit_cast(bf16x8, pw2), __builtin_bit_cast(bf16x8, pw3));
            if (MSUM) {
                lacc = __builtin_amdgcn_mfma_f32_32x32x16_bf16(__builtin_bit_cast(bf16x8, pw0), ones8, lacc, 0, 0, 0);
                lacc = __builtin_amdgcn_mfma_f32_32x32x16_bf16(__builtin_bit_cast(bf16x8, pw1), ones8, lacc, 0, 0, 0);
                lacc = __builtin_amdgcn_mfma_f32_32x32x16_bf16(__builtin_bit_cast(bf16x8, pw2), ones8, lacc, 0, 0, 0);
                lacc = __builtin_amdgcn_mfma_f32_32x32x16_bf16(__builtin_bit_cast(bf16x8, pw3), ones8, lacc, 0, 0, 0);
            }
        }
        buf ^= 1;
    }
    float rli[16];
    if (MSUM) {
        if (MODE == 1) { if (hi == 0) wsf[32 + r32] = __builtin_amdgcn_exp2f(sinkl2 - mhat); asm volatile("s_waitcnt lgkmcnt(0)" ::: "memory"); }
#pragma unroll
        for (int r = 0; r < 16; ++r) rli[r] = __builtin_amdgcn_rcpf(lacc[r] + (MODE == 1 ? wsf[32 + crow(r, hi)] : 0.f));
    } else {
        { auto rr = __builtin_amdgcn_permlane32_swap(__float_as_uint(l_reg), __float_as_uint(l_reg), false, false); l_reg = __uint_as_float(rr[0]) + __uint_as_float(rr[1]); }
        if (MODE == 1) l_reg += __builtin_amdgcn_exp2f(sinkl2 - mhat);
        if (hi == 0) wsf[32 + r32] = l_reg; asm volatile("s_waitcnt lgkmcnt(0)" ::: "memory");
#pragma unroll
        for (int r = 0; r < 16; ++r) rli[r] = __builtin_amdgcn_rcpf(wsf[32 + crow(r, hi)]);
    }
    bf16* Ow = d.O + (size_t)qw * d.ldo;
    { ATT_LAS bf16* stg = (ATT_LAS bf16*)(shm + LDS_OST) + wid * 2048;
#pragma unroll
      for (int r = 0; r < 16; ++r) { const int orow = crow(r, hi);
#pragma unroll
          for (int d0 = 0; d0 < 2; ++d0) { const unsigned w = cvtpk_s(o[d0][r] * rli[r], 0.f); stg[orow * 64 + d0 * 32 + r32] = (bf16)(w & 0xffffu); } }
      asm volatile("s_waitcnt lgkmcnt(0)" ::: "memory");
#pragma unroll
      for (int i = 0; i < 4; ++i) { const int row = i * 8 + (lane >> 3), ch = lane & 7; const u32x4 v = *(const ATT_LAS u32x4*)(stg + row * 64 + ch * 8); GS(u32x4, Ow + (size_t)row * d.ldo + ch * 8) = v; } }
    asm volatile("s_waitcnt lgkmcnt(0)\n\ts_barrier" ::: "memory");
#undef ATT_DMA
}
}
#define GAS __attribute__((address_space(1)))
#define LAS __attribute__((address_space(3)))
typedef unsigned short bf16;
typedef unsigned v4u __attribute__((ext_vector_type(4)));
typedef float f32x4 __attribute__((ext_vector_type(4)));
typedef float f32x16 __attribute__((ext_vector_type(16)));
constexpr int NWAVES = 8;
constexpr int LDS_BYTES = 155648;
constexpr size_t MiB = 1u << 20;
constexpr size_t WS_MODS = 0;
constexpr size_t WS_SHW = 3 * MiB;
constexpr size_t SHW_L = (size_t)32 * (NGU + NIN + NGU) * 4;
constexpr size_t WS_ROWSS = 8 * MiB;
constexpr size_t WS_RSTD = 13 * MiB;
constexpr size_t WS_CS = 12 * MiB, WS_SN = WS_CS + 131072;
constexpr size_t WS_BIAS = WS_SN + 131072;
constexpr size_t WS_CTL = 15 * MiB, CTL_BYTES = 16384;
constexpr size_t WS_W = 16 * MiB, W_LAYER = 48 * MiB;
constexpr size_t W_GU1 = 0, W_DN1 = 11 * MiB, W_GU2 = W_DN1 + 5632 * 1024, W_DN2 = W_GU2 + 11 * MiB, W_IN = 33 * MiB, W_QUP = W_IN + (size_t)NIN * 1024 * 2, W_KVUP = W_QUP + 262144, W_BR = 43 * MiB, W_OUT = 45 * MiB;
constexpr size_t WS_AP = 112 * MiB;
constexpr size_t WS_YS = 240 * MiB;
constexpr size_t WS_QC = 464 * MiB;
constexpr size_t WS_KVC = 512 * MiB;
constexpr size_t WS_YG = 576 * MiB;
constexpr size_t WS_H = 240 * MiB;
constexpr size_t WS_MG = 240 * MiB;
constexpr size_t WS_END = 960 * MiB;
static_assert(W_DN2 + 5632 * 1024 <= W_IN && W_KVUP + 131072 <= W_BR && W_OUT + 2 * MiB <= W_LAYER && WS_W + 2 * W_LAYER <= WS_AP, "weight map");
static_assert(WS_H + (size_t)MTOK * FF * 2 <= WS_YG + 3 * (size_t)MTOK * DM * 2 && WS_MG + (size_t)MTOK * DM * 4 <= WS_KVC && WS_SHW + 2 * SHW_L <= WS_ROWSS, "ws map");

struct Args { const float* in[25]; float* out; unsigned char* ws; };
__device__ __forceinline__ int lauint(int k) { asm volatile("" : "+s"(k)); return k; }
__device__ __forceinline__ unsigned char* lau(unsigned char* p) { asm volatile("" : "+s"(p)); return p; }

__device__ __forceinline__ unsigned f2bf(float f) { unsigned u = __builtin_bit_cast(unsigned, f); return (u + 0x7fffu + ((u >> 16) & 1u)) >> 16; }
__device__ __forceinline__ unsigned pk2(float lo, float hi) { return f2bf(lo) | (f2bf(hi) << 16); }
__device__ __forceinline__ float bflo(unsigned w) { return __uint_as_float(w << 16); }
__device__ __forceinline__ float bfhi(unsigned w) { return __uint_as_float(w & 0xffff0000u); }
__device__ __forceinline__ float wave_sum(float v) {
#pragma unroll
    for (int o = 1; o < 64; o <<= 1) v += __shfl_xor(v, o);
    return v;
}
__device__ __forceinline__ void tr_item(const float* W, int N, int k0, int n0, bf16* WT, int ldk, int drow0, int dk0, const float* kscale, LAS float* scr, int lane) {
    { const int rr = lane >> 3, c4 = lane & 7;
      f32x4 v[8];
#pragma unroll
      for (int i = 0; i < 8; ++i) v[i] = GL(f32x4, W + (size_t)(k0 + i * 8 + rr) * N + n0 + 4 * c4);
#pragma unroll
      for (int i = 0; i < 8; ++i) { const int kk = i * 8 + rr; f32x4 x = v[i]; if (kscale) x = x * kscale[k0 + kk];
          scr[kk * 33 + 4 * c4 + 0] = x[0]; scr[kk * 33 + 4 * c4 + 1] = x[1]; scr[kk * 33 + 4 * c4 + 2] = x[2]; scr[kk * 33 + 4 * c4 + 3] = x[3]; } }
    asm volatile("s_waitcnt lgkmcnt(0)" ::: "memory");
    const int c = lane & 7;
#pragma unroll
    for (int j = 0; j < 4; ++j) { const int n = (lane >> 3) + 8 * j; const LAS float* s = scr + (8 * c) * 33 + n;
        v4u o; o.x = pk2(s[0 * 33], s[1 * 33]); o.y = pk2(s[2 * 33], s[3 * 33]); o.z = pk2(s[4 * 33], s[5 * 33]); o.w = pk2(s[6 * 33], s[7 * 33]);
        GS(v4u, WT + (size_t)(drow0 + n) * ldk + dk0 + k0 + 8 * c) = o; }
    asm volatile("s_waitcnt lgkmcnt(0)" ::: "memory");
}
__device__ __forceinline__ void tr_matrix(const float* W, int K, int N, bf16* WT, int ldk, int dk0, int remap, const float* kscale, LAS float* scr, int lane, int gw, int NGW) {
    const int nblk = N / 32, items = (K / 64) * nblk;
    for (int it = gw; it < items; it += NGW) {
        const int kb = it / nblk, nb = it - kb * nblk, n0 = nb * 32;
        int dr = n0;
        if (remap == 1) dr = (n0 < FF) ? (n0 / 128) * 256 + (n0 % 128) : ((n0 - FF) / 128) * 256 + 128 + ((n0 - FF) % 128);
        else if (remap == 2) { dr = (n0 < 1696) ? n0 : n0 + 96; const int c = dr & 255; dr = (dr & ~255) + 128 * ((c & 63) >> 5) + 32 * (c >> 6); }
        tr_item(W, N, kb * 64, n0, WT, ldk, dr, dk0, kscale, scr, lane);
    }
}
__device__ __forceinline__ void sg_item(const float* in, int in_stride, bool do_silu, const float* W, int N, int n0, float* out, int out_stride, int dcol0, const float* bias, int lane) {
    const int i = lane & 31, hi = lane >> 5;
    f32x16 acc = f32x16{};
    const float* ip = in + (size_t)i * in_stride + 4 * hi;
    const float* wp = W + (size_t)(4 * hi) * N + n0 + i;
#pragma unroll 16
    for (int k0 = 0; k0 < 1024; k0 += 8) {
        f32x4 a = GL(f32x4, ip + k0);
        if (do_silu) { a[0] = a[0] / (1.0f + __expf(-a[0])); a[1] = a[1] / (1.0f + __expf(-a[1])); a[2] = a[2] / (1.0f + __expf(-a[2])); a[3] = a[3] / (1.0f + __expf(-a[3])); }
        const float b0 = wp[(size_t)(k0 + 0) * N], b1 = wp[(size_t)(k0 + 1) * N], b2 = wp[(size_t)(k0 + 2) * N], b3 = wp[(size_t)(k0 + 3) * N];
        acc = __builtin_amdgcn_mfma_f32_32x32x2f32(a[0], b0, acc, 0, 0, 0);
        acc = __builtin_amdgcn_mfma_f32_32x32x2f32(a[1], b1, acc, 0, 0, 0);
        acc = __builtin_amdgcn_mfma_f32_32x32x2f32(a[2], b2, acc, 0, 0, 0);
        acc = __builtin_amdgcn_mfma_f32_32x32x2f32(a[3], b3, acc, 0, 0, 0);
    }
    const float bv = bias ? bias[n0 + i] : 0.f;
#pragma unroll
    for (int r = 0; r < 16; ++r) { const int b = (r & 3) + 8 * (r >> 2) + 4 * hi; out[(size_t)b * out_stride + dcol0 + i] = acc[r] + bv; }
}
__device__ __forceinline__ void sincos_d(float af, float& sv, float& cv) {
    const double a = (double)af; const double kq = rint(a * 0.63661977236758134308); const double r = (a - kq * 1.57079632679489655800) - kq * 6.123233995736766e-17;
    const double r2 = r * r;
    const double s = r * (1.0 - r2 * (1.0 / 6.0 - r2 * (1.0 / 120.0 - r2 * (1.0 / 5040.0 - r2 * (1.0 / 362880.0 - r2 * (1.0 / 39916800.0 - r2 * (1.0 / 6227020800.0 - r2 * (1.0 / 1307674368000.0))))))));
    const double c = 1.0 - r2 * (0.5 - r2 * (1.0 / 24.0 - r2 * (1.0 / 720.0 - r2 * (1.0 / 40320.0 - r2 * (1.0 / 3628800.0 - r2 * (1.0 / 479001600.0 - r2 * (1.0 / 87178291200.0 - r2 * (1.0 / 20922789888000.0))))))));
    const int q = ((int)kq) & 3;
    const double ss = (q == 0) ? s : (q == 1) ? c : (q == 2) ? -s : -c;
    const double cc = (q == 0) ? c : (q == 1) ? -s : (q == 2) ? -c : s;
    sv = (float)ss; cv = (float)cc;
}
#define XB_TMO      128
#define XB_XCNT(j)  (256  + 64 * (j))
#define XB_XSUB(j)  (1280 + 64 * (j))
#define XB_XGEN(j)  (2304 + 64 * (j))
#define XB_TOP      3328
#define XB_TOPGEN   3392
#define XCD_BAR_WORDS 3456
#define XB_SPIN_CAP (1u << 18)

__device__ __forceinline__ unsigned xb_ld(unsigned* p)              { return __hip_atomic_load(p, __ATOMIC_RELAXED, __HIP_MEMORY_SCOPE_AGENT); }
__device__ __forceinline__ unsigned xb_add(unsigned* p, unsigned v) { return __hip_atomic_fetch_add(p, v, __ATOMIC_RELAXED, __HIP_MEMORY_SCOPE_AGENT); }
__device__ __forceinline__ unsigned xb_xcc_id() { return (unsigned)__builtin_amdgcn_s_getreg((3 << 11) | 20) & 0xFu; }
#define XB_SPIN(cond, bar) do { unsigned _sp = 0; while (cond) { __builtin_amdgcn_s_sleep(1); \
    if ((++_sp & 255u) == 0u) { if (xb_ld(&(bar)[XB_TMO])) break; if (_sp > XB_SPIN_CAP) { atomicAdd(&(bar)[XB_TMO], 1u); break; } } } } while (0)

struct XcdBarrier {
    unsigned* bar; unsigned x;
    volatile LAS unsigned* st;
};

__device__ __forceinline__ XcdBarrier xcd_barrier_post(unsigned* bar, volatile LAS unsigned* st) {
    XcdBarrier b; b.bar = bar; b.x = (unsigned)__builtin_amdgcn_readfirstlane((int)xb_xcc_id()); b.st = st;
    if (threadIdx.x == 0) (void)xb_add(&bar[XB_XCNT(b.x)], 1u);
    return b;
}
__device__ __forceinline__ void xcd_barrier_complete(unsigned* bar, unsigned x, unsigned& nloc, unsigned& nx) {
    const unsigned G = gridDim.x * gridDim.y * gridDim.z;
    unsigned sum, cnt, mine, sp = 0u;
    for (;;) {
        sum = 0u; cnt = 0u; mine = 0u;
#pragma unroll
        for (unsigned j = 0; j < 16; ++j) { const unsigned c = xb_ld(&bar[XB_XCNT(j)]); sum += c; cnt += (c > 0u) ? 1u : 0u; mine = (j == x) ? c : mine; }
        if (sum == G) break;
        __builtin_amdgcn_s_sleep(1);
        if ((++sp & 255u) == 0u) { if (xb_ld(&bar[XB_TMO])) break; if (sp > XB_SPIN_CAP) { atomicAdd(&bar[XB_TMO], 1u); break; } }
    }
    nloc = mine > 0u ? mine : 1u; nx = cnt > 0u ? cnt : 1u;
}

__device__ __forceinline__ void xcd_barrier(const XcdBarrier& b) {
    asm volatile("s_waitcnt vmcnt(0)" ::: "memory");
    __syncthreads();
    if (threadIdx.x == 0) {
        unsigned* bar = b.bar;
        __builtin_amdgcn_s_waitcnt(0);
        unsigned nloc = b.st[0], nx = b.st[1];
        if (nloc == 0u) { xcd_barrier_complete(bar, b.x, nloc, nx); b.st[0] = nloc; b.st[1] = nx; }
        const unsigned old = xb_add(&bar[XB_XSUB(b.x)], 1u);
        const unsigned gen = old / nloc;
        if (old + 1u == (gen + 1u) * nloc) {
            __builtin_amdgcn_fence(__ATOMIC_RELEASE, "agent");
            asm volatile("s_waitcnt vmcnt(0)" ::: "memory");
            const unsigned og = xb_add(&bar[XB_TOP], 1u);
            const unsigned tg = og / nx;
            if (og + 1u == (tg + 1u) * nx) xb_add(&bar[XB_TOPGEN], 1u);
            else XB_SPIN(xb_ld(&bar[XB_TOPGEN]) == tg, bar);
            __builtin_amdgcn_fence(__ATOMIC_ACQUIRE, "agent");
            xb_add(&bar[XB_XGEN(b.x)], 1u);
            asm volatile("s_waitcnt vmcnt(0)" ::: "memory");
        } else {
            XB_SPIN(xb_ld(&bar[XB_XGEN(b.x)]) == gen, bar);
            __builtin_amdgcn_fence(__ATOMIC_ACQUIRE, "agent");
            asm volatile("s_waitcnt vmcnt(0)" ::: "memory");
        }
    }
    __syncthreads();
}

#ifndef PHMASK
#define PHMASK 0x1FFF
#endif
#define PH_ON(k) (((PHMASK) >> (k)) & 1)
#define INP(k) (args.in[lauint(k)])
__global__ void __launch_bounds__(NWAVES * 64, 2) mega_fwd(Args args) {
    extern __shared__ __attribute__((aligned(16))) unsigned char lds[];
    cg::grid_group grid = cg::this_grid();
    const int G = gridDim.x, bx = blockIdx.x;
    const int vcu = (G % 8 == 0) ? (bx % 8) * (G / 8) + bx / 8 : bx;
    const int NGW = G * NWAVES;
    volatile LAS unsigned* MISC = (volatile LAS unsigned*)((LAS unsigned char*)lds + 131072 + 320);
    if (threadIdx.x < 32) MISC[threadIdx.x] = 0u;
    __syncthreads();
    XcdBarrier xbar = xcd_barrier_post((unsigned*)(args.ws + WS_CTL), MISC + 8);
#define GRID_BAR() do { XcdBarrier bb_ = xbar; bb_.bar = (unsigned*)lau((unsigned char*)bb_.bar); bb_.x = (unsigned)lauint((int)bb_.x); xcd_barrier(bb_); } while (0)
#define PTRS const int tid = lautid(), lane = tid & 63, wave = __builtin_amdgcn_readfirstlane(tid >> 6), gw = vcu * NWAVES + wave; (void)lane; (void)gw; unsigned char* ws = lau(args.ws); float* X = (float*)lau((unsigned char*)args.out); (void)X; \
    float* mods = (float*)(ws + WS_MODS); float* rowss = (float*)(ws + WS_ROWSS); float* rstdv = (float*)(ws + WS_RSTD); (void)rstdv; float* cs = (float*)(ws + WS_CS); float* sn = (float*)(ws + WS_SN); float* biasT = (float*)(ws + WS_BIAS); \
    bf16* AP = (bf16*)(ws + WS_AP); bf16* YS = (bf16*)(ws + WS_YS); bf16* QC = (bf16*)(ws + WS_QC); bf16* KVC = (bf16*)(ws + WS_KVC); bf16* YG = (bf16*)(ws + WS_YG); bf16* HB = (bf16*)(ws + WS_H); float* MG = (float*)(ws + WS_MG); \
    (void)mods; (void)rowss; (void)cs; (void)sn; (void)biasT; (void)AP; (void)YS; (void)QC; (void)KVC; (void)YG; (void)HB; (void)MG; \
    unsigned char* wl = ws + WS_W + (size_t)l * W_LAYER; const float* ml = mods + (size_t)l * NB * NMOD; const float* shw = (const float*)(ws + WS_SHW + (size_t)l * SHW_L); (void)wl; (void)ml; (void)shw;
    LAS unsigned char* ldsl = (LAS unsigned char*)lds;

    if (PH_ON(0)) {
        const int l = 0; PTRS
        for (int it = wave * G + vcu; it < 2 * (NMOD / 32); it += NGW) { const int l = it / (NMOD / 32), n0 = (it % (NMOD / 32)) * 32;
            sg_item(INP(1), DM, true, INP(2) + (size_t)l * DM * NMOD, NMOD, n0, mods + (size_t)l * NB * NMOD, NMOD, n0, INP(3) + (size_t)l * NMOD, lane); }
        for (int e = bx * 512 + tid; e < 2048 * 16; e += G * 512) { const int p = e >> 4, i = e & 15; const float inv = powf(10000.0f, -(float)(2 * i) / 32.0f); const float ang = (float)p * inv; float s, c; sincos_d(ang, s, c); cs[e] = c; sn[e] = s; }
        for (int e = bx * 512 + tid; e < 6 * 257; e += G * 512) { const int h = e / 257, idx = e % 257, rel = idx - 128, n = rel < 0 ? -rel : rel;
            int bk = rel > 0 ? 16 : 0; if (n < 8) bk += n; else { int lg = 31 - __clz(n * n); int large = 2 + lg; if (large > 15) large = 15; bk += large; }
            biasT[h * 260 + idx] = INP(12)[bk * 6 + h] * LOG2E; }
        LAS float* scr = (LAS float*)(ldsl + wave * 16384);
#pragma unroll 1
        for (int l2 = 0; l2 < 2; ++l2) { const int l = l2;
            unsigned char* wl = ws + WS_W + (size_t)l * W_LAYER;
            tr_matrix(INP(5) + (size_t)l * DM * NGU, DM, NGU, (bf16*)(wl + W_GU1), DM, 0, 1, nullptr, scr, lane, gw, NGW);
            tr_matrix(INP(6) + (size_t)l * FF * DM, FF, DM, (bf16*)(wl + W_DN1), FF, 0, 0, nullptr, scr, lane, gw, NGW);
            tr_matrix(INP(22) + (size_t)l * DM * NGU, DM, NGU, (bf16*)(wl + W_GU2), DM, 0, 1, nullptr, scr, lane, gw, NGW);
            tr_matrix(INP(23) + (size_t)l * FF * DM, FF, DM, (bf16*)(wl + W_DN2), FF, 0, 0, nullptr, scr, lane, gw, NGW);
            tr_matrix(INP(8) + (size_t)l * DM * 4768, DM, 4768, (bf16*)(wl + W_IN), DM, 0, 2, nullptr, scr, lane, gw, NGW);
            tr_matrix(INP(14) + (size_t)l * 256 * 384, 256, 384, (bf16*)(wl + W_QUP), 256, 0, 0, INP(13) + l * 256, scr, lane, gw, NGW);
            tr_matrix(INP(16) + (size_t)l * 128 * 512, 128, 512, (bf16*)(wl + W_KVUP), 128, 0, 0, INP(15) + l * 128, scr, lane, gw, NGW);
            tr_matrix(INP(17) + (size_t)l * 384 * DM, 384, DM, (bf16*)(wl + W_BR), DM, 0, 0, nullptr, scr, lane, gw, NGW);
            tr_matrix(INP(18) + (size_t)l * 384 * DM, 384, DM, (bf16*)(wl + W_BR), DM, 384, 0, nullptr, scr, lane, gw, NGW);
            tr_matrix(INP(19) + (size_t)l * 256 * DM, 256, DM, (bf16*)(wl + W_BR), DM, 768, 0, nullptr, scr, lane, gw, NGW);
            tr_matrix(INP(20) + (size_t)l * DM * DM, DM, DM, (bf16*)(wl + W_OUT), DM, 0, 0, nullptr, scr, lane, gw, NGW);
            for (int e = bx * 512 + tid; e < 96 * 1024 / 8; e += G * 512) { const int rr = e >> 7, r2 = rr < 32 ? 1536 + 96 + rr : 1536 + 192 + (rr - 32); ((v4u*)(wl + W_IN + (size_t)r2 * 1024 * 2))[e & 127] = (v4u){0u, 0u, 0u, 0u}; }
            for (int e = bx * 512 + tid; e < 128 * 256 / 8; e += G * 512) ((v4u*)(wl + W_QUP + (size_t)384 * 256 * 2))[e] = (v4u){0u, 0u, 0u, 0u};
        }
    }
    grid.sync();
    if (PH_ON(1)) {
        const int l = 0; PTRS
#pragma unroll 1
        for (int l2 = 0; l2 < 2; ++l2) { const int l = l2;
            float* shw = (float*)(ws + WS_SHW + (size_t)l * SHW_L); const float* ml = mods + (size_t)l * NB * NMOD;
            for (int it = wave * G + vcu; it < (NGU + 4768 + NGU) / 32; it += NGW) {
                int n0 = it * 32;
                if (n0 < NGU) { const int dr = (n0 < FF) ? (n0 / 128) * 256 + (n0 % 128) : ((n0 - FF) / 128) * 256 + 128 + ((n0 - FF) % 128);
                    sg_item(ml + 0 * DM, NMOD, false, INP(5) + (size_t)l * DM * NGU, NGU, n0, shw, NGU, dr, nullptr, lane); continue; }
                n0 -= NGU;
                if (n0 < 4768) { const int dr = (n0 < 1696) ? n0 : n0 + 96;
                    sg_item(ml + 3 * DM, NMOD, false, INP(8) + (size_t)l * DM * 4768, 4768, n0, shw + 32 * NGU, NIN, dr, nullptr, lane); continue; }
                n0 -= 4768;
                { const int dr = (n0 < FF) ? (n0 / 128) * 256 + (n0 % 128) : ((n0 - FF) / 128) * 256 + 128 + ((n0 - FF) % 128);
                    sg_item(ml + 6 * DM, NMOD, false, INP(22) + (size_t)l * DM * NGU, NGU, n0, shw + 32 * NGU + 32 * NIN, NGU, dr, nullptr, lane); }
            }
        }
        const float* gain = INP(4);
#pragma unroll 2
        for (int m = gw; m < MTOK; m += NGW) {
            const int b = m >> 11; const f32x4* xr = (const f32x4*)(INP(0) + (size_t)m * DM) + lane; const float* scp = mods + (size_t)b * NMOD + 1 * DM;
            f32x4 v[4]; float s = 0.f;
#pragma unroll
            for (int j = 0; j < 4; ++j) { v[j] = xr[64 * j]; s += (v[j][0] * v[j][0] + v[j][1] * v[j][1]) + (v[j][2] * v[j][2] + v[j][3] * v[j][3]); }
            s = wave_sum(s);
            if (lane < 16) rowss[(size_t)m * 16 + lane] = lane == 0 ? s : 0.f;
            unsigned long long* o8 = (unsigned long long*)(AP + (size_t)m * DM) + lane;
#pragma unroll
            for (int j = 0; j < 4; ++j) { const int col = 4 * lane + 256 * j; const f32x4 g = GL(f32x4, gain + col), sc = GL(f32x4, scp + col); const f32x4 y = v[j] * g * (sc + 1.0f);
                o8[64 * j] = (unsigned long long)pk2(y[0], y[1]) | ((unsigned long long)pk2(y[2], y[3]) << 32); }
        }
    }
    GRID_BAR();

#pragma unroll 1
    for (int ph = 0; ph < 26; ++ph) {
        const int l = ph >= 13 ? 1 : 0, k = ph - 13 * l, f = k >= 10 ? 1 : 0;
        if (k == 0 || k == 3 || k == 10) continue;
        {
            {
                if (k == 4 && PH_ON(2)) { PTRS   pg8::Gemm g{AP, (const bf16*)(wl + W_IN), DM, DM}; pg8::Order S; S.init(MTOK, NIN, G, bx, DM / 64, 0);
 { int lastpm_ = -1; pg8::Unit uu_;
                    for (int i_ = 0; S.next(i_, uu_); ++i_) if (uu_.pm != lastpm_) { lastpm_ = uu_.pm;
                        if (tid < 256) { const int row = uu_.pm * 256 + tid; const f32x4 a = GL(f32x4, rowss + (size_t)row * 16), b = GL(f32x4, rowss + (size_t)row * 16 + 4), c = GL(f32x4, rowss + (size_t)row * 16 + 8), d = GL(f32x4, rowss + (size_t)row * 16 + 12);
                            const float sq = ((a[0] + a[1]) + (a[2] + a[3])) + ((b[0] + b[1]) + (b[2] + b[3])) + ((c[0] + c[1]) + (c[2] + c[3])) + ((d[0] + d[1]) + (d[2] + d[3])); rstdv[row] = 1.0f / sqrtf(sq * (1.0f / 1024.0f) + EPS); } }
                    asm volatile("s_waitcnt vmcnt(0)" ::: "memory"); __syncthreads(); }
                  pg8::EpiIn E{YS, YG, rstdv, shw + 32 * NGU, ldsl + 131072 + 1024};
                  pg8::gemm_phase<pg8::EpiIn, pg8::Order, true, true>(ldsl, g, S, E); }
                if (k == 5 && PH_ON(3)) { PTRS
                    const float* gq = INP(9) + l * 64; const float* gk = INP(10) + l * 64;
#pragma unroll 2
                    for (int m = gw; m < MTOK; m += NGW) {
                        const int t = m & (SEQ - 1), rp = t >> 6, cp = t & 63;
                        bf16* yr = YS + (size_t)m * NYS;
                        const v4u w1 = GL(v4u, yr + lane * 8), w2 = GL(v4u, yr + 1280 + lane * 8);
                        { float v[8] = {bflo(w1.x), bfhi(w1.x), bflo(w1.y), bfhi(w1.y), bflo(w1.z), bfhi(w1.z), bflo(w1.w), bfhi(w1.w)};
                          const int hh = lane >> 3, j = lane & 7;
                          float ss = 0.f;
#pragma unroll
                          for (int e = 0; e < 8; ++e) ss += v[e] * v[e];
                          ss += __shfl_xor(ss, 1); ss += __shfl_xor(ss, 2); ss += __shfl_xor(ss, 4);
                          const float rstd = 1.0f / sqrtf(ss * (1.0f / 64.0f) + EPS);
                          const float* gp = (hh < 6 ? gq : gk) + j * 8;
                          const int pos = (j < 4) ? rp : cp; const float* cp_ = cs + pos * 16 + (j & 1) * 8; const float* sp_ = sn + pos * 16 + (j & 1) * 8;
                          const float osc = hh < 6 ? C2A : 1.0f; float o[8];
#pragma unroll
                          for (int e = 0; e < 8; ++e) { const float a = v[e] * rstd * gp[e]; const float pa = __shfl_xor(a, 2); const float c = cp_[e], s = sp_[e];
                              o[e] = ((j & 2) == 0 ? a * c - pa * s : pa * s + a * c) * osc; }
                          v4u ow; ow.x = pk2(o[0], o[1]); ow.y = pk2(o[2], o[3]); ow.z = pk2(o[4], o[5]); ow.w = pk2(o[6], o[7]);
                          GS(v4u, yr + lane * 8) = ow; }
                        { float v[8] = {bflo(w2.x), bfhi(w2.x), bflo(w2.y), bfhi(w2.y), bflo(w2.z), bfhi(w2.z), bflo(w2.w), bfhi(w2.w)};
                          float ss = 0.f;
#pragma unroll
                          for (int e = 0; e < 8; ++e) ss += v[e] * v[e];
                          ss += __shfl_xor(ss, 1); ss += __shfl_xor(ss, 2); ss += __shfl_xor(ss, 4); ss += __shfl_xor(ss, 8);
                          const float s32 = ss + __shfl_xor(ss, 16);
                          const float rstd = lane < 32 ? 1.0f / sqrtf(s32 * (1.0f / 256.0f) + EPS) : 1.0f / sqrtf(ss * (1.0f / 128.0f) + EPS);
                          const int j = lane & 3; const float* cp_ = cs + t * 16 + (j & 1) * 8; const float* sp_ = sn + t * 16 + (j & 1) * 8;
                          float o[8];
#pragma unroll
                          for (int e = 0; e < 8; ++e) { const float pa = __shfl_xor(v[e], 2); const float c = cp_[e], s = sp_[e];
                              o[e] = lane < 48 ? v[e] * rstd : ((j & 2) == 0 ? v[e] * c - pa * s : pa * s + v[e] * c); }
                          v4u ow; ow.x = pk2(o[0], o[1]); ow.y = pk2(o[2], o[3]); ow.z = pk2(o[4], o[5]); ow.w = pk2(o[6], o[7]);
                          if (lane < 52) GS(v4u, yr + 1280 + lane * 8) = ow; }
                    }
                }
                if (k == 6 && PH_ON(4)) { PTRS  pg8::Gemm g{YS + 1280, (const bf16*)(wl + W_QUP), NYS, 256}; pg8::Order S; S.init(MTOK, 512, G, bx, 4, 0);
                  pg8::EpiQup E{QC, cs, sn};
                  pg8::gemm_phase<pg8::EpiQup, pg8::Order, true, true>(ldsl, g, S, E); }
                if (k == 6 && PH_ON(5)) { PTRS  pg8::Gemm g{YS + 1536, (const bf16*)(wl + W_KVUP), NYS, 128}; pg8::Order S; S.init(MTOK, 512, G, bx, 2, 0);
                  pg8::EpiPlain E{KVC, 512};
                  pg8::gemm_phase<pg8::EpiPlain, pg8::Order, true, true>(ldsl, g, S, E); }
#ifndef ATT_REP
#define ATT_REP 1
#endif
                for (int rep = 0; rep < ATT_REP; ++rep) if (k == 7 && PH_ON(6)) { PTRS
                    const int b = vcu >> 3, jj = vcu & 7; const size_t r0 = (size_t)b * SEQ;
                    float refA; { float gq_ = fabsf(INP(9)[l * 64 + lane]), gk_ = fabsf(INP(10)[l * 64 + lane]);
#pragma unroll
                        for (int o_ = 1; o_ < 64; o_ <<= 1) { gq_ = fmaxf(gq_, __shfl_xor(gq_, o_)); gk_ = fmaxf(gk_, __shfl_xor(gk_, o_)); }
                        refA = 8.0f * LOG2E * 1.01f * gq_ * gk_; }
#pragma unroll 1
                    for (int i = 0; i < 6; ++i) { const int e = (jj & 3) * 6 + i, h = (jj >> 2) * 3 + (e >> 3), qb = e & 7, kvh = jj >> 2;
                        att::Desc d{YS + r0 * NYS + h * 64, NYS, YS + r0 * NYS + 384 + kvh * 64, NYS, nullptr, 0, YS + r0 * NYS + 512 + kvh * 64, NYS, AP + r0 * DM + h * 64, DM};
                        att::unit<64, 0, true>(d, qb * 256, (att::ATT_LAS_T)lds, nullptr, refA); }
#pragma unroll 1
                    for (int i = 0; i < 4; ++i) { const int e = jj * 4 + i, h = e >> 3, qb = e & 7;
                        att::Desc d{QC + r0 * 384 + h * 96, 384, KVC + r0 * 512 + h * 128, 512, YS + r0 * NYS + 1664, NYS, KVC + r0 * 512 + h * 128 + 64, 512, AP + r0 * DM + 768 + h * 64, DM};
                        att::unit<96, 0>(d, qb * 256, (att::ATT_LAS_T)lds, nullptr, 0.f); }
#pragma unroll 1
                    for (int i = 0; i < 6; ++i) { const int e = (jj & 3) * 6 + i, h = (jj >> 2) * 3 + (e >> 3), qb = e & 7, kvh = jj >> 2;
                        att::Desc d{YS + r0 * NYS + 640 + h * 64, NYS, YS + r0 * NYS + 1024 + kvh * 64, NYS, nullptr, 0, YS + r0 * NYS + 1152 + kvh * 64, NYS, AP + r0 * DM + 384 + h * 64, DM};
                        att::unit<64, 1>(d, qb * 256, (att::ATT_LAS_T)lds, biasT + h * 260, INP(11)[l * 6 + h] * LOG2E); }
                }
                if (k == 8 && PH_ON(7)) { PTRS  pg8::Gemm g{AP, (const bf16*)(wl + W_BR), DM, DM}; pg8::Order S; S.init(MTOK, DM, G, bx, 0, 1);
                  pg8::EpiBr E{YG, MG};
                  pg8::gemm_phase<pg8::EpiBr, pg8::Order, true, true>(ldsl, g, S, E); }
                if (k == 9 && PH_ON(8)) { PTRS  pg8::Gemm g{YG, (const bf16*)(wl + W_OUT), DM, DM}; pg8::Order S; S.init(MTOK, DM, G, bx, DM / 64, 0);
                  pg8::EpiRes E{X, X, ml + 5 * DM, AP, INP(21) + l * DM, ml + 7 * DM, rowss, ldsl + 131072 + 1024, 1.0f, 0};
                  pg8::gemm_phase<pg8::EpiRes, pg8::Order, true, true>(ldsl, g, S, E); }
            }
            if ((k == 1 || k == 11) && PH_ON(9)) { PTRS   pg8::Gemm g{AP, (const bf16*)(wl + (f ? W_GU2 : W_GU1)), DM, DM}; pg8::Order S; S.init(MTOK, NGU, G, bx, DM / 64, 0);
 { int lastpm_ = -1; pg8::Unit uu_;
                    for (int i_ = 0; S.next(i_, uu_); ++i_) if (uu_.pm != lastpm_) { lastpm_ = uu_.pm;
                        if (tid < 256) { const int row = uu_.pm * 256 + tid; const f32x4 a = GL(f32x4, rowss + (size_t)row * 16), b = GL(f32x4, rowss + (size_t)row * 16 + 4), c = GL(f32x4, rowss + (size_t)row * 16 + 8), d = GL(f32x4, rowss + (size_t)row * 16 + 12);
                            const float sq = ((a[0] + a[1]) + (a[2] + a[3])) + ((b[0] + b[1]) + (b[2] + b[3])) + ((c[0] + c[1]) + (c[2] + c[3])) + ((d[0] + d[1]) + (d[2] + d[3])); rstdv[row] = 1.0f / sqrtf(sq * (1.0f / 1024.0f) + EPS); } }
                    asm volatile("s_waitcnt vmcnt(0)" ::: "memory"); __syncthreads(); }
              pg8::EpiGU E{HB, rstdv, shw + (f ? 32 * NGU + 32 * NIN : 0)};
              pg8::gemm_phase<pg8::EpiGU, pg8::Order, true, true>(ldsl, g, S, E); }
            if ((k == 2 || k == 12) && PH_ON(10)) { PTRS  pg8::Gemm g{HB, (const bf16*)(wl + (f ? W_DN2 : W_DN1)), FF, FF}; pg8::Order S; S.init(MTOK, DM, G, bx, FF / 64, 0);
              const float* base = (l == 0 && f == 0) ? INP(0) : X;
              const bool has_next = !(l == 1 && f == 1);
              const float* ngain = f == 0 ? INP(7) + l * DM : INP(4) + (l + 1) * DM;
              const float* nsc = f == 0 ? ml + 4 * DM : ml + (size_t)NB * NMOD + 1 * DM;
              pg8::EpiRes E{base, X, ml + (f ? 8 : 2) * DM, has_next ? AP : nullptr, ngain, nsc, rowss, ldsl + 131072 + 1024, 0.5f, 0};
              pg8::gemm_phase<pg8::EpiRes, pg8::Order, true, true>(ldsl, g, S, E); }
        }
        GRID_BAR();
    }
    if (PH_ON(11)) {
        const int l = 0; PTRS
        const float* gain = INP(24);
        for (int m = gw; m < MTOK; m += 2 * NGW) {
            f32x4* xr0 = (f32x4*)(X + (size_t)m * DM) + lane; f32x4* xr1 = (f32x4*)(X + (size_t)(m + NGW) * DM) + lane; f32x4 v[2][4]; float s0 = 0.f, s1 = 0.f;
#pragma unroll
            for (int j = 0; j < 4; ++j) { v[0][j] = GL(f32x4, xr0 + 64 * j); v[1][j] = GL(f32x4, xr1 + 64 * j); }
#pragma unroll
            for (int j = 0; j < 4; ++j) { s0 += (v[0][j][0] * v[0][j][0] + v[0][j][1] * v[0][j][1]) + (v[0][j][2] * v[0][j][2] + v[0][j][3] * v[0][j][3]); s1 += (v[1][j][0] * v[1][j][0] + v[1][j][1] * v[1][j][1]) + (v[1][j][2] * v[1][j][2] + v[1][j][3] * v[1][j][3]); }
            const float r0 = 1.0f / sqrtf(wave_sum(s0) * (1.0f / 1024.0f) + EPS), r1 = 1.0f / sqrtf(wave_sum(s1) * (1.0f / 1024.0f) + EPS);
#pragma unroll
            for (int j = 0; j < 4; ++j) { const f32x4 g = GL(f32x4, gain + 4 * lane + 256 * j); GS(f32x4, xr0 + 64 * j) = v[0][j] * r0 * g; GS(f32x4, xr1 + 64 * j) = v[1][j] * r1 * g; }
        }
    }
}

extern "C" void kernel_launch(void* const* d_in, const int* in_sizes, int n_in, void* d_out, int out_size, void* d_ws, size_t ws_size, hipStream_t stream) {
    static int grid = 0;
    if (grid == 0) {
        if (n_in != 25 || out_size != MTOK * DM || ws_size < WS_END) { fprintf(stderr, "kernel_launch: unexpected shapes (n_in %d, out %d, ws %zu)\n", n_in, out_size, ws_size); grid = -1; return; }
        int dev = 0, cus = 0, per_cu = 0;
        hipGetDevice(&dev); hipDeviceGetAttribute(&cus, hipDeviceAttributeMultiprocessorCount, dev);
        if (hipFuncSetAttribute((const void*)mega_fwd, hipFuncAttributeMaxDynamicSharedMemorySize, LDS_BYTES) != hipSuccess) { fprintf(stderr, "kernel_launch: hipFuncSetAttribute failed\n"); grid = -1; return; }
        if (hipOccupancyMaxActiveBlocksPerMultiprocessor(&per_cu, (const void*)mega_fwd, NWAVES * 64, LDS_BYTES) != hipSuccess || per_cu < 1) { fprintf(stderr, "kernel_launch: occupancy query failed (%d)\n", per_cu); per_cu = 1; }
        (void)hipGetLastError();
        grid = cus * (per_cu > 1 ? 1 : per_cu);
        fprintf(stderr, "kernel_launch: grid %d (cus %d, per_cu %d)\n", grid, cus, per_cu);
    }
    if (grid < 0) return;
    if (hipMemsetAsync((char*)d_ws + WS_CTL, 0, CTL_BYTES, stream) != hipSuccess) { fprintf(stderr, "kernel_launch: memset failed\n"); return; }
    Args a{};
    for (int i = 0; i < 25; ++i) a.in[i] = (const float*)d_in[i];
    a.out = (float*)d_out; a.ws = (unsigned char*)d_ws;
    void* kargs[] = {&a};
    hipError_t e = hipLaunchCooperativeKernel((const void*)mega_fwd, dim3(grid), dim3(NWAVES * 64), kargs, LDS_BYTES, stream);
    if (e != hipSuccess) fprintf(stderr, "kernel_launch: cooperative launch failed: %s (grid %d)\n", hipGetErrorString(e), grid);
}
```
